# Optimizing an MI355X kernel written in HIP

```python
import math
import jax, jax.numpy as jnp
from jax import lax
import numpy as np

D_MODEL = 1024
BATCH = 4
SEQ = 4096
DEPTH = 2
DEC_BATCH = 32
DEC_SEQ = 4
PAST_LEN = 8192
PAGE_SIZE = 128

N_EVEN = (DEPTH + 1) // 2
N_ODD = DEPTH // 2
EPS = 1e-6

A_HEAD_DIM = 64
A_HEADS_PER_GROUP = 4
A_GROUPS = ((128, 1), (512, 4), (2048, 16))
A_N_GROUPS = len(A_GROUPS)
A_HEADS = A_N_GROUPS * A_HEADS_PER_GROUP
A_OUT = A_HEADS_PER_GROUP * A_HEAD_DIM
A_QKV = 3 * A_HEADS * A_HEAD_DIM
A_BLOCK = 128
A_SCALE = A_HEAD_DIM ** -0.5
N_BUCKETS = 32
BUCKET_MAX_DIST = 2048

B_HEAD_DIM = 64
B_HEADS = 12
B_WIDTH = B_HEADS * B_HEAD_DIM
DECAY_LORA = 64
AAA_LORA = 64
GATE_LORA = 160
B_COLS = 3 * B_WIDTH + DECAY_LORA + AAA_LORA + GATE_LORA
E_COLS = A_QKV + B_COLS
MIX_WIDTH = A_OUT + B_WIDTH
LNX_EPS = 64e-5

C_EXPAND = 128
C_HEADS = D_MODEL // C_EXPAND
C_FDIM = C_HEADS * C_EXPAND
C_VDIM_HEAD = D_MODEL // C_HEADS
C_COLS = 2 * C_FDIM + 2 * D_MODEL
C_CHUNK = 64

D_FF = 4 * D_MODEL

kernel_name = 'hybrid_dilated_rwkv7_hgrn2_step'


def rmsnorm(x, g):
    xf = x.astype(jnp.float32)
    y = xf * lax.rsqrt(jnp.mean(xf * xf, -1, keepdims=True) + EPS)
    return (y * g.astype(jnp.float32)).astype(x.dtype)


def t5_bucket(dist):
    max_exact = N_BUCKETS // 2
    d = jnp.maximum(dist, 1).astype(jnp.float32)
    large = max_exact + (jnp.log(d / max_exact) / math.log(BUCKET_MAX_DIST / max_exact)
                         * (N_BUCKETS - max_exact)).astype(jnp.int32)
    large = jnp.minimum(large, N_BUCKETS - 1)
    return jnp.where(dist < max_exact, dist, large)


def dilated_block(q, kv, pos0, bias, window, dil):
    T = q.shape[1]
    nk = window // dil + 1
    t = jnp.arange(T)
    j = jnp.arange(nk)
    rows = window + t[:, None] - j[None, :] * dil
    valid = (pos0 + t[:, None] - j[None, :] * dil) >= 0
    kvg = kv[:, rows].astype(jnp.float32)
    logits = jnp.einsum('bthd,btjhd->bhtj', q.astype(jnp.float32), kvg[:, :, :, 0]) * A_SCALE
    logits = logits + bias.T[None, :, None, :]
    logits = jnp.where(valid[None, None], logits, -jnp.inf)
    lse = jax.nn.logsumexp(logits, axis=-1)
    p = jnp.exp(logits - lse[..., None])
    o = jnp.einsum('bhtj,btjhd->bthd', p, kvg[:, :, :, 1])
    return o, lse


def attend_group(q, kv_full, pos0, bias, window, dil):
    B_, T, H, Dh = q.shape
    if T <= A_BLOCK:
        return dilated_block(q, kv_full, pos0, bias, window, dil)
    nb = T // A_BLOCK

    def one(n):
        s = n * A_BLOCK
        qb = lax.dynamic_slice_in_dim(q, s, A_BLOCK, axis=1)
        kvb = lax.dynamic_slice_in_dim(kv_full, s, window + A_BLOCK, axis=1)
        return dilated_block(qb, kvb, pos0 + s, bias, window, dil)

    o, lse = lax.map(one, jnp.arange(nb))
    o = jnp.moveaxis(o, 0, 1).reshape(B_, T, H, Dh)
    lse = jnp.moveaxis(lse, 0, 2).reshape(B_, H, T)
    return o, lse


def mixer_a(qkv, pos0, rel_bias, fronts):
    B_, T = qkv.shape[:2]
    outs, lses, rows = [], [], []
    for g, (window, dil) in enumerate(A_GROUPS):
        hs = slice(g * A_HEADS_PER_GROUP, (g + 1) * A_HEADS_PER_GROUP)
        q = qkv[:, :, 0, hs]
        kv_new = qkv[:, :, 1:, hs]
        kv_full = jnp.concatenate([fronts[g].astype(kv_new.dtype), kv_new], axis=1)
        nk = window // dil + 1
        bias = rel_bias[t5_bucket(jnp.arange(nk) * dil)][:, hs].astype(jnp.float32)
        o, lse = attend_group(q, kv_full, pos0, bias, window, dil)
        outs.append(o)
        lses.append(lse)
        rows.append(kv_new[:, -min(window, T):])
    wts = jax.nn.softmax(jnp.stack(lses), axis=0)
    out = jnp.einsum('gbht,gbthd->bthd', wts, jnp.stack(outs))
    return out.reshape(B_, T, A_OUT), rows


def mixer_b(pb, shift_prev, s0, mu, w0, w2, a0, a2, g2, k_k, k_a, r_k, lnx_w, lnx_b):
    f32 = jnp.float32
    B_, T, _ = pb.shape
    pb = pb.astype(f32)
    prev = jnp.concatenate([shift_prev.astype(f32)[:, None], pb[:, :-1]], axis=1)
    xs = pb + (prev - pb) * mu.astype(f32)
    W = B_WIDTH
    r = xs[..., :W]
    k = xs[..., W:2 * W]
    v = xs[..., 2 * W:3 * W]
    wd = xs[..., 3 * W:3 * W + DECAY_LORA]
    ad = xs[..., 3 * W + DECAY_LORA:3 * W + DECAY_LORA + AAA_LORA]
    gd = xs[..., 3 * W + DECAY_LORA + AAA_LORA:]
    w = -jax.nn.softplus(-(w0.astype(f32) + jnp.tanh(wd) @ w2.astype(f32))) - 0.5
    decay = jnp.exp(-jnp.exp(w))
    a = jax.nn.sigmoid(a0.astype(f32) + ad @ a2.astype(f32))
    g = jax.nn.sigmoid(gd) @ g2.astype(f32)
    heads = lambda t: t.reshape(B_, T, B_HEADS, B_HEAD_DIM)
    kk = heads(k * k_k.astype(f32))
    kk = kk / jnp.maximum(jnp.sqrt(jnp.sum(kk * kk, -1, keepdims=True)), 1e-12)
    k = k * (1.0 + (a - 1.0) * k_a.astype(f32))
    r_h, k_h, v_h, d_h, a_h = heads(r), heads(k), heads(v), heads(decay), heads(a)
    tm = lambda t: jnp.moveaxis(t, 1, 0)

    def step(S, inp):
        r_t, d_t, k_t, v_t, kk_t, a_t = inp
        sa = jnp.einsum('bhvk,bhk->bhv', S, -kk_t)
        S = (S * d_t[:, :, None, :] + sa[..., None] * (kk_t * a_t)[:, :, None, :]
             + v_t[..., None] * k_t[:, :, None, :])
        return S, jnp.einsum('bhvk,bhk->bhv', S, r_t)

    S, y = lax.scan(step, s0.astype(f32), (tm(r_h), tm(d_h), tm(k_h), tm(v_h), tm(kk), tm(a_h)))
    y = tm(y)
    mean = jnp.mean(y, -1, keepdims=True)
    var = jnp.mean(jnp.square(y - mean), -1, keepdims=True)
    y = ((y - mean) * lax.rsqrt(var + LNX_EPS)).reshape(B_, T, W) * lnx_w.astype(f32) + lnx_b.astype(f32)
    bonus = jnp.sum(r_h * k_h * r_k.astype(f32), -1, keepdims=True) * v_h
    out = (y + bonus.reshape(B_, T, W)) * g
    return out, pb[:, -1], S


def hgrn_lower_bounds(lb_raw):
    sm = jax.nn.softmax(lb_raw.astype(jnp.float32), axis=0)
    return jnp.cumsum(sm, axis=0) - sm[0]


def gla_chunks(q, k, v, logf, s0, chunk):
    B_, T, H, Dk = q.shape
    Dv = v.shape[-1]
    n = T // chunk
    to_chunks = lambda t: jnp.moveaxis(t.reshape(B_, n, chunk, H, t.shape[-1]), 1, 0)
    mask = jnp.tril(jnp.ones((chunk, chunk), bool))[None, :, :, None, None]

    def step(S, inp):
        qc, kc, vc, lc = inp
        b = jnp.cumsum(lc, axis=1)
        diff = b[:, :, None] - b[:, None, :]
        dec = jnp.exp(jnp.where(mask, diff, -jnp.inf))
        att = jnp.einsum('bthk,bshk,btshk->bhts', qc, kc, dec)
        o = (jnp.einsum('bthk,bhkv->bthv', qc * jnp.exp(b), S)
             + jnp.einsum('bhts,bshv->bthv', att, vc))
        bl = b[:, -1]
        S = S * jnp.exp(bl)[..., None] + jnp.einsum('bshk,bshv->bhkv', kc * jnp.exp(bl[:, None] - b), vc)
        return S, o

    S, o = lax.scan(step, s0, (to_chunks(q), to_chunks(k), to_chunks(v), to_chunks(logf)))
    return jnp.moveaxis(o, 0, 1).reshape(B_, T, H, Dv), S


def mixer_c(pc, s0, lb, norm_g):
    f32 = jnp.float32
    B_, T, _ = pc.shape
    pc = pc.astype(f32)
    q = jax.nn.silu(pc[..., :C_FDIM])
    fg = lb + (1.0 - lb) * jax.nn.sigmoid(pc[..., C_FDIM:2 * C_FDIM])
    k = 1.0 - fg
    logf = jnp.log(fg)
    i = pc[..., 2 * C_FDIM:2 * C_FDIM + D_MODEL]
    gate = pc[..., 2 * C_FDIM + D_MODEL:]
    hk = lambda t: t.reshape(B_, T, C_HEADS, C_EXPAND)
    chunk = C_CHUNK if T % C_CHUNK == 0 else T
    o, S = gla_chunks(hk(q), hk(k), i.reshape(B_, T, C_HEADS, C_VDIM_HEAD), hk(logf), s0.astype(f32), chunk)
    o = rmsnorm(o.reshape(B_, T, D_MODEL), norm_g) * jax.nn.silu(gate)
    return o, S


def trunk(x, pos0, a_fronts, b_shift0, b_state0, c_state0, p):
    B_, T, _ = x.shape
    dt = x.dtype
    lb_all = hgrn_lower_bounds(p['c_lb_raw'])
    kv_rows = [[] for _ in A_GROUPS]
    shifts, wkvs, cstates = [], [], []
    for layer in range(DEPTH):
        h = rmsnorm(x, p['norm_mix'][layer])
        if layer % 2 == 0:
            e = layer // 2
            proj = h @ p['e_w_in'][e]
            qkv = proj[..., :A_QKV].reshape(B_, T, 3, A_HEADS, A_HEAD_DIM)
            a_out, rows = mixer_a(qkv, pos0, p['rel_bias'], [f[e] for f in a_fronts])
            b_out, shift, wkv = mixer_b(proj[..., A_QKV:], b_shift0[e], b_state0[e], p['e_mu'][e],
                                        p['e_w0'][e], p['e_w2'][e], p['e_a0'][e], p['e_a2'][e],
                                        p['e_g2'][e], p['e_k_k'][e], p['e_k_a'][e], p['e_r_k'][e],
                                        p['e_lnx_w'][e], p['e_lnx_b'][e])
            for g in range(A_N_GROUPS):
                kv_rows[g].append(rows[g])
            shifts.append(shift)
            wkvs.append(wkv)
            mix = jnp.concatenate([a_out, b_out], -1).astype(dt) @ p['e_w_out'][e]
        else:
            o = layer // 2
            c_out, sc = mixer_c(h @ p['c_w_in'][o], c_state0[o], lb_all[layer], p['c_norm'][o])
            cstates.append(sc)
            mix = c_out.astype(dt) @ p['c_w_out'][o]
        x = x + mix.astype(dt)
        h = rmsnorm(x, p['norm_mlp'][layer])
        x = x + (jnp.square(jax.nn.relu(h @ p['mlp_up'][layer])) @ p['mlp_down'][layer]).astype(dt)
    y = rmsnorm(x, p['norm_final'])
    return y, [jnp.stack(r) for r in kv_rows], jnp.stack(shifts), jnp.stack(wkvs), jnp.stack(cstates)


def setup_inputs(seed: int = 0) -> dict:
    key = jax.random.key(seed)
    ks = iter(jax.random.split(key, 40))
    nrm = lambda shape, s: jax.random.normal(next(ks), shape, jnp.float32) * s
    L = [min(w, PAST_LEN) for w, _ in A_GROUPS]
    d = {}
    d['x_prompt'] = nrm((BATCH, SEQ, D_MODEL), 1.0)
    d['x_sample'] = nrm((DEC_BATCH, DEC_SEQ, D_MODEL), 1.0)
    d['cache_a0'] = nrm((N_EVEN, DEC_BATCH, L[0], 2, A_HEADS_PER_GROUP, A_HEAD_DIM), 1.0)
    d['cache_a1'] = nrm((N_EVEN, DEC_BATCH, L[1], 2, A_HEADS_PER_GROUP, A_HEAD_DIM), 1.0)
    d['cache_a2'] = nrm((N_EVEN, DEC_BATCH, L[2], 2, A_HEADS_PER_GROUP, A_HEAD_DIM), 1.0)
    d['state_b_shift'] = nrm((N_EVEN, DEC_BATCH, B_COLS), 1.0)
    d['state_b_wkv'] = nrm((N_EVEN, DEC_BATCH, B_HEADS, B_HEAD_DIM, B_HEAD_DIM), 0.5)
    d['state_c'] = nrm((N_ODD, DEC_BATCH, C_HEADS, C_EXPAND, C_VDIM_HEAD), 0.5)
    d['rel_bias'] = nrm((N_BUCKETS, A_HEADS), 0.5)
    d['norm_mix'] = 1.0 + nrm((DEPTH, D_MODEL), 0.05)
    d['norm_mlp'] = 1.0 + nrm((DEPTH, D_MODEL), 0.05)
    d['norm_final'] = 1.0 + nrm((D_MODEL,), 0.05)
    d['e_w_in'] = nrm((N_EVEN, D_MODEL, E_COLS), D_MODEL ** -0.5)
    d['e_mu'] = jax.random.uniform(next(ks), (N_EVEN, B_COLS), jnp.float32)
    d['e_w0'] = nrm((N_EVEN, B_WIDTH), 0.5)
    d['e_w2'] = nrm((N_EVEN, DECAY_LORA, B_WIDTH), DECAY_LORA ** -0.5)
    d['e_a0'] = nrm((N_EVEN, B_WIDTH), 0.5)
    d['e_a2'] = nrm((N_EVEN, AAA_LORA, B_WIDTH), AAA_LORA ** -0.5)
    d['e_g2'] = nrm((N_EVEN, GATE_LORA, B_WIDTH), GATE_LORA ** -0.5)
    d['e_k_k'] = 0.85 + nrm((N_EVEN, B_WIDTH), 0.05)
    d['e_k_a'] = 1.0 + nrm((N_EVEN, B_WIDTH), 0.05)
    d['e_r_k'] = nrm((N_EVEN, B_HEADS, B_HEAD_DIM), 0.1)
    d['e_lnx_w'] = 1.0 + nrm((N_EVEN, B_WIDTH), 0.05)
    d['e_lnx_b'] = nrm((N_EVEN, B_WIDTH), 0.02)
    d['e_w_out'] = nrm((N_EVEN, MIX_WIDTH, D_MODEL), MIX_WIDTH ** -0.5)
    d['c_w_in'] = nrm((N_ODD, D_MODEL, C_COLS), D_MODEL ** -0.5)
    d['c_lb_raw'] = nrm((DEPTH, C_FDIM), 0.5)
    d['c_norm'] = 1.0 + nrm((N_ODD, D_MODEL), 0.05)
    d['c_w_out'] = nrm((N_ODD, D_MODEL, D_MODEL), D_MODEL ** -0.5)
    d['mlp_up'] = nrm((DEPTH, D_MODEL, D_FF), D_MODEL ** -0.5)
    d['mlp_down'] = nrm((DEPTH, D_FF, D_MODEL), D_FF ** -0.5)
    return d


def reference(x_prompt, x_sample, cache_a0, cache_a1, cache_a2, state_b_shift, state_b_wkv, state_c,
              rel_bias, norm_mix, norm_mlp, norm_final, e_w_in, e_mu, e_w0, e_w2, e_a0, e_a2, e_g2,
              e_k_k, e_k_a, e_r_k, e_lnx_w, e_lnx_b, e_w_out, c_w_in, c_lb_raw, c_norm, c_w_out,
              mlp_up, mlp_down):
    p = dict(rel_bias=rel_bias, norm_mix=norm_mix, norm_mlp=norm_mlp, norm_final=norm_final,
             e_w_in=e_w_in, e_mu=e_mu, e_w0=e_w0, e_w2=e_w2, e_a0=e_a0, e_a2=e_a2, e_g2=e_g2,
             e_k_k=e_k_k, e_k_a=e_k_a, e_r_k=e_r_k, e_lnx_w=e_lnx_w, e_lnx_b=e_lnx_b, e_w_out=e_w_out,
             c_w_in=c_w_in, c_lb_raw=c_lb_raw, c_norm=c_norm, c_w_out=c_w_out,
             mlp_up=mlp_up, mlp_down=mlp_down)
    dt = x_prompt.dtype
    bp = x_prompt.shape[0]
    p_fronts = [jnp.zeros((N_EVEN, bp, w, 2, A_HEADS_PER_GROUP, A_HEAD_DIM), dt) for w, _ in A_GROUPS]
    y_prompt, p_kv, p_shift, p_wkv, p_c = trunk(
        x_prompt, 0, p_fronts,
        jnp.zeros((N_EVEN, bp, B_COLS), jnp.float32),
        jnp.zeros((N_EVEN, bp, B_HEADS, B_HEAD_DIM, B_HEAD_DIM), jnp.float32),
        jnp.zeros((N_ODD, bp, C_HEADS, C_EXPAND, C_VDIM_HEAD), jnp.float32), p)
    s_fronts = [jnp.pad(c, ((0, 0), (0, 0), (w - c.shape[2], 0), (0, 0), (0, 0), (0, 0)))
                for c, (w, _) in zip((cache_a0, cache_a1, cache_a2), A_GROUPS)]
    y_sample, s_kv, s_shift, s_wkv, s_c = trunk(
        x_sample, PAST_LEN, s_fronts, state_b_shift, state_b_wkv, state_c, p)
    p_a0, p_a1, p_a2 = p_kv
    s_a0, s_a1, s_a2 = s_kv
    return (y_prompt, y_sample, p_a0, p_a1, p_a2, p_shift, p_wkv, p_c,
            s_a0, s_a1, s_a2, s_shift, s_wkv, s_c)
```

```cpp
#include <hip/hip_runtime.h>
#include <cstdio>
#include <cstdint>

#ifndef MK_PER_PHASE
#define MK_PER_PHASE 1
#endif

namespace pg8 {
#define PG8_LAS __attribute__((address_space(3)))
typedef unsigned short bf16_t;
typedef short bf16x8 __attribute__((ext_vector_type(8)));
typedef float f32x4 __attribute__((ext_vector_type(4)));
typedef unsigned u32x4 __attribute__((ext_vector_type(4)));
constexpr int BM = 256, BK = 64, HALF = 128, HTB = HALF * BK * 2  , STAGE_BYTES = 8 * HTB, NXCD = 8, WGM = 8;

__host__ __device__ __forceinline__ int lds_byte(int r, int c) { const int st = (r >> 4) * 2 + (c >> 5), rr = r & 15, cc = c & 31, ob = rr * 64 + cc * 2; return st * 1024 + (ob ^ (((ob >> 9) & 1) << 5)); }
__host__ __device__ __forceinline__ void stage_rc(int b, int& R, int& C) { const int st = b / 1024, sb = b % 1024, swz = sb ^ (((sb >> 9) & 1) << 5); R = (st >> 1) * 16 + swz / 64; C = (st & 1) * 32 + (swz % 64) / 2; }
__host__ __device__ __forceinline__ int perm32(int rho) { const int n = rho >> 4, i = rho & 15; return 8 * (i >> 2) + 4 * n + (i & 3); }

struct Unit { int pm, pn; };
struct Gemm { const bf16_t* A; const bf16_t* Bt; int M, N, K; };

struct StaticOrder {
    int nM, nN, nwg, G, c;
    __host__ __device__ void init(int M, int N, int G_, int c_) { nM = M / BM; nN = N / BM; nwg = nM * nN; G = G_; c = c_; }
    __host__ __device__ bool next(int i, Unit& u) const {
        const long L = (long)i * G + c; if (L >= nwg) return false;
        int wgid = (int)L; { const int q = nwg / NXCD, r = nwg % NXCD, xcd = wgid % NXCD, off = wgid / NXCD; wgid = (xcd < r ? xcd * (q + 1) : r * (q + 1) + (xcd - r) * q) + off; }
        const int nig = WGM * nN, gid = wgid / nig, fm = gid * WGM, gsz = (nM - fm) < WGM ? (nM - fm) : WGM;
        u.pm = fm + ((wgid % nig) % gsz); u.pn = (wgid % nig) / gsz; return true;
    }
    __device__ __forceinline__ void a_ready(const Unit&) const {}
    __device__ __forceinline__ void done(const Unit&) const {}
};


__device__ __forceinline__ unsigned cvt_pk_bf16(float lo, float hi) { unsigned r; asm volatile("v_cvt_pk_bf16_f32 %0, %1, %2" : "=v"(r) : "v"(lo), "v"(hi)); return r; }
typedef unsigned u32x2 __attribute__((ext_vector_type(2)));

template <int RELU2> struct EpiScale {
    static constexpr bool PERM = false, AFTER_DRAIN = false;
    bf16_t* O; int ldc; const float* rsq;
    __device__ __forceinline__ void operator()(const f32x4 (&acc)[2][2][4][2], const Unit& u, int wr, int wc, int fr, int fq) const {
        const int col0 = u.pn * BM + wc * 32 + 4 * fq;
#pragma unroll
        for (int ai = 0; ai < 2; ++ai)
#pragma unroll
            for (int m = 0; m < 4; ++m) {
                const int row = u.pm * BM + ai * HALF + wr * 64 + m * 16 + fr;
                const float s = rsqrtf(rsq[row] * (1.0f / 1024.0f) + 1e-6f);
                bf16_t* rowp = O + (size_t)row * ldc + col0;
#pragma unroll
                for (int bj = 0; bj < 2; ++bj)
#pragma unroll
                    for (int n = 0; n < 2; ++n) {
                        f32x4 v = acc[ai][bj][m][n] * s;
                        if (RELU2) { v.x = fmaxf(v.x, 0.f); v.y = fmaxf(v.y, 0.f); v.z = fmaxf(v.z, 0.f); v.w = fmaxf(v.w, 0.f); v = v * v; }
                        u32x2 w; w.x = cvt_pk_bf16(v.x, v.y); w.y = cvt_pk_bf16(v.z, v.w);
                        *(u32x2*)(rowp + bj * HALF + n * 16) = w;
                    }
            }
    }
};

struct EpiResid {
    static constexpr bool PERM = false, AFTER_DRAIN = false;
    const float* Rp; const float* Rs;
    float* X; bf16_t* XB; float* rsq; int Mv;
    __device__ __forceinline__ void operator()(const f32x4 (&acc)[2][2][4][2], const Unit& u, int wr, int wc, int fr, int fq) const {
        const int col0 = u.pn * BM + wc * 32 + 4 * fq;
#pragma unroll
        for (int ai = 0; ai < 2; ++ai)
#pragma unroll
            for (int m = 0; m < 4; ++m) {
                const int row = u.pm * BM + ai * HALF + wr * 64 + m * 16 + fr;
                const bool valid = row < Mv;
                const float* rrow = (row < 16384) ? (Rp + (size_t)row * 1024) : (Rs + (size_t)(row - 16384) * 1024);
                float ss = 0.f;
#pragma unroll
                for (int bj = 0; bj < 2; ++bj)
#pragma unroll
                    for (int n = 0; n < 2; ++n) {
                        const int col = col0 + bj * HALF + n * 16;
                        f32x4 x = (f32x4){0.f, 0.f, 0.f, 0.f};
                        if (valid) {
                            x = *(const f32x4*)(rrow + col) + acc[ai][bj][m][n];
                            *(f32x4*)(X + (size_t)row * 1024 + col) = x;
                            ss += (x.x * x.x + x.y * x.y) + (x.z * x.z + x.w * x.w);
                        }
                        u32x2 w; w.x = cvt_pk_bf16(x.x, x.y); w.y = cvt_pk_bf16(x.z, x.w);
                        *(u32x2*)(XB + (size_t)row * 1024 + col) = w;
                    }
                ss += __shfl_xor(ss, 16); ss += __shfl_xor(ss, 32);
                if (fq == 0 && valid) unsafeAtomicAdd(rsq + row, ss);
            }
    }
};

template <class Epi, class Sched, bool ALIGN_EPI = false, bool SP2 = false>
__device__ __forceinline__ void gemm_phase(PG8_LAS unsigned char* lds, const Gemm g, const Sched& S, const Epi& E) {
    const int tid = threadIdx.x, wid = __builtin_amdgcn_readfirstlane(tid >> 6), lane = tid & 63, wr = wid >> 2, wc = wid & 3, fr = lane & 15, fq = lane >> 4;
    const int K = g.K, nt = K / BK;
    unsigned voffA[2], voffB[2];
#pragma unroll
    for (int i = 0; i < 2; ++i) { int R, C; stage_rc(tid * 16 + i * 8192, R, C); const int Rb = Epi::PERM ? ((R & ~31) + perm32(R & 31)) : R;
        voffA[i] = (unsigned)(R * K + C) * 2u; voffB[i] = (unsigned)(Rb * K + C) * 2u; }
    const size_t kstep = (size_t)(BK * 2);
    const size_t hstep = (size_t)HALF * K * 2;
    const size_t tstep = 2 * hstep;
    const unsigned ldsw = (unsigned)wid * 1024u;
    const int aoff = lds_byte(wr * 64 + fr, fq * 8), boff = lds_byte(wc * 32 + fr, fq * 8);
#define PG8_SA(b, h) (((b) * 2 + (h)) * HTB)
#define PG8_SB(b, h) ((4 + (b) * 2 + (h)) * HTB)
#define PG8_STAGE(bufoff, gbase, voff) do { _Pragma("unroll") for (int _i = 0; _i < 2; ++_i) \
        __builtin_amdgcn_global_load_lds((const unsigned*)((const char*)(gbase) + (voff)[_i]), (PG8_LAS unsigned*)(lds + (bufoff) + ldsw + _i * 8192), 16, 0, 0); } while (0)
#define PG8_LDA(dst, b, h) do { _Pragma("unroll") for (int m = 0; m < 4; ++m) _Pragma("unroll") for (int k = 0; k < 2; ++k) dst[m][k] = *(const PG8_LAS bf16x8*)(lds + PG8_SA(b, h) + aoff + m * 2048 + k * 1024); } while (0)
#define PG8_LDB(dst, b, h) do { _Pragma("unroll") for (int n = 0; n < 2; ++n) _Pragma("unroll") for (int k = 0; k < 2; ++k) dst[n][k] = *(const PG8_LAS bf16x8*)(lds + PG8_SB(b, h) + boff + n * 2048 + k * 1024); } while (0)
#define PG8_MMA(ai, bj, At, Bt) do { __builtin_amdgcn_s_setprio(1); _Pragma("unroll") for (int m = 0; m < 4; ++m) _Pragma("unroll") for (int n = 0; n < 2; ++n) _Pragma("unroll") for (int k = 0; k < 2; ++k) \
        acc[ai][bj][m][n] = __builtin_amdgcn_mfma_f32_16x16x32_bf16(Bt[n][k], At[m][k], acc[ai][bj][m][n], 0, 0, 0); __builtin_amdgcn_s_setprio(0); } while (0)
#define PG8_WAIT_V(n) asm volatile("s_waitcnt vmcnt(" #n ")" ::: "memory")
#define PG8_WAIT_L(n) asm volatile("s_waitcnt lgkmcnt(" #n ")" ::: "memory")
#define PG8_BAR __builtin_amdgcn_s_barrier()
#define PG8_SCHED __builtin_amdgcn_sched_barrier(0)
    Unit cur, nxt; int ui = 0;
    if (!S.next(0, cur)) return;
    f32x4 acc[2][2][4][2];
#pragma unroll
    for (int a = 0; a < 2; ++a)
#pragma unroll
        for (int b = 0; b < 2; ++b)
#pragma unroll
            for (int m = 0; m < 4; ++m)
#pragma unroll
                for (int n = 0; n < 2; ++n) acc[a][b][m][n] = (f32x4){0.f, 0.f, 0.f, 0.f};
    bf16x8 At[4][2], B0[2][2], B1[2][2];
    const char* cA = (const char*)g.A + (size_t)cur.pm * tstep; const char* cB = (const char*)g.Bt + (size_t)cur.pn * tstep;
    S.a_ready(cur);
    if constexpr (SP2) {
        PG8_STAGE(PG8_SB(0, 0), cB, voffB); PG8_STAGE(PG8_SB(0, 1), cB + hstep, voffB); PG8_STAGE(PG8_SA(0, 0), cA, voffA); PG8_STAGE(PG8_SA(0, 1), cA + hstep, voffA);
        if (wr == 1) PG8_BAR;
        PG8_WAIT_V(2); PG8_BAR;
        PG8_STAGE(PG8_SB(1, 0), cB + kstep, voffB); PG8_STAGE(PG8_SA(1, 0), cA + kstep, voffA); PG8_STAGE(PG8_SB(1, 1), cB + hstep + kstep, voffB);
        PG8_WAIT_V(6); PG8_BAR;
    } else {
        PG8_STAGE(PG8_SB(0, 0), cB, voffB); PG8_STAGE(PG8_SA(0, 0), cA, voffA); PG8_STAGE(PG8_SB(0, 1), cB + hstep, voffB); PG8_STAGE(PG8_SA(0, 1), cA + hstep, voffA);
        if (wr == 1) PG8_BAR;
        PG8_WAIT_V(4); PG8_BAR;
        PG8_STAGE(PG8_SB(1, 0), cB + kstep, voffB); PG8_STAGE(PG8_SA(1, 0), cA + kstep, voffA); PG8_STAGE(PG8_SB(1, 1), cB + hstep + kstep, voffB);
        PG8_WAIT_V(6); PG8_BAR;
    }
    for (;;) {
        const bool has_next = S.next(ui + 1, nxt);
        const char* nA = has_next ? (const char*)g.A + (size_t)nxt.pm * tstep : cA; const char* nB = has_next ? (const char*)g.Bt + (size_t)nxt.pn * tstep : cB;
        for (int t = 0; t < nt; t += 2) {
            const bool last = (t == nt - 2);
            const char* a1 = cA + (size_t)(t + 1) * kstep;
            const char* a2 = last ? nA : cA + (size_t)(t + 2) * kstep; const char* b2 = last ? nB : cB + (size_t)(t + 2) * kstep;
            const char* a3 = a2 + kstep; const char* b3 = b2 + kstep;
            if (last && has_next) S.a_ready(nxt);
            if constexpr (SP2) {
            PG8_LDB(B0, 0, 0); PG8_LDB(B1, 0, 1); PG8_SCHED; PG8_LDA(At, 0, 0); PG8_STAGE(PG8_SA(1, 1), a1 + hstep, voffA);
            PG8_WAIT_V(8); PG8_WAIT_L(0); PG8_BAR; PG8_MMA(0, 0, At, B0); PG8_MMA(0, 1, At, B1); PG8_BAR; PG8_SCHED;
            PG8_LDA(At, 0, 1); PG8_STAGE(PG8_SB(0, 0), b2, voffB); PG8_STAGE(PG8_SB(0, 1), b2 + hstep, voffB); PG8_STAGE(PG8_SA(0, 0), a2, voffA);
            PG8_WAIT_V(8); PG8_WAIT_L(0); PG8_BAR; PG8_MMA(1, 0, At, B0); PG8_MMA(1, 1, At, B1); PG8_BAR; PG8_SCHED;
            PG8_LDB(B0, 1, 0); PG8_LDB(B1, 1, 1); PG8_SCHED; PG8_LDA(At, 1, 0); PG8_STAGE(PG8_SA(0, 1), a2 + hstep, voffA);
            PG8_WAIT_V(8); PG8_WAIT_L(0); PG8_BAR; PG8_MMA(0, 0, At, B0); PG8_MMA(0, 1, At, B1); PG8_BAR; PG8_SCHED;
            PG8_LDA(At, 1, 1); PG8_STAGE(PG8_SB(1, 0), b3, voffB); PG8_STAGE(PG8_SB(1, 1), b3 + hstep, voffB); PG8_STAGE(PG8_SA(1, 0), a3, voffA);
            PG8_WAIT_V(8); PG8_WAIT_L(0); PG8_BAR; PG8_MMA(1, 0, At, B0); PG8_MMA(1, 1, At, B1); PG8_BAR; PG8_SCHED;
            } else {
            PG8_LDB(B0, 0, 0); PG8_SCHED; PG8_LDA(At, 0, 0); PG8_STAGE(PG8_SA(1, 1), a1 + hstep, voffA);
            PG8_WAIT_L(8); PG8_BAR; PG8_WAIT_L(0); PG8_MMA(0, 0, At, B0); PG8_BAR; PG8_SCHED;
            PG8_LDB(B1, 0, 1); PG8_STAGE(PG8_SB(0, 0), b2, voffB);
            PG8_BAR; PG8_WAIT_L(0); PG8_MMA(0, 1, At, B1); PG8_BAR;
            PG8_LDA(At, 0, 1); PG8_STAGE(PG8_SA(0, 0), a2, voffA);
            PG8_BAR; PG8_WAIT_L(0); PG8_MMA(1, 0, At, B0); PG8_BAR; PG8_SCHED;
            PG8_STAGE(PG8_SB(0, 1), b2 + hstep, voffB);
            PG8_WAIT_V(6); PG8_BAR; PG8_MMA(1, 1, At, B1); PG8_BAR;
            PG8_LDB(B0, 1, 0); PG8_SCHED; PG8_LDA(At, 1, 0); PG8_STAGE(PG8_SA(0, 1), a2 + hstep, voffA);
            PG8_WAIT_L(8); PG8_BAR; PG8_WAIT_L(0); PG8_MMA(0, 0, At, B0); PG8_BAR; PG8_SCHED;
            PG8_LDB(B1, 1, 1); PG8_STAGE(PG8_SB(1, 0), b3, voffB);
            PG8_BAR; PG8_WAIT_L(0); PG8_MMA(0, 1, At, B1); PG8_BAR;
            PG8_LDA(At, 1, 1); PG8_STAGE(PG8_SA(1, 0), a3, voffA);
            PG8_BAR; PG8_WAIT_L(0); PG8_MMA(1, 0, At, B0); PG8_BAR; PG8_SCHED;
            PG8_STAGE(PG8_SB(1, 1), b3 + hstep, voffB);
            PG8_WAIT_V(6); PG8_BAR; PG8_MMA(1, 1, At, B1); PG8_BAR;
            }
        }
        if constexpr (ALIGN_EPI) { if (wr == 0) PG8_BAR; }
        if constexpr (!Epi::AFTER_DRAIN) { E(acc, cur, wr, wc, fr, fq); S.done(cur); }
        if (!has_next) break;
#pragma unroll
        for (int a = 0; a < 2; ++a)
#pragma unroll
            for (int b = 0; b < 2; ++b)
#pragma unroll
                for (int m = 0; m < 4; ++m)
#pragma unroll
                    for (int n = 0; n < 2; ++n) acc[a][b][m][n] = (f32x4){0.f, 0.f, 0.f, 0.f};
        cur = nxt; cA = nA; cB = nB; ++ui;
        if constexpr (ALIGN_EPI) { if (wr == 1) PG8_BAR; }
    }
    PG8_WAIT_V(0);
    if constexpr (!ALIGN_EPI) { if (wr == 0) PG8_BAR; }
    PG8_BAR;
    if constexpr (Epi::AFTER_DRAIN) { E.fused(acc, cur, wr, wc, fr, fq, lds, wid, lane); S.done(cur); }
#undef PG8_SA
#undef PG8_SB
#undef PG8_STAGE
#undef PG8_LDA
#undef PG8_LDB
#undef PG8_MMA
#undef PG8_WAIT_V
#undef PG8_WAIT_L
#undef PG8_BAR
#undef PG8_SCHED
}
}

#define GAS __attribute__((address_space(1)))
#define LAS __attribute__((address_space(3)))
typedef unsigned short bf16;
typedef unsigned v4u __attribute__((ext_vector_type(4)));
typedef unsigned v2u __attribute__((ext_vector_type(2)));
typedef float f32x4 __attribute__((ext_vector_type(4)));
typedef float f32x2 __attribute__((ext_vector_type(2)));
typedef float f32x16 __attribute__((ext_vector_type(16)));
typedef short bf16x8 __attribute__((ext_vector_type(8)));
typedef GAS unsigned gu32;

constexpr int NWAVES = 8, NTHR = 512;
constexpr int D = 1024, T = 4096, NB = 4, MP = NB * T, SB = 32, ST = 4, MS = SB * ST, M = MP + MS, MPAD = 16640;
constexpr int EC = 5120, ECR = 4896, AQKV = 2304, BCOLS = 2592, CC = 4096, FF = 4096, BW = 768;
constexpr int LORA = 288;
constexpr float EPS = 1e-6f, LNX_EPS = 64e-5f, LOG2E = 1.4426950408889634f;
constexpr float QSCALE2 = 0.125f * LOG2E;
constexpr int BT_LD = 132;

constexpr size_t O_YP = 0, O_YS = (size_t)MP * D, O_PA0 = (size_t)M * D;
constexpr size_t O_PA1 = O_PA0 + (size_t)4 * 128 * 512, O_PA2 = O_PA1 + (size_t)4 * 512 * 512, O_PSH = O_PA2 + (size_t)4 * 2048 * 512;
constexpr size_t O_PWKV = O_PSH + (size_t)4 * BCOLS, O_PC = O_PWKV + (size_t)4 * 12 * 64 * 64, O_SA0 = O_PC + (size_t)4 * 8 * 128 * 128;
constexpr size_t O_SA1 = O_SA0 + (size_t)32 * 4 * 512, O_SA2 = O_SA1 + (size_t)32 * 4 * 512, O_SSH = O_SA2 + (size_t)32 * 4 * 512;
constexpr size_t O_SWKV = O_SSH + (size_t)32 * BCOLS, O_SC = O_SWKV + (size_t)32 * 12 * 64 * 64, O_END = O_SC + (size_t)32 * 8 * 128 * 128;
static_assert(O_END == 29191296, "output size");

constexpr size_t MiB = 1u << 20;
constexpr size_t WS_CTL = 0, CTL_ZERO_BYTES = 1 * MiB;
constexpr int CW_BAR = 4096;
constexpr size_t RSQ_OFF = 65536;
constexpr size_t WS_TAB = 1 * MiB;
constexpr size_t WS_WIN0 = 2 * MiB;
constexpr size_t WS_WOUT0 = WS_WIN0 + (size_t)EC * D * 2;
constexpr size_t WS_WUP0 = WS_WOUT0 + (size_t)D * D * 2;
constexpr size_t WS_WDN0 = WS_WUP0 + (size_t)FF * D * 2;
constexpr size_t WS_WCIN = WS_WDN0 + (size_t)FF * D * 2;
constexpr size_t WS_WCOUT = WS_WCIN + (size_t)CC * D * 2;
constexpr size_t WS_WUP1 = WS_WCOUT + (size_t)D * D * 2;
constexpr size_t WS_WDN1 = WS_WUP1 + (size_t)FF * D * 2;
constexpr size_t WS_BUF0 = WS_WDN1 + (size_t)FF * D * 2;
constexpr size_t WS_BUF1 = WS_BUF0 + (size_t)MPAD * D * 2;
constexpr size_t WS_ATTO = WS_BUF1 + (size_t)MPAD * D * 2;
constexpr size_t WS_LSE = WS_ATTO + (size_t)3 * M * 256 * 2;
constexpr size_t WS_SQ = WS_LSE + (size_t)3 * M * 4 * 4;
constexpr size_t WS_A = ((WS_SQ + (size_t)MS * 3 * 1024 * 4 + 255) / 256) * 256;
constexpr size_t WS_B = WS_A + (size_t)MPAD * EC * 2;
constexpr int NPREP = 48 * T + 384 * ST;
constexpr size_t WS_END = WS_B + (size_t)NPREP * 1024;
constexpr size_t WS_QE = WS_B, WS_KE = WS_QE + (size_t)MP * D * 2, WS_KET = WS_KE + (size_t)MP * D * 2, WS_VT = WS_KET + (size_t)MP * D * 2, WS_EBL = WS_VT + (size_t)MP * D * 2;
static_assert(WS_EBL + (size_t)(MP / 16) * D * 4 <= WS_END, "region B");

constexpr int RING_BYTES = 131072, LDSCTL_OFF = RING_BYTES, MISC_OFF = LDSCTL_OFF + 320, BT_OFF = 135168, LDS_BYTES = 147456;
static_assert(BT_OFF + 12 * BT_LD * 4 <= LDS_BYTES && MISC_OFF + 128 <= BT_OFF, "LDS map");

#define RLX_AGENT __ATOMIC_RELAXED, __HIP_MEMORY_SCOPE_AGENT
#define LDS_WAIT() asm volatile("s_waitcnt lgkmcnt(0)" ::: "memory")
#define VM_WAIT() asm volatile("s_waitcnt vmcnt(0)" ::: "memory")
__device__ __forceinline__ unsigned f2bf(float f) { unsigned u = __builtin_bit_cast(unsigned, f); return (u + 0x7fffu + ((u >> 16) & 1u)) >> 16; }
__device__ __forceinline__ unsigned pk2(float lo, float hi) { return f2bf(lo) | (f2bf(hi) << 16); }
__device__ __forceinline__ float bf2f(unsigned short b) { return __uint_as_float((unsigned)b << 16); }
__device__ __forceinline__ float bflo(unsigned w) { return __uint_as_float(w << 16); }
__device__ __forceinline__ float bfhi(unsigned w) { return __uint_as_float(w & 0xffff0000u); }
__device__ __forceinline__ float wave_sum(float v) {
#pragma unroll
    for (int o = 1; o < 64; o <<= 1) v += __shfl_xor(v, o);
    return v;
}
__device__ __forceinline__ float wave_max(float v) {
#pragma unroll
    for (int o = 1; o < 64; o <<= 1) v = fmaxf(v, __shfl_xor(v, o));
    return v;
}
__device__ __forceinline__ float sigmoidf_(float x) { return 1.0f / (1.0f + __expf(-x)); }
__device__ __forceinline__ float siluf_(float x) { return x / (1.0f + __expf(-x)); }

#define XB_TMO      128
#define XB_XCNT(j)  (256  + 64 * (j))
#define XB_XSUB(j)  (1280 + 64 * (j))
#define XB_XGEN(j)  (2304 + 64 * (j))
#define XB_TOP      3328
#define XB_TOPGEN   3392
#define XCD_BAR_WORDS 3456
#define XB_SPIN_CAP (1u << 18)

__device__ __forceinline__ unsigned xb_ld(unsigned* p)              { return __hip_atomic_load(p, __ATOMIC_RELAXED, __HIP_MEMORY_SCOPE_AGENT); }
__device__ __forceinline__ unsigned xb_add(unsigned* p, unsigned v) { return __hip_atomic_fetch_add(p, v, __ATOMIC_RELAXED, __HIP_MEMORY_SCOPE_AGENT); }
__device__ __forceinline__ unsigned xb_xcc_id() { return (unsigned)__builtin_amdgcn_s_getreg((3 << 11) | 20) & 0xFu; }
#define XB_SPIN(cond, bar) do { unsigned _sp = 0; while (cond) { __builtin_amdgcn_s_sleep(1); \
    if ((++_sp & 255u) == 0u) { if (xb_ld(&(bar)[XB_TMO])) break; if (_sp > XB_SPIN_CAP) { atomicAdd(&(bar)[XB_TMO], 1u); break; } } } } while (0)

struct XcdBarrier {
    unsigned* bar; unsigned x;
    volatile LAS unsigned* st;
};

__device__ __forceinline__ XcdBarrier xcd_barrier_post(unsigned* bar, volatile LAS unsigned* st) {
    XcdBarrier b; b.bar = bar; b.x = xb_xcc_id(); b.st = st;
    if (threadIdx.x == 0) (void)xb_add(&bar[XB_XCNT(b.x)], 1u);
    return b;
}
__device__ __forceinline__ void xcd_barrier_complete(unsigned* bar, unsigned x, unsigned& nloc, unsigned& nx) {
    const unsigned G = gridDim.x * gridDim.y * gridDim.z;
    unsigned sum, cnt, mine, sp = 0u;
    for (;;) {
        sum = 0u; cnt = 0u; mine = 0u;
#pragma unroll
        for (unsigned j = 0; j < 16; ++j) { const unsigned c = xb_ld(&bar[XB_XCNT(j)]); sum += c; cnt += (c > 0u) ? 1u : 0u; mine = (j == x) ? c : mine; }
        if (sum == G) break;
        __builtin_amdgcn_s_sleep(1);
        if ((++sp & 255u) == 0u) { if (xb_ld(&bar[XB_TMO])) break; if (sp > XB_SPIN_CAP) { atomicAdd(&bar[XB_TMO], 1u); break; } }
    }
    nloc = mine > 0u ? mine : 1u; nx = cnt > 0u ? cnt : 1u;
}

__device__ __forceinline__ void xcd_barrier(const XcdBarrier& b) {
    asm volatile("s_waitcnt vmcnt(0)" ::: "memory");
    __syncthreads();
    if (threadIdx.x == 0) {
        unsigned* bar = b.bar;
        __builtin_amdgcn_s_waitcnt(0);
        unsigned nloc = b.st[0], nx = b.st[1];
        if (nloc == 0u) { xcd_barrier_complete(bar, b.x, nloc, nx); b.st[0] = nloc; b.st[1] = nx; }
        const unsigned old = xb_add(&bar[XB_XSUB(b.x)], 1u);
        const unsigned gen = old / nloc;
        if (old + 1u == (gen + 1u) * nloc) {
            __builtin_amdgcn_fence(__ATOMIC_RELEASE, "agent");
            asm volatile("s_waitcnt vmcnt(0)" ::: "memory");
            const unsigned og = xb_add(&bar[XB_TOP], 1u);
            const unsigned tg = og / nx;
            if (og + 1u == (tg + 1u) * nx) xb_add(&bar[XB_TOPGEN], 1u);
            else XB_SPIN(xb_ld(&bar[XB_TOPGEN]) == tg, bar);
            __builtin_amdgcn_fence(__ATOMIC_ACQUIRE, "agent");
            xb_add(&bar[XB_XGEN(b.x)], 1u);
            asm volatile("s_waitcnt vmcnt(0)" ::: "memory");
        } else {
            XB_SPIN(xb_ld(&bar[XB_XGEN(b.x)]) == gen, bar);
            __builtin_amdgcn_fence(__ATOMIC_ACQUIRE, "agent");
            asm volatile("s_waitcnt vmcnt(0)" ::: "memory");
        }
    }
    __syncthreads();
}

struct Args { const float* in[31]; float* out; unsigned char* ws; int ph_lo, ph_hi; };
enum { I_XP = 0, I_XS, I_CA0, I_CA1, I_CA2, I_SSH, I_SWKV, I_SC, I_RELB, I_NMIX, I_NMLP, I_NFIN, I_EWIN, I_EMU, I_EW0, I_EW2, I_EA0, I_EA2, I_EG2,
       I_EKK, I_EKA, I_ERK, I_ELNW, I_ELNB, I_EWOUT, I_CWIN, I_CLB, I_CNORM, I_CWOUT, I_MUP, I_MDN };

struct Frame {
    LAS unsigned char* lds;
    int tid, lane, wave, bid, gw;
};
constexpr int NGW = 256 * NWAVES, NGT = 256 * NTHR;

__device__ __forceinline__ void p0_transpose_item(const float* W, int K, int N, bf16* WT, const float* gain, LAS float* scr, int item, int lane) {
    const int nblk = N / 32, kb = item / nblk, nb = item % nblk, k0 = 64 * kb, n0 = 32 * nb;
#pragma unroll 8
    for (int i = 0; i < 32; ++i) { const int kk = 2 * i + (lane >> 5); const float gv = gain ? gain[k0 + kk] : 1.0f;
        scr[kk * 33 + (lane & 31)] = W[(size_t)(k0 + kk) * N + n0 + (lane & 31)] * gv; }
    LDS_WAIT(); asm volatile("" ::: "memory");
    const int c = lane & 7;
#pragma unroll
    for (int j = 0; j < 4; ++j) { const int n = (lane >> 3) + 8 * j; const LAS float* s = scr + (8 * c) * 33 + n;
        v4u o; o.x = pk2(s[0 * 33], s[1 * 33]); o.y = pk2(s[2 * 33], s[3 * 33]); o.z = pk2(s[4 * 33], s[5 * 33]); o.w = pk2(s[6 * 33], s[7 * 33]);
        *(GAS v4u*)(WT + (size_t)(n0 + n) * K + k0 + 8 * c) = o; }
    LDS_WAIT(); asm volatile("" ::: "memory");
}

__device__ __forceinline__ int t5_bucket(int dist) {
    if (dist < 16) return dist;
    const float d = (float)dist;
    int large = 16 + (int)(logf(d * (1.0f / 16.0f)) / 4.852030263919617f * 16.0f);
    return large < 31 ? large : 31;
}

__device__ __forceinline__ void p0_prologue(const Args& a, Frame& F) {
    unsigned char* ws = a.ws;
    LAS float* scr = (LAS float*)(F.lds + F.wave * 16384);
    {
        constexpr int I_IN = 16 * (ECR / 32), I_SQ = 16 * 32, I_UP = 16 * 128, I_DN = 64 * 32;
        constexpr int NITEMS = I_IN + I_SQ + I_UP + I_DN + I_UP + I_SQ + I_UP + I_DN;
        for (int it = F.gw; it < NITEMS; it += NGW) {
            int r = it;
            if (r < I_IN) { p0_transpose_item(a.in[I_EWIN], D, ECR, (bf16*)(ws + WS_WIN0), a.in[I_NMIX], scr, r, F.lane); continue; } r -= I_IN;
            if (r < I_SQ) { p0_transpose_item(a.in[I_EWOUT], D, D, (bf16*)(ws + WS_WOUT0), nullptr, scr, r, F.lane); continue; } r -= I_SQ;
            if (r < I_UP) { p0_transpose_item(a.in[I_MUP], D, FF, (bf16*)(ws + WS_WUP0), a.in[I_NMLP], scr, r, F.lane); continue; } r -= I_UP;
            if (r < I_DN) { p0_transpose_item(a.in[I_MDN], FF, D, (bf16*)(ws + WS_WDN0), nullptr, scr, r, F.lane); continue; } r -= I_DN;
            if (r < I_UP) { p0_transpose_item(a.in[I_CWIN], D, CC, (bf16*)(ws + WS_WCIN), a.in[I_NMIX] + D, scr, r, F.lane); continue; } r -= I_UP;
            if (r < I_SQ) { p0_transpose_item(a.in[I_CWOUT], D, D, (bf16*)(ws + WS_WCOUT), nullptr, scr, r, F.lane); continue; } r -= I_SQ;
            if (r < I_UP) { p0_transpose_item(a.in[I_MUP] + (size_t)D * FF, D, FF, (bf16*)(ws + WS_WUP1), a.in[I_NMLP] + D, scr, r, F.lane); continue; } r -= I_UP;
            p0_transpose_item(a.in[I_MDN] + (size_t)FF * D, FF, D, (bf16*)(ws + WS_WDN1), nullptr, scr, r, F.lane);
        }
    }
    const int gt = F.bid * NTHR + F.tid;
    { v4u* z = (v4u*)(ws + WS_WIN0 + (size_t)ECR * D * 2); const int n = (EC - ECR) * D * 2 / 16;
      for (int i = gt; i < n; i += NGT) z[i] = (v4u){0u, 0u, 0u, 0u}; }
    { float* BT = (float*)(ws + WS_TAB); const float* rb = a.in[I_RELB];
      for (int i = gt; i < 12 * 129; i += NGT) { const int hd = i / 129, j = i % 129, g = hd >> 2; const int dist = j << (2 * g);
          BT[hd * BT_LD + j] = rb[t5_bucket(dist) * 12 + hd] * LOG2E; }
      float* LB = (float*)(ws + WS_TAB + 8192); const float* lr = a.in[I_CLB];
      for (int i = gt; i < 1024; i += NGT) LB[i] = 1.0f / (1.0f + expf(lr[i] - lr[1024 + i]));
      bf16* LW = (bf16*)(ws + WS_TAB + 16384); const float* w2 = a.in[I_EW2]; const float* a2 = a.in[I_EA2]; const float* g2 = a.in[I_EG2];
      for (int i = gt; i < BW * LORA; i += NGT) { const int ch = i / LORA, j = i % LORA;
          const float v = j < 64 ? w2[j * BW + ch] : (j < 128 ? a2[(j - 64) * BW + ch] : g2[(j - 128) * BW + ch]);
          LW[i] = (bf16)f2bf(v); } }
    { bf16* B0 = (bf16*)(ws + WS_BUF0); bf16* B1 = (bf16*)(ws + WS_BUF1); float* rsq0 = (float*)(ws + WS_CTL + RSQ_OFF);
      for (int m = F.gw; m < MPAD; m += NGW) {
          unsigned long long* o8 = (unsigned long long*)(B0 + (size_t)m * D) + F.lane;
          if (m < M) {
              const float* xr = (m < MP) ? (a.in[I_XP] + (size_t)m * D) : (a.in[I_XS] + (size_t)(m - MP) * D);
              const f32x4* x4 = (const f32x4*)xr + F.lane; f32x4 v[4]; float s = 0.f;
#pragma unroll
              for (int j = 0; j < 4; ++j) { v[j] = x4[64 * j]; s += (v[j].x * v[j].x + v[j].y * v[j].y) + (v[j].z * v[j].z + v[j].w * v[j].w); }
              s = wave_sum(s);
#pragma unroll
              for (int j = 0; j < 4; ++j) o8[64 * j] = (unsigned long long)pk2(v[j].x, v[j].y) | ((unsigned long long)pk2(v[j].z, v[j].w) << 32);
              if (F.lane == 0) rsq0[m] = s;
          } else {
              unsigned long long* p8 = (unsigned long long*)(B1 + (size_t)m * D) + F.lane;
#pragma unroll
              for (int j = 0; j < 4; ++j) { o8[64 * j] = 0ull; p8[64 * j] = 0ull; }
          }
      } }
}

__device__ __forceinline__ f32x16 mfma32(bf16x8 a, bf16x8 b, f32x16 c) { return __builtin_amdgcn_mfma_f32_32x32x16_bf16(a, b, c, 0, 0, 0); }
__device__ __forceinline__ f32x4 mfma16(bf16x8 a, bf16x8 b, f32x4 c) { return __builtin_amdgcn_mfma_f32_16x16x32_bf16(a, b, c, 0, 0, 0); }

__device__ __forceinline__ void attn_task(const bf16* __restrict__ PROJ, const LAS float* bt, bf16* ATTO, float* LSE, int task, int lane) {
    const int ti = task & 127; int rest = task >> 7; const int hs = rest & 3; rest >>= 2; const int g = rest % 3; const int b = rest / 3;
    const int dsh = 2 * g, dil = 1 << dsh, tpr = (T >> dsh) >> 5;
    const int r = ti / tpr, s0 = (ti % tpr) * 32, hd = 4 * g + hs;
    const int q = lane & 31, hh = lane >> 5;
    const size_t rowbase = (size_t)b * T + r;
    const bf16* Qp = PROJ + (rowbase + (size_t)dil * (s0 + q)) * EC + hd * 64 + 8 * hh;
    bf16x8 qf[4];
#pragma unroll
    for (int ks = 0; ks < 4; ++ks) qf[ks] = *(const bf16x8*)(Qp + 16 * ks);
    f32x16 o0, o1;
#pragma unroll
    for (int i = 0; i < 16; ++i) { o0[i] = 0.f; o1[i] = 0.f; }
    float mrun = -1e30f, lrun = 0.f;
    const LAS float* btp = bt + hd * BT_LD;
    for (int kt = 4; kt >= 0; --kt) {
        const int kbase = s0 - 128 + 32 * kt;
        if (kbase + 31 < 0) break;
        int sk = kbase + q; sk = sk < 0 ? 0 : sk;
        const bf16* Kp = PROJ + (rowbase + (size_t)dil * sk) * EC + BW + hd * 64 + 8 * hh;
        bf16x8 kf[4];
#pragma unroll
        for (int ks = 0; ks < 4; ++ks) kf[ks] = *(const bf16x8*)(Kp + 16 * ks);
        bf16x8 vf[2][2];
#pragma unroll
        for (int s = 0; s < 2; ++s)
#pragma unroll
            for (int j = 0; j < 8; ++j) {
                int key = kbase + 16 * s + 8 * (j >> 2) + 4 * hh + (j & 3); key = key < 0 ? 0 : key;
                const bf16* vp = PROJ + (rowbase + (size_t)dil * key) * EC + 2 * BW + hd * 64 + q;
                vf[s][0][j] = (short)vp[0]; vf[s][1][j] = (short)vp[32];
            }
        f32x16 sacc;
#pragma unroll
        for (int i = 0; i < 16; ++i) sacc[i] = 0.f;
#pragma unroll
        for (int ks = 0; ks < 4; ++ks) sacc = mfma32(kf[ks], qf[ks], sacc);
        float x[16]; float tmax = -1e30f;
#pragma unroll
        for (int reg = 0; reg < 16; ++reg) {
            const int i = (reg & 3) + 8 * (reg >> 2) + 4 * hh;
            const int jj = q - i + 128 - 32 * kt;
            const bool valid = (jj >= 0) && (jj <= 128) && (kbase + i >= 0);
            const int jc = jj < 0 ? 0 : (jj > 128 ? 128 : jj);
            const float bv = btp[jc];
            x[reg] = valid ? (sacc[reg] * QSCALE2 + bv) : -1e30f;
            tmax = fmaxf(tmax, x[reg]);
        }
        tmax = fmaxf(tmax, __shfl_xor(tmax, 32));
        const float mnew = fmaxf(mrun, tmax);
        const float alpha = __builtin_amdgcn_exp2f(mrun - mnew);
        float psum = 0.f; float p[16];
#pragma unroll
        for (int reg = 0; reg < 16; ++reg) { p[reg] = __builtin_amdgcn_exp2f(x[reg] - mnew); psum += p[reg]; }
        psum += __shfl_xor(psum, 32);
        lrun = lrun * alpha + psum; mrun = mnew;
#pragma unroll
        for (int i = 0; i < 16; ++i) { o0[i] *= alpha; o1[i] *= alpha; }
        v4u pw0, pw1;
        pw0.x = pk2(p[0], p[1]); pw0.y = pk2(p[2], p[3]); pw0.z = pk2(p[4], p[5]); pw0.w = pk2(p[6], p[7]);
        pw1.x = pk2(p[8], p[9]); pw1.y = pk2(p[10], p[11]); pw1.z = pk2(p[12], p[13]); pw1.w = pk2(p[14], p[15]);
        const bf16x8 pf0 = __builtin_bit_cast(bf16x8, pw0), pf1 = __builtin_bit_cast(bf16x8, pw1);
        o0 = mfma32(vf[0][0], pf0, o0); o0 = mfma32(vf[1][0], pf1, o0);
        o1 = mfma32(vf[0][1], pf0, o1); o1 = mfma32(vf[1][1], pf1, o1);
    }
    const float inv = 1.0f / lrun;
    const size_t mq = rowbase + (size_t)dil * (s0 + q);
    bf16* op = ATTO + ((size_t)g * M + mq) * 256 + hs * 64 + 4 * hh;
#pragma unroll
    for (int rg = 0; rg < 4; ++rg) {
        v2u w0; w0.x = pk2(o0[4 * rg] * inv, o0[4 * rg + 1] * inv); w0.y = pk2(o0[4 * rg + 2] * inv, o0[4 * rg + 3] * inv);
        v2u w1; w1.x = pk2(o1[4 * rg] * inv, o1[4 * rg + 1] * inv); w1.y = pk2(o1[4 * rg + 2] * inv, o1[4 * rg + 3] * inv);
        *(v2u*)(op + 8 * rg) = w0; *(v2u*)(op + 32 + 8 * rg) = w1;
    }
    if (hh == 0) LSE[((size_t)g * M + mq) * 4 + hs] = mrun + __log2f(lrun);
}

__device__ __forceinline__ void sattn_task(const Args& a, const bf16* __restrict__ PROJ, const LAS float* bt, bf16* ATTO, float* LSE, LAS float* scr, int task, int lane) {
    const int bs = task / 12, hd = task % 12, g = hd >> 2, hs = hd & 3, dsh = 2 * g, dil = 1 << dsh, W = 128 << dsh;
    const float* cache = a.in[I_CA0 + g];
    const LAS float* btp = bt + hd * BT_LD;
    LAS float* qs = scr; LAS float* ps = scr + 256;
    const size_t m0 = (size_t)MP + bs * 4;
#pragma unroll
    for (int t = 0; t < 4; ++t) qs[t * 64 + lane] = bf2f(PROJ[(m0 + t) * EC + hd * 64 + lane]) * QSCALE2;
    LDS_WAIT(); asm volatile("" ::: "memory");
    for (int t = 0; t < 4; ++t) {
        float xv[3]; float mx = -1e30f;
#pragma unroll
        for (int ksl = 0; ksl < 3; ++ksl) {
            const int j = lane + 64 * ksl; float x = -1e30f;
            if (j <= 128) {
                const int rho = W + t - j * dil; float dot = 0.f;
                if (rho >= W) {
                    const bf16* kp = PROJ + (m0 + (rho - W)) * EC + BW + hd * 64;
                    for (int d = 0; d < 64; ++d) dot += bf2f(kp[d]) * qs[t * 64 + d];
                } else {
                    const float* kp = cache + (((size_t)bs * W + rho) * 2 + 0) * 256 + hs * 64;
                    for (int d4 = 0; d4 < 16; ++d4) { const f32x4 kv = *(const f32x4*)(kp + 4 * d4); const LAS float* qq = qs + t * 64 + 4 * d4;
                        dot += kv.x * qq[0] + kv.y * qq[1] + kv.z * qq[2] + kv.w * qq[3]; }
                }
                x = dot + btp[j];
            }
            xv[ksl] = x; mx = fmaxf(mx, x);
        }
        mx = wave_max(mx);
        float psum = 0.f;
#pragma unroll
        for (int ksl = 0; ksl < 3; ++ksl) { const int j = lane + 64 * ksl; const float p = (j <= 128) ? __builtin_amdgcn_exp2f(xv[ksl] - mx) : 0.f; psum += p; if (j <= 128) ps[j] = p; }
        psum = wave_sum(psum);
        LDS_WAIT(); asm volatile("" ::: "memory");
        float acc = 0.f;
        for (int j = 0; j <= 128; ++j) {
            const int rho = W + t - j * dil;
            const float v = (rho >= W) ? bf2f(PROJ[(m0 + (rho - W)) * EC + 2 * BW + hd * 64 + lane]) : cache[(((size_t)bs * W + rho) * 2 + 1) * 256 + hs * 64 + lane];
            acc += ps[j] * v;
        }
        ATTO[((size_t)g * M + m0 + t) * 256 + hs * 64 + lane] = (bf16)f2bf(acc / psum);
        if (lane == 0) LSE[((size_t)g * M + m0 + t) * 4 + hs] = mx + __log2f(psum);
        LDS_WAIT(); asm volatile("" ::: "memory");
    }
}

__device__ __forceinline__ void kv_copies(const bf16* __restrict__ PROJ, float* out, int gt) {
#pragma unroll
    for (int g = 0; g < 3; ++g) {
        const int Wp = 128 << (2 * g); const size_t off = g == 0 ? O_PA0 : (g == 1 ? O_PA1 : O_PA2);
        const int n = NB * Wp * 512;
        for (int i = gt; i < n; i += NGT) { const int d = i & 63, hs = (i >> 6) & 3, kv = (i >> 8) & 1, rr = i >> 9, ii = rr % Wp, b = rr / Wp;
            out[off + i] = bf2f(PROJ[((size_t)b * T + (T - Wp) + ii) * EC + (1 + kv) * BW + (4 * g + hs) * 64 + d]); }
        const size_t soff = g == 0 ? O_SA0 : (g == 1 ? O_SA1 : O_SA2);
        for (int i = gt; i < SB * ST * 512; i += NGT) { const int d = i & 63, hs = (i >> 6) & 3, kv = (i >> 8) & 1, rr = i >> 9;
            out[soff + i] = bf2f(PROJ[((size_t)MP + rr) * EC + (1 + kv) * BW + (4 * g + hs) * 64 + d]); }
    }
    for (int i = gt; i < NB * BCOLS; i += NGT) { const int b = i / BCOLS, c = i % BCOLS; out[O_PSH + i] = bf2f(PROJ[((size_t)b * T + T - 1) * EC + AQKV + c]); }
    for (int i = gt; i < SB * BCOLS; i += NGT) { const int b = i / BCOLS, c = i % BCOLS; out[O_SSH + i] = bf2f(PROJ[((size_t)MP + b * 4 + 3) * EC + AQKV + c]); }
}

__device__ __forceinline__ void xs8(const bf16* cur, const bf16* prv, const float* stp, const float* mu, int kind, int col, float* o) {
    const v4u c8 = *(const v4u*)(cur + col);
    float c[8] = {bflo(c8.x), bfhi(c8.x), bflo(c8.y), bfhi(c8.y), bflo(c8.z), bfhi(c8.z), bflo(c8.w), bfhi(c8.w)};
    float p[8];
    if (kind == 1) { const v4u p8 = *(const v4u*)(prv + col);
        p[0] = bflo(p8.x); p[1] = bfhi(p8.x); p[2] = bflo(p8.y); p[3] = bfhi(p8.y); p[4] = bflo(p8.z); p[5] = bfhi(p8.z); p[6] = bflo(p8.w); p[7] = bfhi(p8.w); }
    else if (kind == 2) { const f32x4 a0 = *(const f32x4*)(stp + col), a1 = *(const f32x4*)(stp + col + 4);
        p[0] = a0.x; p[1] = a0.y; p[2] = a0.z; p[3] = a0.w; p[4] = a1.x; p[5] = a1.y; p[6] = a1.z; p[7] = a1.w; }
    else {
#pragma unroll
        for (int i = 0; i < 8; ++i) p[i] = 0.f; }
    const f32x4 m0 = *(const f32x4*)(mu + col), m1 = *(const f32x4*)(mu + col + 4);
    const float mm[8] = {m0.x, m0.y, m0.z, m0.w, m1.x, m1.y, m1.z, m1.w};
#pragma unroll
    for (int i = 0; i < 8; ++i) o[i] = c[i] + (p[i] - c[i]) * mm[i];
}
__device__ __forceinline__ f32x4 xs4(const bf16* cur, const bf16* prv, const float* stp, const float* mu, int kind, int col) {
    const v2u c4 = *(const v2u*)(cur + col);
    const f32x4 c = (f32x4){bflo(c4.x), bfhi(c4.x), bflo(c4.y), bfhi(c4.y)};
    f32x4 p = (f32x4){0.f, 0.f, 0.f, 0.f};
    if (kind == 1) { const v2u p4 = *(const v2u*)(prv + col); p = (f32x4){bflo(p4.x), bfhi(p4.x), bflo(p4.y), bfhi(p4.y)}; }
    else if (kind == 2) p = *(const f32x4*)(stp + col);
    const f32x4 m = *(const f32x4*)(mu + col);
    return c + (p - c) * m;
}

__device__ __forceinline__ void prep_task(const Args& a, const bf16* __restrict__ PROJ, const bf16* __restrict__ LW, unsigned char* PREP, int grp, int h, int lane) {
    const int tok = lane & 15, g4 = lane >> 4;
    const int m = grp * 16 + tok;
    int kind, sb = 0; size_t entry;
    if (m < MP) { const int t = m & (T - 1), b = m >> 12; kind = (t == 0) ? 0 : 1; entry = (size_t)(b * 12 + h) * T + t; }
    else { const int s = m - MP, t = s & 3; sb = s >> 2; kind = (t == 0) ? 2 : 1; entry = (size_t)48 * T + (size_t)((sb * 12 + h) * 4 + t); }
    const bf16* cur = PROJ + (size_t)m * EC + AQKV;
    const bf16* prv = cur - EC;
    const float* stp = a.in[I_SSH] + (size_t)sb * BCOLS;
    const float* mu = a.in[I_EMU];
    bf16x8 af[9];
#pragma unroll
    for (int ks = 0; ks < 9; ++ks) {
        float v[8]; xs8(cur, prv, stp, mu, kind, 3 * BW + 32 * ks + 8 * g4, v);
#pragma unroll
        for (int i = 0; i < 8; ++i) {
            if (ks < 2) { const float e = __expf(2.0f * v[i]); v[i] = 1.0f - 2.0f / (e + 1.0f); }
            else if (ks >= 4) v[i] = sigmoidf_(v[i]);
        }
        v4u w; w.x = pk2(v[0], v[1]); w.y = pk2(v[2], v[3]); w.z = pk2(v[4], v[5]); w.w = pk2(v[6], v[7]);
        af[ks] = __builtin_bit_cast(bf16x8, w);
    }
    f32x4 accw[4], acca[4], accg[4], kr[4];
    float ssq = 0.f;
    const float* k_k = a.in[I_EKK];
#pragma unroll
    for (int nt = 0; nt < 4; ++nt) {
        const bf16* lwp = LW + (size_t)(h * 64 + 16 * nt + tok) * LORA + 8 * g4;
        f32x4 aw = (f32x4){0.f, 0.f, 0.f, 0.f}, aa = aw, ag = aw;
#pragma unroll
        for (int ks = 0; ks < 9; ++ks) { const bf16x8 bw = *(const bf16x8*)(lwp + 32 * ks);
            if (ks < 2) aw = mfma16(bw, af[ks], aw); else if (ks < 4) aa = mfma16(bw, af[ks], aa); else ag = mfma16(bw, af[ks], ag); }
        accw[nt] = aw; acca[nt] = aa; accg[nt] = ag;
        const int c4 = h * 64 + 16 * nt + 4 * g4;
        kr[nt] = xs4(cur, prv, stp, mu, kind, BW + c4);
        const f32x4 kkr = kr[nt] * *(const f32x4*)(k_k + c4);
        ssq += (kkr.x * kkr.x + kkr.y * kkr.y) + (kkr.z * kkr.z + kkr.w * kkr.w);
    }
    ssq += __shfl_xor(ssq, 16); ssq += __shfl_xor(ssq, 32);
    const float kinv = 1.0f / fmaxf(sqrtf(ssq), 1e-12f);
    unsigned char* E = PREP + entry * 1024;
#pragma unroll
    for (int nt = 0; nt < 4; ++nt) {
        const int c4 = h * 64 + 16 * nt + 4 * g4, cl = 16 * nt + 4 * g4;
        const f32x4 w0 = *(const f32x4*)(a.in[I_EW0] + c4), a0 = *(const f32x4*)(a.in[I_EA0] + c4), kkc = *(const f32x4*)(k_k + c4), kac = *(const f32x4*)(a.in[I_EKA] + c4);
        f32x4 dec, av, kk, kp, bb;
#pragma unroll
        for (int i = 0; i < 4; ++i) {
            const float z = -(w0[i] + accw[nt][i]);
            const float sp = fmaxf(z, 0.f) + __logf(1.0f + __expf(-fabsf(z)));
            const float w = -sp - 0.5f;
            dec[i] = __expf(-__expf(w));
            av[i] = sigmoidf_(a0[i] + acca[nt][i]);
            kk[i] = kr[nt][i] * kkc[i] * kinv;
            kp[i] = kr[nt][i] * (1.0f + (av[i] - 1.0f) * kac[i]);
            bb[i] = kk[i] * av[i];
        }
        const f32x4 rr4 = xs4(cur, prv, stp, mu, kind, c4), vr4 = xs4(cur, prv, stp, mu, kind, 2 * BW + c4);
        v2u w;
        w.x = pk2(rr4.x, rr4.y); w.y = pk2(rr4.z, rr4.w); *(v2u*)(E + 0 + 2 * cl) = w;
        w.x = pk2(kp.x, kp.y); w.y = pk2(kp.z, kp.w); *(v2u*)(E + 128 + 2 * cl) = w;
        w.x = pk2(vr4.x, vr4.y); w.y = pk2(vr4.z, vr4.w); *(v2u*)(E + 256 + 2 * cl) = w;
        w.x = pk2(kk.x, kk.y); w.y = pk2(kk.z, kk.w); *(v2u*)(E + 384 + 2 * cl) = w;
        w.x = pk2(bb.x, bb.y); w.y = pk2(bb.z, bb.w); *(v2u*)(E + 512 + 2 * cl) = w;
        w.x = pk2(accg[nt].x, accg[nt].y); w.y = pk2(accg[nt].z, accg[nt].w); *(v2u*)(E + 640 + 2 * cl) = w;
        *(f32x4*)(E + 768 + 4 * cl) = dec;
    }
}

__device__ __forceinline__ float row16_sum(float x) {
    x += __int_as_float(__builtin_amdgcn_mov_dpp(__float_as_int(x), 0x128, 0xf, 0xf, false));
    x += __int_as_float(__builtin_amdgcn_mov_dpp(__float_as_int(x), 0x124, 0xf, 0xf, false));
    x += __int_as_float(__builtin_amdgcn_mov_dpp(__float_as_int(x), 0x122, 0xf, 0xf, false));
    x += __int_as_float(__builtin_amdgcn_mov_dpp(__float_as_int(x), 0x121, 0xf, 0xf, false));
    return x;
}
__device__ __forceinline__ float wkv_step(f32x4& S, const f32x4 d, const f32x4 kk, const f32x4 bb, const f32x4 kp, const f32x4 r, const float v) {
    float p = S.x * kk.x; p = fmaf(S.y, kk.y, p); p = fmaf(S.z, kk.z, p); p = fmaf(S.w, kk.w, p);
    const float sa = -row16_sum(p);
    S.x = fmaf(sa, bb.x, fmaf(S.x, d.x, v * kp.x));
    S.y = fmaf(sa, bb.y, fmaf(S.y, d.y, v * kp.y));
    S.z = fmaf(sa, bb.z, fmaf(S.z, d.z, v * kp.z));
    S.w = fmaf(sa, bb.w, fmaf(S.w, d.w, v * kp.w));
    float y = S.x * r.x; y = fmaf(S.y, r.y, y); y = fmaf(S.z, r.z, y); y = fmaf(S.w, r.w, y);
    return row16_sum(y);
}
__device__ __forceinline__ f32x4 ld_bf4(const unsigned char* p) { const v2u w = *(const v2u*)p; return (f32x4){bflo(w.x), bfhi(w.x), bflo(w.y), bfhi(w.y)}; }

constexpr int WK_TCH = 32, WK_STEP_F = 336, WK_BUF_F = WK_TCH * WK_STEP_F, WK_YB_OFF = 2 * WK_BUF_F * 4;
constexpr int WK_NG = WK_TCH * 100;
__device__ __forceinline__ void wkv_stage(LAS float* L, const unsigned char* Eb, int c, int li, int rowq) {
    LAS float* buf = L + (c & 1) * WK_BUF_F; const unsigned char* Ec = Eb + (size_t)c * WK_TCH * 1024;
    v2u raw[13];
#pragma unroll
    for (int i = 0; i < 13; ++i) { const int gi = li + 256 * i;
        if (gi < WK_NG) { const int st = gi / 100, gg = gi % 100; int off;
            if (gg < 32) off = 768 + 8 * gg; else if (gg < 48) off = 384 + 8 * (gg - 32); else if (gg < 64) off = 512 + 8 * (gg - 48);
            else if (gg < 80) off = 128 + 8 * (gg - 64); else if (gg < 96) off = 8 * (gg - 80); else off = 256 + 2 * (16 * rowq + 4 * (gg - 96));
            raw[i] = *(const v2u*)(Ec + (size_t)st * 1024 + off); }
        else raw[i] = (v2u){0u, 0u}; }
#pragma unroll
    for (int i = 0; i < 13; ++i) { const int gi = li + 256 * i;
        if (gi < WK_NG) { const int st = gi / 100, gg = gi % 100; LAS float* sp = buf + st * WK_STEP_F;
            if (gg < 32) *(LAS v2u*)(sp + 2 * gg) = raw[i];
            else { const int fo = gg < 96 ? 64 + 4 * (gg - 32) : 320 + 4 * (gg - 96);
                *(LAS f32x4*)(sp + fo) = (f32x4){bflo(raw[i].x), bfhi(raw[i].x), bflo(raw[i].y), bfhi(raw[i].y)}; } } }
}
__device__ __forceinline__ void wkv_flush(const LAS float* YB, bf16* PROJ, int c, int li, int b, int h, int rowq) {
    if (li < 128) { const int st = li >> 2, rq = li & 3; const f32x4 yv = *(const LAS f32x4*)(YB + (c & 1) * 512 + st * 16 + 4 * rq);
        const size_t m = (size_t)b * T + (size_t)c * WK_TCH + st;
        *(f32x4*)((float*)(PROJ + m * EC) + h * 64 + 16 * rowq + 4 * rq) = yv; }
}
__device__ __forceinline__ void wkv_phase(const Args& a, Frame& F, unsigned char* PREP, bf16* PROJ) {
    if (F.bid < 192) {
        const int chain = F.bid >> 2, rowq = F.bid & 3, b = chain / 12, h = chain % 12;
        LAS float* L = (LAS float*)F.lds;
        LAS float* YB = (LAS float*)(F.lds + WK_YB_OFF);
        const unsigned char* Eb = PREP + (size_t)chain * T * 1024;
        const bool loader = F.wave >= 4; const int li = F.tid - 256;
        f32x4 S = (f32x4){0.f, 0.f, 0.f, 0.f};
        const int k4 = F.lane & 15, rloc = 4 * (F.wave & 3) + (F.lane >> 4);
        constexpr int NCH = T / WK_TCH;
        if (loader) wkv_stage(L, Eb, 0, li, rowq);
        __syncthreads();
        for (int c = 0; c < NCH; ++c) {
            if (loader) { if (c + 1 < NCH) wkv_stage(L, Eb, c + 1, li, rowq); if (c > 0) wkv_flush(YB, PROJ, c - 1, li, b, h, rowq); }
            else {
                const LAS float* buf = L + (c & 1) * WK_BUF_F; LAS float* yb = YB + (c & 1) * 512;
#pragma unroll 4
                for (int s = 0; s < WK_TCH; ++s) { const LAS float* sp = buf + s * WK_STEP_F;
                    const f32x4 d = *(const LAS f32x4*)(sp + 4 * k4), kk = *(const LAS f32x4*)(sp + 64 + 4 * k4), bb = *(const LAS f32x4*)(sp + 128 + 4 * k4),
                                kp = *(const LAS f32x4*)(sp + 192 + 4 * k4), r = *(const LAS f32x4*)(sp + 256 + 4 * k4);
                    const float v = sp[320 + rloc];
                    const float y = wkv_step(S, d, kk, bb, kp, r, v);
                    if (k4 == 0) yb[s * 16 + rloc] = y; }
            }
            __syncthreads();
        }
        if (loader) wkv_flush(YB, PROJ, NCH - 1, li, b, h, rowq);
        else *(f32x4*)(a.out + O_PWKV + ((size_t)chain * 64 + 16 * rowq + rloc) * 64 + 4 * k4) = S;
    } else {
        const int w = (F.bid - 192) * NWAVES + F.wave; const int k4 = F.lane & 15;
        for (int st = w; st < 384 * 16; st += 64 * NWAVES) {
            const int sc = st >> 4, rg = st & 15, row = 4 * rg + (F.lane >> 4), bs = sc / 12, h = sc % 12;
            f32x4 S = *(const f32x4*)(a.in[I_SWKV] + ((size_t)sc * 64 + row) * 64 + 4 * k4);
#pragma unroll
            for (int t = 0; t < 4; ++t) {
                const unsigned char* E = PREP + ((size_t)48 * T + (size_t)sc * 4 + t) * 1024;
                const f32x4 d = *(const f32x4*)(E + 768 + 16 * k4), kk = ld_bf4(E + 384 + 8 * k4), bb = ld_bf4(E + 512 + 8 * k4), kp = ld_bf4(E + 128 + 8 * k4), r = ld_bf4(E + 8 * k4);
                const float v = bf2f(*(const bf16*)(E + 256 + 2 * row));
                const float y = wkv_step(S, d, kk, bb, kp, r, v);
                if (k4 == 0) ((float*)(PROJ + ((size_t)MP + bs * 4 + t) * EC))[h * 64 + row] = y;
            }
            *(f32x4*)(a.out + O_SWKV + ((size_t)sc * 64 + row) * 64 + 4 * k4) = S;
        }
    }
}

__device__ __forceinline__ void mix_phase(const Args& a, Frame& F, const unsigned char* PREP, const bf16* PROJ, const bf16* ATTO, const float* LSE, bf16* MIX) {
    const int lane = F.lane;
    for (int m = F.gw; m < M; m += NGW) {
        const float* Y = (const float*)(PROJ + (size_t)m * EC);
        bf16* orow = MIX + (size_t)m * D;
        for (int h = 0; h < 12; ++h) {
            size_t entry;
            if (m < MP) entry = (size_t)((m >> 12) * 12 + h) * T + (m & (T - 1)); else { const int s = m - MP; entry = (size_t)48 * T + (size_t)(((s >> 2) * 12 + h) * 4 + (s & 3)); }
            const unsigned char* E = PREP + entry * 1024;
            const int c = h * 64 + lane;
            const float y = Y[c];
            const float mean = wave_sum(y) * (1.0f / 64.0f);
            const float dy = y - mean;
            const float var = wave_sum(dy * dy) * (1.0f / 64.0f);
            const float yn = dy * rsqrtf(var + LNX_EPS) * a.in[I_ELNW][c] + a.in[I_ELNB][c];
            const float r = bf2f(*(const bf16*)(E + 2 * lane)), kp = bf2f(*(const bf16*)(E + 128 + 2 * lane)), v = bf2f(*(const bf16*)(E + 256 + 2 * lane)), g = bf2f(*(const bf16*)(E + 640 + 2 * lane));
            const float bonus = wave_sum(r * kp * a.in[I_ERK][c]) * v;
            orow[256 + c] = (bf16)f2bf((yn + bonus) * g);
        }
#pragma unroll
        for (int hs = 0; hs < 4; ++hs) {
            const float l0 = LSE[((size_t)0 * M + m) * 4 + hs], l1 = LSE[((size_t)1 * M + m) * 4 + hs], l2 = LSE[((size_t)2 * M + m) * 4 + hs];
            const float mx = fmaxf(l0, fmaxf(l1, l2));
            const float w0 = __builtin_amdgcn_exp2f(l0 - mx), w1 = __builtin_amdgcn_exp2f(l1 - mx), w2 = __builtin_amdgcn_exp2f(l2 - mx);
            const float inv = 1.0f / (w0 + w1 + w2);
            const int c = hs * 64 + lane;
            const float o = w0 * bf2f(ATTO[((size_t)0 * M + m) * 256 + c]) + w1 * bf2f(ATTO[((size_t)1 * M + m) * 256 + c]) + w2 * bf2f(ATTO[((size_t)2 * M + m) * 256 + c]);
            orow[c] = (bf16)f2bf(o * inv);
        }
    }
}

__device__ __forceinline__ void hgrn_gates(const Args& a, Frame& F, const bf16* __restrict__ PC, unsigned char* ws) {
    const float* LB = (const float*)(ws + WS_TAB + 8192);
    bf16* QE = (bf16*)(ws + WS_QE); bf16* KE = (bf16*)(ws + WS_KE); bf16* KET = (bf16*)(ws + WS_KET); bf16* VT = (bf16*)(ws + WS_VT); float* EBL = (float*)(ws + WS_EBL);
    const int lane = F.lane;
    for (int task = F.gw; task < (MP / 16) * 8; task += NGW) {
        const int ck = task >> 3, h = task & 7, c2 = h * 128 + 2 * lane;
        const float lb0 = LB[c2], lb1 = LB[c2 + 1];
        float bs0 = 0.f, bs1 = 0.f, eb0 = 1.f, eb1 = 1.f;
        unsigned ket0[8], ket1[8], vt0[8], vt1[8];
        unsigned tk0 = 0, tk1 = 0, tv0 = 0, tv1 = 0;
#pragma unroll
        for (int tk = 0; tk < 16; ++tk) {
            const size_t m = (size_t)ck * 16 + tk; const bf16* pr = PC + m * CC;
            const unsigned qw = *(const unsigned*)(pr + c2), fw = *(const unsigned*)(pr + 1024 + c2), iw = *(const unsigned*)(pr + 2048 + c2);
            const float fg0 = lb0 + (1.0f - lb0) * sigmoidf_(bflo(fw)), fg1 = lb1 + (1.0f - lb1) * sigmoidf_(bfhi(fw));
            bs0 += __logf(fg0); bs1 += __logf(fg1);
            eb0 = __expf(bs0); eb1 = __expf(bs1);
            const float en0 = 1.0f / eb0, en1 = 1.0f / eb1;
            const float ke0 = (1.0f - fg0) * en0, ke1 = (1.0f - fg1) * en1;
            const float qe0 = siluf_(bflo(qw)) * eb0, qe1 = siluf_(bfhi(qw)) * eb1;
            *(unsigned*)(QE + m * D + c2) = pk2(qe0, qe1);
            *(unsigned*)(KE + m * D + c2) = pk2(ke0, ke1);
            if ((tk & 1) == 0) { tk0 = f2bf(ke0); tk1 = f2bf(ke1); tv0 = iw & 0xffffu; tv1 = iw >> 16; }
            else { ket0[tk >> 1] = tk0 | (f2bf(ke0) << 16); ket1[tk >> 1] = tk1 | (f2bf(ke1) << 16); vt0[tk >> 1] = tv0 | (iw << 16); vt1[tk >> 1] = tv1 | (iw & 0xffff0000u); }
        }
        const size_t tb = (size_t)ck * 16;
        *(v4u*)(KET + (size_t)c2 * MP + tb) = (v4u){ket0[0], ket0[1], ket0[2], ket0[3]}; *(v4u*)(KET + (size_t)c2 * MP + tb + 8) = (v4u){ket0[4], ket0[5], ket0[6], ket0[7]};
        *(v4u*)(KET + (size_t)(c2 + 1) * MP + tb) = (v4u){ket1[0], ket1[1], ket1[2], ket1[3]}; *(v4u*)(KET + (size_t)(c2 + 1) * MP + tb + 8) = (v4u){ket1[4], ket1[5], ket1[6], ket1[7]};
        *(v4u*)(VT + (size_t)c2 * MP + tb) = (v4u){vt0[0], vt0[1], vt0[2], vt0[3]}; *(v4u*)(VT + (size_t)c2 * MP + tb + 8) = (v4u){vt0[4], vt0[5], vt0[6], vt0[7]};
        *(v4u*)(VT + (size_t)(c2 + 1) * MP + tb) = (v4u){vt1[0], vt1[1], vt1[2], vt1[3]}; *(v4u*)(VT + (size_t)(c2 + 1) * MP + tb + 8) = (v4u){vt1[4], vt1[5], vt1[6], vt1[7]};
        *(f32x2*)(EBL + (size_t)ck * D + c2) = (f32x2){eb0, eb1};
    }
    float* SQ = (float*)(ws + WS_SQ);
    for (int i = F.bid * NTHR + F.tid; i < MS * 1024; i += NGT) { const int ms = i >> 10, c = i & 1023; const bf16* pr = PC + ((size_t)MP + ms) * CC;
        const float lb = LB[c];
        SQ[((size_t)ms * 3 + 0) * 1024 + c] = siluf_(bf2f(pr[c]));
        SQ[((size_t)ms * 3 + 1) * 1024 + c] = lb + (1.0f - lb) * sigmoidf_(bf2f(pr[1024 + c]));
        SQ[((size_t)ms * 3 + 2) * 1024 + c] = bf2f(pr[2048 + c]); }
}

struct ScanRegs { v2u qlo[4], qhi[4], klo[4], khi[4], ket[8], vt; f32x4 ebl[8]; };
__device__ __forceinline__ void scan_load(ScanRegs& R, const bf16* QE, const bf16* KE, const bf16* KET, const bf16* VT, const float* EBL, int b, int kb, int v0, int ck, int lane) {
    const int tl = lane & 15, g4 = lane >> 4; const size_t m0 = (size_t)b * T + (size_t)ck * 16;
    const bf16* qrow = QE + (m0 + tl) * D + kb + 4 * g4; const bf16* krow = KE + (m0 + tl) * D + kb + 4 * g4;
#pragma unroll
    for (int ks = 0; ks < 4; ++ks) { R.qlo[ks] = *(const v2u*)(qrow + 32 * ks); R.qhi[ks] = *(const v2u*)(qrow + 32 * ks + 16); R.klo[ks] = *(const v2u*)(krow + 32 * ks); R.khi[ks] = *(const v2u*)(krow + 32 * ks + 16); }
#pragma unroll
    for (int kt = 0; kt < 8; ++kt) { R.ket[kt] = *(const v2u*)(KET + (size_t)(kb + 16 * kt + tl) * MP + m0 + 4 * g4); R.ebl[kt] = *(const f32x4*)(EBL + (m0 >> 4) * D + kb + 16 * kt + 4 * g4); }
    R.vt = *(const v2u*)(VT + (size_t)(v0 + tl) * MP + m0 + 4 * g4);
}
__device__ __forceinline__ bf16x8 frag4(unsigned a, unsigned b, unsigned c, unsigned d) { return __builtin_bit_cast(bf16x8, (v4u){a, b, c, d}); }
__device__ __forceinline__ void scan_compute(const ScanRegs& R, f32x4 (&S)[8], bf16* PC, int b, int v0, int ck, int lane) {
    const int tl = lane & 15, g4 = lane >> 4;
    bf16x8 qf[4];
#pragma unroll
    for (int ks = 0; ks < 4; ++ks) qf[ks] = frag4(R.qlo[ks].x, R.qlo[ks].y, R.qhi[ks].x, R.qhi[ks].y);
    f32x4 att = (f32x4){0.f, 0.f, 0.f, 0.f};
#pragma unroll
    for (int ks = 0; ks < 4; ++ks) att = mfma16(frag4(R.klo[ks].x, R.klo[ks].y, R.khi[ks].x, R.khi[ks].y), qf[ks], att);
#pragma unroll
    for (int i = 0; i < 4; ++i) if (4 * g4 + i > tl) att[i] = 0.f;
    const bf16x8 pB = frag4(pk2(att.x, att.y), pk2(att.z, att.w), 0u, 0u);
    const bf16x8 vfr = frag4(R.vt.x, R.vt.y, 0u, 0u);
    f32x4 o = (f32x4){0.f, 0.f, 0.f, 0.f};
#pragma unroll
    for (int ks = 0; ks < 4; ++ks) {
        const bf16x8 sf = frag4(pk2(S[2 * ks].x, S[2 * ks].y), pk2(S[2 * ks].z, S[2 * ks].w), pk2(S[2 * ks + 1].x, S[2 * ks + 1].y), pk2(S[2 * ks + 1].z, S[2 * ks + 1].w));
        o = mfma16(sf, qf[ks], o);
    }
    o = mfma16(vfr, pB, o);
    const size_t m = (size_t)b * T + (size_t)ck * 16 + tl;
    *(f32x4*)((float*)(PC + m * CC) + v0 + 4 * g4) = o;
#pragma unroll
    for (int kt = 0; kt < 8; ++kt) { S[kt] = mfma16(frag4(R.ket[kt].x, R.ket[kt].y, 0u, 0u), vfr, S[kt]); S[kt] = S[kt] * R.ebl[kt]; }
}
__device__ __forceinline__ void hgrn_scan(const Args& a, Frame& F, bf16* PC, unsigned char* ws) {
    {
        const int bs = F.bid >> 3, h = F.bid & 7;
        const float* SQ = (const float*)(ws + WS_SQ);
        LAS float* Lq = (LAS float*)F.lds; LAS float* Lf = Lq + 512; LAS float* Lv = Lf + 512; LAS float* Lr = Lv + 512;
        { const int t = F.tid >> 7, k = F.tid & 127; const size_t ms = (size_t)bs * 4 + t;
          Lq[F.tid] = SQ[(ms * 3 + 0) * 1024 + h * 128 + k]; Lf[F.tid] = SQ[(ms * 3 + 1) * 1024 + h * 128 + k]; Lv[F.tid] = SQ[(ms * 3 + 2) * 1024 + h * 128 + k]; }
        __syncthreads();
        const int v = F.tid & 127, kq = F.tid >> 7;
        float o0 = 0.f, o1 = 0.f, o2 = 0.f, o3 = 0.f;
        const float v0 = Lv[v], v1 = Lv[128 + v], v2 = Lv[256 + v], v3 = Lv[384 + v];
        const size_t sbase = ((size_t)(bs * 8 + h) * 128) * 128;
        for (int kk = 0; kk < 32; ++kk) { const int k = 32 * kq + kk;
            float s = a.in[I_SC][sbase + (size_t)k * 128 + v];
            float fg;
            fg = Lf[k]; s = fg * s + (1.0f - fg) * v0; o0 += Lq[k] * s;
            fg = Lf[128 + k]; s = fg * s + (1.0f - fg) * v1; o1 += Lq[128 + k] * s;
            fg = Lf[256 + k]; s = fg * s + (1.0f - fg) * v2; o2 += Lq[256 + k] * s;
            fg = Lf[384 + k]; s = fg * s + (1.0f - fg) * v3; o3 += Lq[384 + k] * s;
            a.out[O_SC + sbase + (size_t)k * 128 + v] = s; }
        Lr[(kq * 4 + 0) * 128 + v] = o0; Lr[(kq * 4 + 1) * 128 + v] = o1; Lr[(kq * 4 + 2) * 128 + v] = o2; Lr[(kq * 4 + 3) * 128 + v] = o3;
        __syncthreads();
        { const int t = F.tid >> 7, vv = F.tid & 127; const float o = Lr[(0 * 4 + t) * 128 + vv] + Lr[(1 * 4 + t) * 128 + vv] + Lr[(2 * 4 + t) * 128 + vv] + Lr[(3 * 4 + t) * 128 + vv];
          ((float*)(PC + ((size_t)MP + bs * 4 + t) * CC))[h * 128 + vv] = o; }
    }
    if (F.wave == 0) {
        const int b = F.bid >> 6, h = (F.bid >> 3) & 7, vs = F.bid & 7, kb = h * 128, v0 = h * 128 + 16 * vs;
        const bf16* QE = (const bf16*)(ws + WS_QE); const bf16* KE = (const bf16*)(ws + WS_KE); const bf16* KET = (const bf16*)(ws + WS_KET); const bf16* VT = (const bf16*)(ws + WS_VT); const float* EBL = (const float*)(ws + WS_EBL);
        f32x4 S[8];
#pragma unroll
        for (int i = 0; i < 8; ++i) S[i] = (f32x4){0.f, 0.f, 0.f, 0.f};
        ScanRegs cur, nxt;
        scan_load(cur, QE, KE, KET, VT, EBL, b, kb, v0, 0, F.lane);
        for (int ck = 0; ck < T / 16; ++ck) {
            const int cn = ck + 1 < T / 16 ? ck + 1 : ck;
            scan_load(nxt, QE, KE, KET, VT, EBL, b, kb, v0, cn, F.lane);
            scan_compute(cur, S, PC, b, v0, ck, F.lane);
            cur = nxt;
        }
        const int tl = F.lane & 15, g4 = F.lane >> 4;
#pragma unroll
        for (int kt = 0; kt < 8; ++kt)
#pragma unroll
            for (int i = 0; i < 4; ++i) a.out[O_PC + ((size_t)(b * 8 + h) * 128 + 16 * kt + 4 * g4 + i) * 128 + 16 * vs + tl] = S[kt][i];
    }
}

__device__ __forceinline__ void hgrn_out(const Args& a, Frame& F, const bf16* PC, bf16* CO) {
    const float* cn = a.in[I_CNORM];
    for (int m = F.gw; m < M; m += NGW) {
        const float* O = (const float*)(PC + (size_t)m * CC);
        const bf16* gate = PC + (size_t)m * CC + 3072;
        f32x4 v[4]; float s = 0.f;
#pragma unroll
        for (int j = 0; j < 4; ++j) { v[j] = *(const f32x4*)(O + 256 * j + 4 * F.lane); s += (v[j].x * v[j].x + v[j].y * v[j].y) + (v[j].z * v[j].z + v[j].w * v[j].w); }
        s = wave_sum(s);
        const float rs = rsqrtf(s * (1.0f / 1024.0f) + EPS);
#pragma unroll
        for (int j = 0; j < 4; ++j) { const int c = 256 * j + 4 * F.lane; const f32x4 g = *(const f32x4*)(cn + c); const v2u gw = *(const v2u*)(gate + c);
            const float x0 = v[j].x * rs * g.x * siluf_(bflo(gw.x)), x1 = v[j].y * rs * g.y * siluf_(bfhi(gw.x)), x2 = v[j].z * rs * g.z * siluf_(bflo(gw.y)), x3 = v[j].w * rs * g.w * siluf_(bfhi(gw.y));
            v2u w; w.x = pk2(x0, x1); w.y = pk2(x2, x3); *(v2u*)(CO + (size_t)m * D + c) = w; }
    }
}

__device__ __forceinline__ void final_norm(const Args& a, Frame& F, const float* rsq) {
    const float* g = a.in[I_NFIN];
    for (int m = F.gw; m < M; m += NGW) {
        float* X = a.out + (size_t)m * D;
        const float rs = rsqrtf(rsq[m] * (1.0f / 1024.0f) + EPS);
#pragma unroll
        for (int j = 0; j < 4; ++j) { const int c = 256 * j + 4 * F.lane; f32x4 v = *(const f32x4*)(X + c); const f32x4 gg = *(const f32x4*)(g + c); v = v * rs * gg; *(f32x4*)(X + c) = v; }
    }
}


constexpr int NPHASE = 16;
__global__ void __launch_bounds__(NTHR, 2) mk_fwd(Args args) {
    extern __shared__ __attribute__((aligned(16))) unsigned char lds[];
    Frame F;
    F.lds = (LAS unsigned char*)lds;
    F.tid = threadIdx.x; F.lane = F.tid & 63; F.wave = __builtin_amdgcn_readfirstlane(F.tid >> 6); F.bid = blockIdx.x; F.gw = F.bid * NWAVES + F.wave;
    unsigned char* ws = args.ws;
    gu32* ctl = (gu32*)(ws + WS_CTL);
    volatile LAS unsigned* MISC = (volatile LAS unsigned*)(F.lds + MISC_OFF);
    for (int u = F.tid; u < (BT_OFF - LDSCTL_OFF) / 4; u += NTHR) ((LAS unsigned*)(F.lds + LDSCTL_OFF))[u] = 0u;
    __syncthreads();
    XcdBarrier bar; bar.bar = (unsigned*)(ctl + CW_BAR); bar.x = 0; bar.st = nullptr;
#if !MK_PER_PHASE
    bar = xcd_barrier_post((unsigned*)(ctl + CW_BAR), MISC + 8);
#define GRID_BAR() xcd_barrier(bar)
#else
#define GRID_BAR() do {} while (0)
#endif
    const int lo = args.ph_lo, hi = args.ph_hi;
#ifndef PH_MASK
#define PH_MASK 0xFFFF
#endif
#define IN(k) ((((PH_MASK) >> (k)) & 1) && lo <= (k) && (k) < hi)
#define SEAM(k) do { if (IN(k) && IN((k) + 1)) GRID_BAR(); } while (0)

    float* rsq = (float*)(ws + WS_CTL + RSQ_OFF);
    bf16* BUF0 = (bf16*)(ws + WS_BUF0); bf16* BUF1 = (bf16*)(ws + WS_BUF1);
    bf16* RA = (bf16*)(ws + WS_A);
    unsigned char* PREP = ws + WS_B;
    bf16* ATTO = (bf16*)(ws + WS_ATTO); float* LSE = (float*)(ws + WS_LSE);
    const int G = (int)gridDim.x;

    if (IN(0)) { p0_prologue(args, F); }
    SEAM(0);
    if (IN(1)) {
        pg8::Gemm g{BUF0, (const bf16*)(ws + WS_WIN0), MPAD, EC, D}; pg8::StaticOrder S; S.init(MPAD, EC, G, F.bid);
        pg8::EpiScale<0> E{RA, EC, rsq};
        pg8::gemm_phase<pg8::EpiScale<0>, pg8::StaticOrder, true, true>(F.lds, g, S, E);
    }
    SEAM(1);
    if (IN(2)) {
        { const float* BT = (const float*)(ws + WS_TAB); LAS float* bt = (LAS float*)(F.lds + BT_OFF);
          for (int i = F.tid; i < 12 * BT_LD; i += NTHR) bt[i] = BT[i]; }
        __syncthreads();
        const LAS float* bt = (const LAS float*)(F.lds + BT_OFF);
        for (int t = F.gw; t < NB * 3 * 4 * 128; t += NGW) attn_task(RA, bt, ATTO, LSE, t, F.lane);
        for (int t = F.gw; t < SB * 12; t += NGW) sattn_task(args, RA, bt, ATTO, LSE, (LAS float*)(F.lds + F.wave * 16384), t, F.lane);
        for (int t = F.gw; t < (M / 16) * 12; t += NGW) prep_task(args, RA, (const bf16*)(ws + WS_TAB + 16384), PREP, t / 12, t % 12, F.lane);
        kv_copies(RA, args.out, F.bid * NTHR + F.tid);
    }
    SEAM(2);
    if (IN(3)) { wkv_phase(args, F, PREP, RA); }
    SEAM(3);
    if (IN(4)) { mix_phase(args, F, PREP, RA, ATTO, LSE, BUF1); }
    SEAM(4);
    if (IN(5)) {
        pg8::Gemm g{BUF1, (const bf16*)(ws + WS_WOUT0), MPAD, D, D}; pg8::StaticOrder S; S.init(MPAD, D, G, F.bid);
        pg8::EpiResid E{args.in[I_XP], args.in[I_XS], args.out, BUF0, rsq + 1 * MPAD, M};
        pg8::gemm_phase<pg8::EpiResid, pg8::StaticOrder, true, true>(F.lds, g, S, E);
    }
    SEAM(5);
    if (IN(6)) {
        pg8::Gemm g{BUF0, (const bf16*)(ws + WS_WUP0), MPAD, FF, D}; pg8::StaticOrder S; S.init(MPAD, FF, G, F.bid);
        pg8::EpiScale<1> E{RA, FF, rsq + 1 * MPAD};
        pg8::gemm_phase<pg8::EpiScale<1>, pg8::StaticOrder, true, true>(F.lds, g, S, E);
    }
    SEAM(6);
    if (IN(7)) {
        pg8::Gemm g{RA, (const bf16*)(ws + WS_WDN0), MPAD, D, FF}; pg8::StaticOrder S; S.init(MPAD, D, G, F.bid);
        pg8::EpiResid E{args.out, args.out + (size_t)MP * D, args.out, BUF1, rsq + 2 * MPAD, M};
        pg8::gemm_phase<pg8::EpiResid, pg8::StaticOrder, true, true>(F.lds, g, S, E);
    }
    SEAM(7);
    if (IN(8)) {
        pg8::Gemm g{BUF1, (const bf16*)(ws + WS_WCIN), MPAD, CC, D}; pg8::StaticOrder S; S.init(MPAD, CC, G, F.bid);
        pg8::EpiScale<0> E{RA, CC, rsq + 2 * MPAD};
        pg8::gemm_phase<pg8::EpiScale<0>, pg8::StaticOrder, true, true>(F.lds, g, S, E);
    }
    SEAM(8);
    if (IN(9)) { hgrn_gates(args, F, RA, ws); }
    SEAM(9);
    if (IN(10)) { hgrn_scan(args, F, RA, ws); }
    SEAM(10);
    if (IN(11)) { hgrn_out(args, F, RA, BUF0); }
    SEAM(11);
    if (IN(12)) {
        pg8::Gemm g{BUF0, (const bf16*)(ws + WS_WCOUT), MPAD, D, D}; pg8::StaticOrder S; S.init(MPAD, D, G, F.bid);
        pg8::EpiResid E{args.out, args.out + (size_t)MP * D, args.out, BUF1, rsq + 3 * MPAD, M};
        pg8::gemm_phase<pg8::EpiResid, pg8::StaticOrder, true, true>(F.lds, g, S, E);
    }
    SEAM(12);
    if (IN(13)) {
        pg8::Gemm g{BUF1, (const bf16*)(ws + WS_WUP1), MPAD, FF, D}; pg8::StaticOrder S; S.init(MPAD, FF, G, F.bid);
        pg8::EpiScale<1> E{RA, FF, rsq + 3 * MPAD};
        pg8::gemm_phase<pg8::EpiScale<1>, pg8::StaticOrder, true, true>(F.lds, g, S, E);
    }
    SEAM(13);
    if (IN(14)) {
        pg8::Gemm g{RA, (const bf16*)(ws + WS_WDN1), MPAD, D, FF}; pg8::StaticOrder S; S.init(MPAD, D, G, F.bid);
        pg8::EpiResid E{args.out, args.out + (size_t)MP * D, args.out, BUF0, rsq + 4 * MPAD, M};
        pg8::gemm_phase<pg8::EpiResid, pg8::StaticOrder, true, true>(F.lds, g, S, E);
    }
    SEAM(14);
    if (IN(15)) { final_norm(args, F, rsq + 4 * MPAD); }
#undef IN
#undef SEAM
}

extern "C" void kernel_launch(void* const* d_in, const int* in_sizes, int n_in, void* d_out, int out_size, void* d_ws, size_t ws_size, hipStream_t stream) {
    static int grid = 0;
    if (grid == 0) {
        if (n_in != 31 || in_sizes[0] != MP * D || out_size != (int)O_END || ws_size < WS_END) {
            fprintf(stderr, "kernel_launch: shape/workspace mismatch: n_in %d in0 %d out %d ws %zu (need %zu); nothing launched\n", n_in, n_in > 0 ? in_sizes[0] : -1, out_size, ws_size, (size_t)WS_END); grid = -1; return; }
        if (hipFuncSetAttribute((const void*)mk_fwd, hipFuncAttributeMaxDynamicSharedMemorySize, LDS_BYTES) != hipSuccess) { fprintf(stderr, "kernel_launch: hipFuncSetAttribute failed\n"); grid = -1; return; }
        int per_cu = 0;
        if (hipOccupancyMaxActiveBlocksPerMultiprocessor(&per_cu, (const void*)mk_fwd, NTHR, LDS_BYTES) != hipSuccess || per_cu < 1)
            fprintf(stderr, "kernel_launch: note: occupancy query reports %d workgroups per CU\n", per_cu);
        (void)hipGetLastError();
        grid = 256;
    }
    if (grid < 0) return;
    if (hipMemsetAsync((char*)d_ws + WS_CTL, 0, CTL_ZERO_BYTES, stream) != hipSuccess) { fprintf(stderr, "kernel_launch: hipMemsetAsync failed\n"); return; }
    Args a{};
    for (int i = 0; i < 31; ++i) a.in[i] = (const float*)d_in[i];
    a.out = (float*)d_out; a.ws = (unsigned char*)d_ws;
#if MK_PER_PHASE
    for (int p = 0; p < NPHASE; ++p) { a.ph_lo = p; a.ph_hi = p + 1; hipLaunchKernelGGL(mk_fwd, dim3(grid), dim3(NTHR), LDS_BYTES, stream, a); }
#else
    a.ph_lo = 0; a.ph_hi = NPHASE;
    hipLaunchKernelGGL(mk_fwd, dim3(grid), dim3(NTHR), LDS_BYTES, stream, a);
#endif
    const hipError_t le = hipPeekAtLastError();
    if (le != hipSuccess) fprintf(stderr, "kernel_launch: launch failed: %s\n", hipGetErrorName(le));
}
```

```cpp
#include <hip/hip_runtime.h>
#include <cstdio>
#include <cstdint>

#ifndef MK_PER_PHASE
#define MK_PER_PHASE 0
#endif

namespace pg8 {
#define PG8_LAS __attribute__((address_space(3)))
typedef unsigned short bf16_t;
typedef short bf16x8 __attribute__((ext_vector_type(8)));
typedef float f32x4 __attribute__((ext_vector_type(4)));
typedef unsigned u32x4 __attribute__((ext_vector_type(4)));
constexpr int BM = 256, BK = 64, HALF = 128, HTB = HALF * BK * 2  , STAGE_BYTES = 8 * HTB, NXCD = 8, WGM = 8;

__host__ __device__ __forceinline__ int lds_byte(int r, int c) { const int st = (r >> 4) * 2 + (c >> 5), rr = r & 15, cc = c & 31, ob = rr * 64 + cc * 2; return st * 1024 + (ob ^ (((ob >> 9) & 1) << 5)); }
__host__ __device__ __forceinline__ void stage_rc(int b, int& R, int& C) { const int st = b / 1024, sb = b % 1024, swz = sb ^ (((sb >> 9) & 1) << 5); R = (st >> 1) * 16 + swz / 64; C = (st & 1) * 32 + (swz % 64) / 2; }
__host__ __device__ __forceinline__ int perm32(int rho) { const int n = rho >> 4, i = rho & 15; return 8 * (i >> 2) + 4 * n + (i & 3); }

struct Unit { int pm, pn; };
struct Gemm { const bf16_t* A; const bf16_t* Bt; int M, N, K; };

struct StaticOrder {
    int nM, nN, nwg, G, c;
    __host__ __device__ void init(int M, int N, int G_, int c_) { nM = M / BM; nN = N / BM; nwg = nM * nN; G = G_; c = c_; }
    __host__ __device__ bool next(int i, Unit& u) const {
        const long L = (long)i * G + c; if (L >= nwg) return false;
        int wgid = (int)L; { const int q = nwg / NXCD, r = nwg % NXCD, xcd = wgid % NXCD, off = wgid / NXCD; wgid = (xcd < r ? xcd * (q + 1) : r * (q + 1) + (xcd - r) * q) + off; }
        const int nig = WGM * nN, gid = wgid / nig, fm = gid * WGM, gsz = (nM - fm) < WGM ? (nM - fm) : WGM;
        u.pm = fm + ((wgid % nig) % gsz); u.pn = (wgid % nig) / gsz; return true;
    }
    __device__ __forceinline__ void a_ready(const Unit&) const {}
    __device__ __forceinline__ void done(const Unit&) const {}
};


__device__ __forceinline__ unsigned cvt_pk_bf16(float lo, float hi) { unsigned r; asm volatile("v_cvt_pk_bf16_f32 %0, %1, %2" : "=v"(r) : "v"(lo), "v"(hi)); return r; }
typedef unsigned u32x2 __attribute__((ext_vector_type(2)));

template <int RELU2> struct EpiScale {
    static constexpr bool PERM = false, AFTER_DRAIN = false;
    bf16_t* O; int ldc; const float* rsq;
    __device__ __forceinline__ void operator()(const f32x4 (&acc)[2][2][4][2], const Unit& u, int wr, int wc, int fr, int fq) const {
        const int col0 = u.pn * BM + wc * 32 + 4 * fq;
#pragma unroll
        for (int ai = 0; ai < 2; ++ai)
#pragma unroll
            for (int m = 0; m < 4; ++m) {
                const int row = u.pm * BM + ai * HALF + wr * 64 + m * 16 + fr;
                const float s = __builtin_amdgcn_rsqf(rsq[row] * (1.0f / 1024.0f) + 1e-6f);
                bf16_t* rowp = O + (size_t)row * ldc + col0;
#pragma unroll
                for (int bj = 0; bj < 2; ++bj)
#pragma unroll
                    for (int n = 0; n < 2; ++n) {
                        f32x4 v = acc[ai][bj][m][n] * s;
                        if (RELU2) { v.x = fmaxf(v.x, 0.f); v.y = fmaxf(v.y, 0.f); v.z = fmaxf(v.z, 0.f); v.w = fmaxf(v.w, 0.f); v = v * v; }
                        u32x2 w; w.x = cvt_pk_bf16(v.x, v.y); w.y = cvt_pk_bf16(v.z, v.w);
                        *(u32x2*)(rowp + bj * HALF + n * 16) = w;
                    }
            }
    }
};

struct EpiResid {
    static constexpr bool PERM = false, AFTER_DRAIN = false;
    const float* Rp; const float* Rs;
    float* X; bf16_t* XB; float* rsq; int Mv;
    __device__ __forceinline__ void operator()(const f32x4 (&acc)[2][2][4][2], const Unit& u, int wr, int wc, int fr, int fq) const {
        const int col0 = u.pn * BM + wc * 32 + 4 * fq;
#pragma unroll
        for (int ai = 0; ai < 2; ++ai)
#pragma unroll
            for (int m = 0; m < 4; ++m) {
                const int row = u.pm * BM + ai * HALF + wr * 64 + m * 16 + fr;
                const bool valid = row < Mv;
                const float* rrow = (row < 16384) ? (Rp + (size_t)row * 1024) : (Rs + (size_t)(row - 16384) * 1024);
                float ss = 0.f;
#pragma unroll
                for (int bj = 0; bj < 2; ++bj)
#pragma unroll
                    for (int n = 0; n < 2; ++n) {
                        const int col = col0 + bj * HALF + n * 16;
                        f32x4 x = (f32x4){0.f, 0.f, 0.f, 0.f};
                        if (valid) {
                            x = *(const f32x4*)(rrow + col) + acc[ai][bj][m][n];
                            *(f32x4*)(X + (size_t)row * 1024 + col) = x;
                            ss += (x.x * x.x + x.y * x.y) + (x.z * x.z + x.w * x.w);
                        }
                        u32x2 w; w.x = cvt_pk_bf16(x.x, x.y); w.y = cvt_pk_bf16(x.z, x.w);
                        *(u32x2*)(XB + (size_t)row * 1024 + col) = w;
                    }
                ss += __shfl_xor(ss, 16); ss += __shfl_xor(ss, 32);
                if (fq == 0 && valid) unsafeAtomicAdd(rsq + row, ss);
            }
    }
};

template <class Epi, class Sched, bool ALIGN_EPI = false, bool SP2 = false>
__device__ __forceinline__ void gemm_phase(PG8_LAS unsigned char* lds, const Gemm g, const Sched& S, const Epi& E) {
    int tid_ = threadIdx.x; asm volatile("" : "+v"(tid_)); __builtin_assume(tid_ >= 0 && tid_ < 512);
    const int tid = tid_, wid = __builtin_amdgcn_readfirstlane(tid >> 6), lane = tid & 63, wr = wid >> 2, wc = wid & 3, fr = lane & 15, fq = lane >> 4;
    const int K = g.K, nt = K / BK;
    unsigned voffA[2], voffB[2];
#pragma unroll
    for (int i = 0; i < 2; ++i) { int R, C; stage_rc(tid * 16 + i * 8192, R, C); const int Rb = Epi::PERM ? ((R & ~31) + perm32(R & 31)) : R;
        voffA[i] = (unsigned)(R * K + C) * 2u; voffB[i] = (unsigned)(Rb * K + C) * 2u; }
    const size_t kstep = (size_t)(BK * 2);
    const size_t hstep = (size_t)HALF * K * 2;
    const size_t tstep = 2 * hstep;
    const unsigned ldsw = (unsigned)wid * 1024u;
    const int aoff = lds_byte(wr * 64 + fr, fq * 8), boff = lds_byte(wc * 32 + fr, fq * 8);
#define PG8_SA(b, h) (((b) * 2 + (h)) * HTB)
#define PG8_SB(b, h) ((4 + (b) * 2 + (h)) * HTB)
#define PG8_STAGE(bufoff, gbase, voff) do { _Pragma("unroll") for (int _i = 0; _i < 2; ++_i) \
        __builtin_amdgcn_global_load_lds((const unsigned*)((const char*)(gbase) + (voff)[_i]), (PG8_LAS unsigned*)(lds + (bufoff) + ldsw + _i * 8192), 16, 0, 0); } while (0)
#define PG8_LDA(dst, b, h) do { _Pragma("unroll") for (int m = 0; m < 4; ++m) _Pragma("unroll") for (int k = 0; k < 2; ++k) dst[m][k] = *(const PG8_LAS bf16x8*)(lds + PG8_SA(b, h) + aoff + m * 2048 + k * 1024); } while (0)
#define PG8_LDB(dst, b, h) do { _Pragma("unroll") for (int n = 0; n < 2; ++n) _Pragma("unroll") for (int k = 0; k < 2; ++k) dst[n][k] = *(const PG8_LAS bf16x8*)(lds + PG8_SB(b, h) + boff + n * 2048 + k * 1024); } while (0)
#define PG8_MMA(ai, bj, At, Bt) do { __builtin_amdgcn_s_setprio(1); _Pragma("unroll") for (int m = 0; m < 4; ++m) _Pragma("unroll") for (int n = 0; n < 2; ++n) _Pragma("unroll") for (int k = 0; k < 2; ++k) \
        acc[ai][bj][m][n] = __builtin_amdgcn_mfma_f32_16x16x32_bf16(Bt[n][k], At[m][k], acc[ai][bj][m][n], 0, 0, 0); __builtin_amdgcn_s_setprio(0); } while (0)
#define PG8_WAIT_V(n) asm volatile("s_waitcnt vmcnt(" #n ")" ::: "memory")
#define PG8_WAIT_L(n) asm volatile("s_waitcnt lgkmcnt(" #n ")" ::: "memory")
#define PG8_BAR __builtin_amdgcn_s_barrier()
#define PG8_SCHED __builtin_amdgcn_sched_barrier(0)
    Unit cur, nxt; int ui = 0;
    if (!S.next(0, cur)) return;
    f32x4 acc[2][2][4][2];
#pragma unroll
    for (int a = 0; a < 2; ++a)
#pragma unroll
        for (int b = 0; b < 2; ++b)
#pragma unroll
            for (int m = 0; m < 4; ++m)
#pragma unroll
                for (int n = 0; n < 2; ++n) acc[a][b][m][n] = (f32x4){0.f, 0.f, 0.f, 0.f};
    bf16x8 At[4][2], B0[2][2], B1[2][2];
    const char* cA = (const char*)g.A + (size_t)cur.pm * tstep; const char* cB = (const char*)g.Bt + (size_t)cur.pn * tstep;
    S.a_ready(cur);
    if constexpr (SP2) {
        PG8_STAGE(PG8_SB(0, 0), cB, voffB); PG8_STAGE(PG8_SB(0, 1), cB + hstep, voffB); PG8_STAGE(PG8_SA(0, 0), cA, voffA); PG8_STAGE(PG8_SA(0, 1), cA + hstep, voffA);
        if (wr == 1) PG8_BAR;
        PG8_WAIT_V(2); PG8_BAR;
        PG8_STAGE(PG8_SB(1, 0), cB + kstep, voffB); PG8_STAGE(PG8_SA(1, 0), cA + kstep, voffA); PG8_STAGE(PG8_SB(1, 1), cB + hstep + kstep, voffB);
        PG8_WAIT_V(6); PG8_BAR;
    } else {
        PG8_STAGE(PG8_SB(0, 0), cB, voffB); PG8_STAGE(PG8_SA(0, 0), cA, voffA); PG8_STAGE(PG8_SB(0, 1), cB + hstep, voffB); PG8_STAGE(PG8_SA(0, 1), cA + hstep, voffA);
        if (wr == 1) PG8_BAR;
        PG8_WAIT_V(4); PG8_BAR;
        PG8_STAGE(PG8_SB(1, 0), cB + kstep, voffB); PG8_STAGE(PG8_SA(1, 0), cA + kstep, voffA); PG8_STAGE(PG8_SB(1, 1), cB + hstep + kstep, voffB);
        PG8_WAIT_V(6); PG8_BAR;
    }
    for (;;) {
        const bool has_next = S.next(ui + 1, nxt);
        const char* nA = has_next ? (const char*)g.A + (size_t)nxt.pm * tstep : cA; const char* nB = has_next ? (const char*)g.Bt + (size_t)nxt.pn * tstep : cB;
        for (int t = 0; t < nt; t += 2) {
            const bool last = (t == nt - 2);
            const char* a1 = cA + (size_t)(t + 1) * kstep;
            const char* a2 = last ? nA : cA + (size_t)(t + 2) * kstep; const char* b2 = last ? nB : cB + (size_t)(t + 2) * kstep;
            const char* a3 = a2 + kstep; const char* b3 = b2 + kstep;
            if (last && has_next) S.a_ready(nxt);
            if constexpr (SP2) {
            PG8_LDB(B0, 0, 0); PG8_LDB(B1, 0, 1); PG8_SCHED; PG8_LDA(At, 0, 0); PG8_STAGE(PG8_SA(1, 1), a1 + hstep, voffA);
            PG8_WAIT_V(8); PG8_WAIT_L(0); PG8_BAR; PG8_MMA(0, 0, At, B0); PG8_MMA(0, 1, At, B1); PG8_BAR; PG8_SCHED;
            PG8_LDA(At, 0, 1); PG8_STAGE(PG8_SB(0, 0), b2, voffB); PG8_STAGE(PG8_SB(0, 1), b2 + hstep, voffB); PG8_STAGE(PG8_SA(0, 0), a2, voffA);
            PG8_WAIT_V(8); PG8_WAIT_L(0); PG8_BAR; PG8_MMA(1, 0, At, B0); PG8_MMA(1, 1, At, B1); PG8_BAR; PG8_SCHED;
            PG8_LDB(B0, 1, 0); PG8_LDB(B1, 1, 1); PG8_SCHED; PG8_LDA(At, 1, 0); PG8_STAGE(PG8_SA(0, 1), a2 + hstep, voffA);
            PG8_WAIT_V(8); PG8_WAIT_L(0); PG8_BAR; PG8_MMA(0, 0, At, B0); PG8_MMA(0, 1, At, B1); PG8_BAR; PG8_SCHED;
            PG8_LDA(At, 1, 1); PG8_STAGE(PG8_SB(1, 0), b3, voffB); PG8_STAGE(PG8_SB(1, 1), b3 + hstep, voffB); PG8_STAGE(PG8_SA(1, 0), a3, voffA);
            PG8_WAIT_V(8); PG8_WAIT_L(0); PG8_BAR; PG8_MMA(1, 0, At, B0); PG8_MMA(1, 1, At, B1); PG8_BAR; PG8_SCHED;
            } else {
            PG8_LDB(B0, 0, 0); PG8_SCHED; PG8_LDA(At, 0, 0); PG8_STAGE(PG8_SA(1, 1), a1 + hstep, voffA);
            PG8_WAIT_L(8); PG8_BAR; PG8_WAIT_L(0); PG8_MMA(0, 0, At, B0); PG8_BAR; PG8_SCHED;
            PG8_LDB(B1, 0, 1); PG8_STAGE(PG8_SB(0, 0), b2, voffB);
            PG8_BAR; PG8_WAIT_L(0); PG8_MMA(0, 1, At, B1); PG8_BAR;
            PG8_LDA(At, 0, 1); PG8_STAGE(PG8_SA(0, 0), a2, voffA);
            PG8_BAR; PG8_WAIT_L(0); PG8_MMA(1, 0, At, B0); PG8_BAR; PG8_SCHED;
            PG8_STAGE(PG8_SB(0, 1), b2 + hstep, voffB);
            PG8_WAIT_V(6); PG8_BAR; PG8_MMA(1, 1, At, B1); PG8_BAR;
            PG8_LDB(B0, 1, 0); PG8_SCHED; PG8_LDA(At, 1, 0); PG8_STAGE(PG8_SA(0, 1), a2 + hstep, voffA);
            PG8_WAIT_L(8); PG8_BAR; PG8_WAIT_L(0); PG8_MMA(0, 0, At, B0); PG8_BAR; PG8_SCHED;
            PG8_LDB(B1, 1, 1); PG8_STAGE(PG8_SB(1, 0), b3, voffB);
            PG8_BAR; PG8_WAIT_L(0); PG8_MMA(0, 1, At, B1); PG8_BAR;
            PG8_LDA(At, 1, 1); PG8_STAGE(PG8_SA(1, 0), a3, voffA);
            PG8_BAR; PG8_WAIT_L(0); PG8_MMA(1, 0, At, B0); PG8_BAR; PG8_SCHED;
            PG8_STAGE(PG8_SB(1, 1), b3 + hstep, voffB);
            PG8_WAIT_V(6); PG8_BAR; PG8_MMA(1, 1, At, B1); PG8_BAR;
            }
        }
        if constexpr (ALIGN_EPI) { if (wr == 0) PG8_BAR; }
        if constexpr (!Epi::AFTER_DRAIN) { E(acc, cur, wr, wc, fr, fq); S.done(cur); }
        if (!has_next) break;
#pragma unroll
        for (int a = 0; a < 2; ++a)
#pragma unroll
            for (int b = 0; b < 2; ++b)
#pragma unroll
                for (int m = 0; m < 4; ++m)
#pragma unroll
                    for (int n = 0; n < 2; ++n) acc[a][b][m][n] = (f32x4){0.f, 0.f, 0.f, 0.f};
        cur = nxt; cA = nA; cB = nB; ++ui;
        if constexpr (ALIGN_EPI) { if (wr == 1) PG8_BAR; }
    }
    PG8_WAIT_V(0);
    if constexpr (!ALIGN_EPI) { if (wr == 0) PG8_BAR; }
    PG8_BAR;
    if constexpr (Epi::AFTER_DRAIN) { E.fused(acc, cur, wr, wc, fr, fq, lds, wid, lane); S.done(cur); }
#undef PG8_SA
#undef PG8_SB
#undef PG8_STAGE
#undef PG8_LDA
#undef PG8_LDB
#undef PG8_MMA
#undef PG8_WAIT_V
#undef PG8_WAIT_L
#undef PG8_BAR
#undef PG8_SCHED
}
}

#define GAS __attribute__((address_space(1)))
#define LAS __attribute__((address_space(3)))
typedef unsigned short bf16;
typedef unsigned v4u __attribute__((ext_vector_type(4)));
typedef unsigned v2u __attribute__((ext_vector_type(2)));
typedef float f32x4 __attribute__((ext_vector_type(4)));
typedef float f32x2 __attribute__((ext_vector_type(2)));
typedef float f32x16 __attribute__((ext_vector_type(16)));
typedef short bf16x8 __attribute__((ext_vector_type(8)));
typedef GAS unsigned gu32;

constexpr int NWAVES = 8, NTHR = 512;
constexpr int D = 1024, T = 4096, NB = 4, MP = NB * T, SB = 32, ST = 4, MS = SB * ST, M = MP + MS, MPAD = 16640;
constexpr int EC = 5120, ECR = 4896, AQKV = 2304, BCOLS = 2592, CC = 4096, FF = 4096, BW = 768;
constexpr int LORA = 288;
constexpr float EPS = 1e-6f, LNX_EPS = 64e-5f, LOG2E = 1.4426950408889634f;
constexpr float QSCALE2 = 0.125f * LOG2E;
constexpr int BT_LD = 132;

constexpr size_t O_YP = 0, O_YS = (size_t)MP * D, O_PA0 = (size_t)M * D;
constexpr size_t O_PA1 = O_PA0 + (size_t)4 * 128 * 512, O_PA2 = O_PA1 + (size_t)4 * 512 * 512, O_PSH = O_PA2 + (size_t)4 * 2048 * 512;
constexpr size_t O_PWKV = O_PSH + (size_t)4 * BCOLS, O_PC = O_PWKV + (size_t)4 * 12 * 64 * 64, O_SA0 = O_PC + (size_t)4 * 8 * 128 * 128;
constexpr size_t O_SA1 = O_SA0 + (size_t)32 * 4 * 512, O_SA2 = O_SA1 + (size_t)32 * 4 * 512, O_SSH = O_SA2 + (size_t)32 * 4 * 512;
constexpr size_t O_SWKV = O_SSH + (size_t)32 * BCOLS, O_SC = O_SWKV + (size_t)32 * 12 * 64 * 64, O_END = O_SC + (size_t)32 * 8 * 128 * 128;
static_assert(O_END == 29191296, "output size");

constexpr size_t MiB = 1u << 20;
constexpr size_t WS_CTL = 0, CTL_ZERO_BYTES = 1 * MiB;
constexpr int CW_BAR = 4096;
constexpr size_t RSQ_OFF = 65536;
constexpr size_t WS_TAB = 1 * MiB;
constexpr size_t WS_SHB = 1 * MiB + 512 * 1024;
constexpr size_t WS_WIN0 = 2 * MiB;
constexpr size_t WS_WOUT0 = WS_WIN0 + (size_t)EC * D * 2;
constexpr size_t WS_WUP0 = WS_WOUT0 + (size_t)D * D * 2;
constexpr size_t WS_WDN0 = WS_WUP0 + (size_t)FF * D * 2;
constexpr size_t WS_WCIN = WS_WDN0 + (size_t)FF * D * 2;
constexpr size_t WS_WCOUT = WS_WCIN + (size_t)CC * D * 2;
constexpr size_t WS_WUP1 = WS_WCOUT + (size_t)D * D * 2;
constexpr size_t WS_WDN1 = WS_WUP1 + (size_t)FF * D * 2;
constexpr size_t WS_BUF0 = WS_WDN1 + (size_t)FF * D * 2;
constexpr size_t WS_BUF1 = WS_BUF0 + (size_t)MPAD * D * 2;
constexpr size_t WS_ATTO = WS_BUF1 + (size_t)MPAD * D * 2;
constexpr size_t WS_LSE = WS_ATTO + (size_t)3 * M * 256 * 2;
constexpr size_t WS_SQ = WS_LSE + (size_t)3 * M * 4 * 4;
constexpr size_t WS_A = ((WS_SQ + (size_t)MS * 3 * 1024 * 4 + 255) / 256) * 256;
constexpr size_t WS_B = WS_A + (size_t)MPAD * EC * 2;
constexpr int NPREP = 48 * T + 384 * ST;
constexpr size_t WS_END = WS_B + (size_t)NPREP * 1024;
constexpr size_t WS_QE = WS_B, WS_KE = WS_QE + (size_t)MP * D * 2, WS_KET = WS_KE + (size_t)MP * D * 2, WS_VT = WS_KET + (size_t)MP * D * 2, WS_EBL = WS_VT + (size_t)MP * D * 2;
static_assert(WS_EBL + (size_t)(MP / 16) * D * 4 <= WS_END, "region B");

constexpr int RING_BYTES = 131072, LDSCTL_OFF = RING_BYTES, MISC_OFF = LDSCTL_OFF + 320, BT_OFF = 135168, LDS_BYTES = 147456;
static_assert(BT_OFF + 12 * BT_LD * 4 <= LDS_BYTES && MISC_OFF + 128 <= BT_OFF, "LDS map");

#define RLX_AGENT __ATOMIC_RELAXED, __HIP_MEMORY_SCOPE_AGENT
#define LDS_WAIT() asm volatile("s_waitcnt lgkmcnt(0)" ::: "memory")
#define VM_WAIT() asm volatile("s_waitcnt vmcnt(0)" ::: "memory")
typedef __bf16 bf16x2_t __attribute__((ext_vector_type(2)));
__device__ __forceinline__ unsigned pk2(float lo, float hi) { const f32x2 v = {lo, hi}; const bf16x2_t b = __builtin_convertvector(v, bf16x2_t); return __builtin_bit_cast(unsigned, b); }
__device__ __forceinline__ unsigned f2bf(float f) { return pk2(f, 0.f) & 0xffffu; }
__device__ __forceinline__ float bf2f(unsigned short b) { return __uint_as_float((unsigned)b << 16); }
__device__ __forceinline__ float bflo(unsigned w) { return __uint_as_float(w << 16); }
__device__ __forceinline__ float bfhi(unsigned w) { return __uint_as_float(w & 0xffff0000u); }
__device__ __forceinline__ float wave_sum(float v) {
#pragma unroll
    for (int o = 1; o < 64; o <<= 1) v += __shfl_xor(v, o);
    return v;
}
__device__ __forceinline__ float wave_max(float v) {
#pragma unroll
    for (int o = 1; o < 64; o <<= 1) v = fmaxf(v, __shfl_xor(v, o));
    return v;
}
__device__ __forceinline__ float rcpf_(float x) { return __builtin_amdgcn_rcpf(x); }
__device__ __forceinline__ float sigmoidf_(float x) { return rcpf_(1.0f + __expf(-x)); }
__device__ __forceinline__ float siluf_(float x) { return x * rcpf_(1.0f + __expf(-x)); }

#define XB_TMO      128
#define XB_XCNT(j)  (256  + 64 * (j))
#define XB_XSUB(j)  (1280 + 64 * (j))
#define XB_XGEN(j)  (2304 + 64 * (j))
#define XB_TOP      3328
#define XB_TOPGEN   3392
#define XCD_BAR_WORDS 3456
#define XB_SPIN_CAP (1u << 18)

__device__ __forceinline__ unsigned xb_ld(unsigned* p)              { return __hip_atomic_load(p, __ATOMIC_RELAXED, __HIP_MEMORY_SCOPE_AGENT); }
__device__ __forceinline__ unsigned xb_add(unsigned* p, unsigned v) { return __hip_atomic_fetch_add(p, v, __ATOMIC_RELAXED, __HIP_MEMORY_SCOPE_AGENT); }
__device__ __forceinline__ unsigned xb_xcc_id() { return (unsigned)__builtin_amdgcn_s_getreg((3 << 11) | 20) & 0xFu; }
#define XB_SPIN(cond, bar) do { unsigned _sp = 0; while (cond) { __builtin_amdgcn_s_sleep(1); \
    if ((++_sp & 255u) == 0u) { if (xb_ld(&(bar)[XB_TMO])) break; if (_sp > XB_SPIN_CAP) { atomicAdd(&(bar)[XB_TMO], 1u); break; } } } } while (0)

struct XcdBarrier {
    unsigned* bar; unsigned x;
    volatile LAS unsigned* st;
};

__device__ __forceinline__ XcdBarrier xcd_barrier_post(unsigned* bar, volatile LAS unsigned* st) {
    XcdBarrier b; b.bar = bar; b.x = xb_xcc_id(); b.st = st;
    if (threadIdx.x == 0) (void)xb_add(&bar[XB_XCNT(b.x)], 1u);
    return b;
}
__device__ __forceinline__ void xcd_barrier_complete(unsigned* bar, unsigned x, unsigned& nloc, unsigned& nx) {
    const unsigned G = gridDim.x * gridDim.y * gridDim.z;
    unsigned sum, cnt, mine, sp = 0u;
    for (;;) {
        sum = 0u; cnt = 0u; mine = 0u;
#pragma unroll
        for (unsigned j = 0; j < 16; ++j) { const unsigned c = xb_ld(&bar[XB_XCNT(j)]); sum += c; cnt += (c > 0u) ? 1u : 0u; mine = (j == x) ? c : mine; }
        if (sum == G) break;
        __builtin_amdgcn_s_sleep(1);
        if ((++sp & 255u) == 0u) { if (xb_ld(&bar[XB_TMO])) break; if (sp > XB_SPIN_CAP) { atomicAdd(&bar[XB_TMO], 1u); break; } }
    }
    nloc = mine > 0u ? mine : 1u; nx = cnt > 0u ? cnt : 1u;
}

__device__ __forceinline__ void xcd_barrier(const XcdBarrier& b) {
    asm volatile("s_waitcnt vmcnt(0)" ::: "memory");
    __syncthreads();
    if (threadIdx.x == 0) {
        unsigned* bar = b.bar;
        __builtin_amdgcn_s_waitcnt(0);
        unsigned nloc = b.st[0], nx = b.st[1];
        if (nloc == 0u) { xcd_barrier_complete(bar, b.x, nloc, nx); b.st[0] = nloc; b.st[1] = nx; }
        const unsigned old = xb_add(&bar[XB_XSUB(b.x)], 1u);
        const unsigned gen = old / nloc;
        if (old + 1u == (gen + 1u) * nloc) {
            __builtin_amdgcn_fence(__ATOMIC_RELEASE, "agent");
            asm volatile("s_waitcnt vmcnt(0)" ::: "memory");
            const unsigned og = xb_add(&bar[XB_TOP], 1u);
            const unsigned tg = og / nx;
            if (og + 1u == (tg + 1u) * nx) xb_add(&bar[XB_TOPGEN], 1u);
            else XB_SPIN(xb_ld(&bar[XB_TOPGEN]) == tg, bar);
            __builtin_amdgcn_fence(__ATOMIC_ACQUIRE, "agent");
            xb_add(&bar[XB_XGEN(b.x)], 1u);
            asm volatile("s_waitcnt vmcnt(0)" ::: "memory");
        } else {
            XB_SPIN(xb_ld(&bar[XB_XGEN(b.x)]) == gen, bar);
            __builtin_amdgcn_fence(__ATOMIC_ACQUIRE, "agent");
            asm volatile("s_waitcnt vmcnt(0)" ::: "memory");
        }
    }
    __syncthreads();
}

struct Args { const float* in[31]; float* out; unsigned char* ws; int ph_lo, ph_hi, li, pad; };
enum { I_XP = 0, I_XS, I_CA0, I_CA1, I_CA2, I_SSH, I_SWKV, I_SC, I_RELB, I_NMIX, I_NMLP, I_NFIN, I_EWIN, I_EMU, I_EW0, I_EW2, I_EA0, I_EA2, I_EG2,
       I_EKK, I_EKA, I_ERK, I_ELNW, I_ELNB, I_EWOUT, I_CWIN, I_CLB, I_CNORM, I_CWOUT, I_MUP, I_MDN };

struct Frame {
    LAS unsigned char* lds;
    int tid, lane, wave, bid, gw;
};
constexpr int NGW = 256 * NWAVES, NGT = 256 * NTHR;

__device__ __forceinline__ void p0_transpose_item(const float* W, int K, int N, bf16* WT, const float* gain, LAS float* scr, int item, int lane) {
    const int nblk = N / 32, kb = item / nblk, nb = item % nblk, k0 = 64 * kb, n0 = 32 * nb;
#pragma unroll 8
    for (int i = 0; i < 32; ++i) { const int kk = 2 * i + (lane >> 5); const float gv = gain ? gain[k0 + kk] : 1.0f;
        scr[kk * 33 + (lane & 31)] = W[(size_t)(k0 + kk) * N + n0 + (lane & 31)] * gv; }
    LDS_WAIT(); asm volatile("" ::: "memory");
    const int c = lane & 7;
#pragma unroll
    for (int j = 0; j < 4; ++j) { const int n = (lane >> 3) + 8 * j; const LAS float* s = scr + (8 * c) * 33 + n;
        v4u o; o.x = pk2(s[0 * 33], s[1 * 33]); o.y = pk2(s[2 * 33], s[3 * 33]); o.z = pk2(s[4 * 33], s[5 * 33]); o.w = pk2(s[6 * 33], s[7 * 33]);
        *(GAS v4u*)(WT + (size_t)(n0 + n) * K + k0 + 8 * c) = o; }
    LDS_WAIT(); asm volatile("" ::: "memory");
}

__device__ __forceinline__ int t5_bucket(int dist) {
    if (dist < 16) return dist;
    const float d = (float)dist;
    int large = 16 + (int)(logf(d * (1.0f / 16.0f)) / 4.852030263919617f * 16.0f);
    return large < 31 ? large : 31;
}

constexpr int P0_I_IN = 16 * (ECR / 32), P0_I_SQ = 16 * 32, P0_I_UP = 16 * 128, P0_I_DN = 64 * 32;
constexpr int P0_NITEMS = P0_I_IN + P0_I_SQ + P0_I_UP + P0_I_DN + P0_I_UP + P0_I_SQ + P0_I_UP + P0_I_DN;
__device__ __forceinline__ void p0_convert_items(const Args& a, LAS float* scr, int lane, int first, int last, int wid, int nw) {
    unsigned char* ws = a.ws;
    for (int it = first + wid; it < last; it += nw) {
        int r = it;
        if (r < P0_I_IN) { p0_transpose_item(a.in[I_EWIN], D, ECR, (bf16*)(ws + WS_WIN0), a.in[I_NMIX], scr, r, lane); continue; } r -= P0_I_IN;
        if (r < P0_I_SQ) { p0_transpose_item(a.in[I_EWOUT], D, D, (bf16*)(ws + WS_WOUT0), nullptr, scr, r, lane); continue; } r -= P0_I_SQ;
        if (r < P0_I_UP) { p0_transpose_item(a.in[I_MUP], D, FF, (bf16*)(ws + WS_WUP0), a.in[I_NMLP], scr, r, lane); continue; } r -= P0_I_UP;
        if (r < P0_I_DN) { p0_transpose_item(a.in[I_MDN], FF, D, (bf16*)(ws + WS_WDN0), nullptr, scr, r, lane); continue; } r -= P0_I_DN;
        if (r < P0_I_UP) { p0_transpose_item(a.in[I_CWIN], D, CC, (bf16*)(ws + WS_WCIN), a.in[I_NMIX] + D, scr, r, lane); continue; } r -= P0_I_UP;
        if (r < P0_I_SQ) { p0_transpose_item(a.in[I_CWOUT], D, D, (bf16*)(ws + WS_WCOUT), nullptr, scr, r, lane); continue; } r -= P0_I_SQ;
        if (r < P0_I_UP) { p0_transpose_item(a.in[I_MUP] + (size_t)D * FF, D, FF, (bf16*)(ws + WS_WUP1), a.in[I_NMLP] + D, scr, r, lane); continue; } r -= P0_I_UP;
        p0_transpose_item(a.in[I_MDN] + (size_t)FF * D, FF, D, (bf16*)(ws + WS_WDN1), nullptr, scr, r, lane);
    }
}

__device__ __forceinline__ void p0_prologue(const Args& a, Frame& F) {
    unsigned char* ws = a.ws;
    LAS float* scr = (LAS float*)(F.lds + F.wave * 16384);
    p0_convert_items(a, scr, F.lane, 0, P0_I_IN, F.gw, NGW);
    const int gt = F.bid * NTHR + F.tid;
    { v4u* z = (v4u*)(ws + WS_WIN0 + (size_t)ECR * D * 2); const int n = (EC - ECR) * D * 2 / 16;
      for (int i = gt; i < n; i += NGT) z[i] = (v4u){0u, 0u, 0u, 0u}; }
    { float* BT = (float*)(ws + WS_TAB); const float* rb = a.in[I_RELB];
      for (int i = gt; i < 12 * 129; i += NGT) { const int hd = i / 129, j = i % 129, g = hd >> 2; const int dist = j << (2 * g);
          BT[hd * BT_LD + j] = rb[t5_bucket(dist) * 12 + hd] * LOG2E; }
      float* LB = (float*)(ws + WS_TAB + 8192); const float* lr = a.in[I_CLB];
      for (int i = gt; i < 1024; i += NGT) LB[i] = 1.0f / (1.0f + expf(lr[i] - lr[1024 + i]));
      bf16* LW = (bf16*)(ws + WS_TAB + 16384); const float* w2 = a.in[I_EW2]; const float* a2 = a.in[I_EA2]; const float* g2 = a.in[I_EG2];
      for (int i = gt; i < BW * LORA; i += NGT) { const int ch = i / LORA, j = i % LORA;
          const float v = j < 64 ? w2[j * BW + ch] : (j < 128 ? a2[(j - 64) * BW + ch] : g2[(j - 128) * BW + ch]);
          LW[i] = (bf16)f2bf(v); } }
    { bf16* SHB = (bf16*)(ws + WS_SHB); const float* ss = a.in[I_SSH];
      for (int i = gt; i < 33 * BCOLS; i += NGT) SHB[i] = (i < 32 * BCOLS) ? (bf16)f2bf(ss[i]) : (bf16)0; }
    { bf16* B0 = (bf16*)(ws + WS_BUF0); bf16* B1 = (bf16*)(ws + WS_BUF1); float* rsq0 = (float*)(ws + WS_CTL + RSQ_OFF);
      for (int m = F.gw; m < MPAD; m += NGW) {
          unsigned long long* o8 = (unsigned long long*)(B0 + (size_t)m * D) + F.lane;
          if (m < M) {
              const float* xr = (m < MP) ? (a.in[I_XP] + (size_t)m * D) : (a.in[I_XS] + (size_t)(m - MP) * D);
              const f32x4* x4 = (const f32x4*)xr + F.lane; f32x4 v[4]; float s = 0.f;
#pragma unroll
              for (int j = 0; j < 4; ++j) { v[j] = x4[64 * j]; s += (v[j].x * v[j].x + v[j].y * v[j].y) + (v[j].z * v[j].z + v[j].w * v[j].w); }
              s = wave_sum(s);
#pragma unroll
              for (int j = 0; j < 4; ++j) o8[64 * j] = (unsigned long long)pk2(v[j].x, v[j].y) | ((unsigned long long)pk2(v[j].z, v[j].w) << 32);
              if (F.lane == 0) rsq0[m] = s;
          } else {
              unsigned long long* p8 = (unsigned long long*)(B1 + (size_t)m * D) + F.lane;
#pragma unroll
              for (int j = 0; j < 4; ++j) { o8[64 * j] = 0ull; p8[64 * j] = 0ull; }
          }
      } }
}

__device__ __forceinline__ f32x16 mfma32(bf16x8 a, bf16x8 b, f32x16 c) { return __builtin_amdgcn_mfma_f32_32x32x16_bf16(a, b, c, 0, 0, 0); }
__device__ __forceinline__ f32x4 mfma16(bf16x8 a, bf16x8 b, f32x4 c) { return __builtin_amdgcn_mfma_f32_16x16x32_bf16(a, b, c, 0, 0, 0); }

struct SEpiScale {
    bf16* O; int ldc; const float* rsq; int relu2;
    __device__ __forceinline__ void operator()(int row, int col, f32x4 v, int fq) const {
        const float s = __builtin_amdgcn_rsqf(rsq[row] * (1.0f / 1024.0f) + EPS);
        v = v * s;
        if (relu2) { v.x = fmaxf(v.x, 0.f); v.y = fmaxf(v.y, 0.f); v.z = fmaxf(v.z, 0.f); v.w = fmaxf(v.w, 0.f); v = v * v; }
        v2u w; w.x = pk2(v.x, v.y); w.y = pk2(v.z, v.w);
        *(v2u*)(O + (size_t)row * ldc + col) = w;
    }
};
struct SEpiResid {
    const float* R; float* X; bf16* XB; float* rsq;
    __device__ __forceinline__ void operator()(int row, int col, f32x4 v, int fq) const {
        const size_t o = (size_t)(row - MP) * 1024 + col;
        const f32x4 x = *(const f32x4*)(R + o) + v;
        *(f32x4*)(X + o) = x;
        v2u w; w.x = pk2(x.x, x.y); w.y = pk2(x.z, x.w);
        *(v2u*)(XB + (size_t)row * 1024 + col) = w;
        float ss = (x.x * x.x + x.y * x.y) + (x.z * x.z + x.w * x.w);
        ss += __shfl_xor(ss, 16); ss += __shfl_xor(ss, 32);
        if (fq == 0) unsafeAtomicAdd(rsq + row, ss);
    }
};
template <class Epi>
__device__ __forceinline__ void sgemm_phase(Frame& F, const bf16* __restrict__ A, const bf16* __restrict__ Bt, int N, int K, const Epi& E) {
    const int fr = F.lane & 15, fq = F.lane >> 4, w = F.wave;
    const int kw = K >> 3;
    LAS f32x4* red = (LAS f32x4*)F.lds;
    for (int u = F.bid; u < (N >> 4); u += 256) {
        const int n0 = u << 4;
        f32x4 acc[8];
#pragma unroll
        for (int mt = 0; mt < 8; ++mt) acc[mt] = (f32x4){0.f, 0.f, 0.f, 0.f};
        const bf16* ap = A + (size_t)(MP + fr) * K + w * kw + 8 * fq;
        const bf16* bp = Bt + (size_t)(n0 + fr) * K + w * kw + 8 * fq;
        for (int k0 = 0; k0 < kw; k0 += 128) {
            bf16x8 bfr[4], afr[4][8];
#pragma unroll
            for (int kk = 0; kk < 4; ++kk) { const int k = k0 + 32 * kk;
                bfr[kk] = *(const bf16x8*)(bp + k);
#pragma unroll
                for (int mt = 0; mt < 8; ++mt) afr[kk][mt] = *(const bf16x8*)(ap + (size_t)(16 * mt) * K + k); }
#pragma unroll
            for (int kk = 0; kk < 4; ++kk)
#pragma unroll
                for (int mt = 0; mt < 8; ++mt) acc[mt] = mfma16(bfr[kk], afr[kk][mt], acc[mt]);
        }
#pragma unroll
        for (int mt = 0; mt < 8; ++mt) red[(w * 8 + mt) * 64 + F.lane] = acc[mt];
        __syncthreads();
        f32x4 sum = red[(0 * 8 + w) * 64 + F.lane];
#pragma unroll
        for (int j = 1; j < 8; ++j) sum = sum + red[(j * 8 + w) * 64 + F.lane];
        E(MP + 16 * w + fr, n0 + 4 * fq, sum, fq);
        __syncthreads();
    }
}


constexpr int AT_ROW = 144, AT_K = 0, AT_V = 384 * AT_ROW;
static_assert(2 * 384 * AT_ROW <= RING_BYTES && 8 * 32 * AT_ROW <= AT_V, "attention LDS");
__device__ __forceinline__ void attn_block(Frame& F, const bf16* __restrict__ PROJ, const LAS float* bt, bf16* ATTO, float* LSE, int btask) {
    const int lane = F.lane, w = F.wave;
    const int ti8 = btask & 15; int rest = btask >> 4; const int hs = rest & 3; rest >>= 2; const int g = rest % 3; const int b = rest / 3;
    const int dsh = 2 * g, dil = 1 << dsh, tpr = (T >> dsh) >> 5;
    const int r = (ti8 * 8) / tpr, s0blk = ((ti8 * 8) % tpr) * 32, hd = 4 * g + hs;
    const int q = lane & 31, hh = lane >> 5;
    const size_t rowbase = (size_t)b * T + r;
    const int s0 = s0blk + 32 * w;
    const bf16* Qp = PROJ + (rowbase + (size_t)dil * (s0 + q)) * EC + hd * 64 + 8 * hh;
    bf16x8 qf[4];
#pragma unroll
    for (int ks = 0; ks < 4; ++ks) qf[ks] = *(const bf16x8*)(Qp + 16 * ks);
    {
        v4u stg[12];
#pragma unroll
        for (int i = 0; i < 12; ++i) { const int idx = F.tid + NTHR * i, kv = idx / 3072, rem = idx - kv * 3072, row = rem >> 3, piece = rem & 7;
            int sk = s0blk - 128 + row; sk = sk < 0 ? 0 : sk;
            stg[i] = *(const v4u*)(PROJ + (rowbase + (size_t)dil * sk) * EC + (1 + kv) * BW + hd * 64 + piece * 8); }
#pragma unroll
        for (int i = 0; i < 12; ++i) { const int idx = F.tid + NTHR * i, kv = idx / 3072, rem = idx - kv * 3072, row = rem >> 3, piece = rem & 7;
            *(LAS v4u*)(F.lds + (kv ? AT_V : AT_K) + row * AT_ROW + piece * 16) = stg[i]; }
    }
    __syncthreads();
    f32x16 o0, o1;
#pragma unroll
    for (int i = 0; i < 16; ++i) { o0[i] = 0.f; o1[i] = 0.f; }
    float mrun = -1e30f, lrun = 0.f;
    const LAS float* btp = bt + hd * BT_LD;
    for (int kt = 4; kt >= 0; --kt) {
        const int kbase = s0 - 128 + 32 * kt;
        if (kbase + 31 < 0) break;
        const int kb = 32 * w + 32 * kt;
        const LAS unsigned char* kp = F.lds + AT_K + (kb + q) * AT_ROW + 16 * hh;
        bf16x8 kf[4];
#pragma unroll
        for (int ks = 0; ks < 4; ++ks) kf[ks] = *(const LAS bf16x8*)(kp + 32 * ks);
        bf16x8 vf[2][2];
#pragma unroll
        for (int s = 0; s < 2; ++s)
#pragma unroll
            for (int j = 0; j < 8; ++j) {
                const int key = 16 * s + 8 * (j >> 2) + 4 * hh + (j & 3);
                const LAS unsigned short* vp = (const LAS unsigned short*)(F.lds + AT_V + (kb + key) * AT_ROW) + q;
                vf[s][0][j] = (short)vp[0]; vf[s][1][j] = (short)vp[32];
            }
        f32x16 sacc;
#pragma unroll
        for (int i = 0; i < 16; ++i) sacc[i] = 0.f;
#pragma unroll
        for (int ks = 0; ks < 4; ++ks) sacc = mfma32(kf[ks], qf[ks], sacc);
        float x[16]; float tmax = -1e30f;
#pragma unroll
        for (int reg = 0; reg < 16; ++reg) {
            const int i = (reg & 3) + 8 * (reg >> 2) + 4 * hh;
            const int jj = q - i + 128 - 32 * kt;
            const bool valid = (jj >= 0) && (jj <= 128) && (kbase + i >= 0);
            const int jc = jj < 0 ? 0 : (jj > 128 ? 128 : jj);
            const float bv = btp[jc];
            x[reg] = valid ? (sacc[reg] * QSCALE2 + bv) : -1e30f;
            tmax = fmaxf(tmax, x[reg]);
        }
        tmax = fmaxf(tmax, __shfl_xor(tmax, 32));
        const float mnew = fmaxf(mrun, tmax);
        const float alpha = __builtin_amdgcn_exp2f(mrun - mnew);
        float psum = 0.f; float p[16];
#pragma unroll
        for (int reg = 0; reg < 16; ++reg) { p[reg] = __builtin_amdgcn_exp2f(x[reg] - mnew); psum += p[reg]; }
        psum += __shfl_xor(psum, 32);
        lrun = lrun * alpha + psum; mrun = mnew;
#pragma unroll
        for (int i = 0; i < 16; ++i) { o0[i] *= alpha; o1[i] *= alpha; }
        v4u pw0, pw1;
        pw0.x = pk2(p[0], p[1]); pw0.y = pk2(p[2], p[3]); pw0.z = pk2(p[4], p[5]); pw0.w = pk2(p[6], p[7]);
        pw1.x = pk2(p[8], p[9]); pw1.y = pk2(p[10], p[11]); pw1.z = pk2(p[12], p[13]); pw1.w = pk2(p[14], p[15]);
        const bf16x8 pf0 = __builtin_bit_cast(bf16x8, pw0), pf1 = __builtin_bit_cast(bf16x8, pw1);
        o0 = mfma32(vf[0][0], pf0, o0); o0 = mfma32(vf[1][0], pf1, o0);
        o1 = mfma32(vf[0][1], pf0, o1); o1 = mfma32(vf[1][1], pf1, o1);
    }
    const float inv = rcpf_(lrun);
    __syncthreads();
    {
        LAS unsigned char* ob = F.lds + w * (32 * AT_ROW);
        LAS unsigned char* op = ob + q * AT_ROW + 8 * hh;
#pragma unroll
        for (int rg = 0; rg < 4; ++rg) {
            *(LAS v2u*)(op + 16 * rg) = (v2u){pk2(o0[4 * rg] * inv, o0[4 * rg + 1] * inv), pk2(o0[4 * rg + 2] * inv, o0[4 * rg + 3] * inv)};
            *(LAS v2u*)(op + 64 + 16 * rg) = (v2u){pk2(o1[4 * rg] * inv, o1[4 * rg + 1] * inv), pk2(o1[4 * rg + 2] * inv, o1[4 * rg + 3] * inv)};
        }
#pragma unroll
        for (int ps = 0; ps < 4; ++ps) { const int row = 8 * ps + (lane >> 3), piece = lane & 7;
            const v4u v = *(const LAS v4u*)(ob + row * AT_ROW + piece * 16);
            *(v4u*)(ATTO + ((size_t)g * M + rowbase + (size_t)dil * (s0 + row)) * 256 + hs * 64 + piece * 8) = v; }
    }
    if (hh == 0) LSE[((size_t)g * M + rowbase + (size_t)dil * (s0 + q)) * 4 + hs] = mrun + __log2f(lrun);
    __syncthreads();
}

__device__ __forceinline__ void sattn_task(const Args& a, const bf16* __restrict__ PROJ, const LAS float* bt, bf16* ATTO, float* LSE, LAS float* scr, int task, int lane) {
    const int t = task & 3, hd = (task >> 2) % 12, bs = task / 48, g = hd >> 2, hs = hd & 3, dsh = 2 * g, dil = 1 << dsh, W = 128 << dsh;
    const float* cache = a.in[I_CA0 + g];
    const LAS float* btp = bt + hd * BT_LD;
    LAS float* qs = scr; LAS float* ps = scr + 64;
    const size_t m0 = (size_t)MP + bs * 4;
    qs[lane] = bf2f(PROJ[(m0 + t) * EC + hd * 64 + lane]) * QSCALE2;
    LDS_WAIT(); asm volatile("" ::: "memory");
    float xv[3]; float mx = -1e30f;
#pragma unroll
    for (int ksl = 0; ksl < 3; ++ksl) {
        const int j = lane + 64 * ksl; float x = -1e30f;
        if (j <= 128) {
            const int rho = W + t - j * dil; float dot = 0.f;
            if (rho >= W) {
                const bf16* kp = PROJ + (m0 + (rho - W)) * EC + BW + hd * 64;
#pragma unroll 8
                for (int d = 0; d < 64; ++d) dot += bf2f(kp[d]) * qs[d];
            } else {
                const float* kp = cache + (((size_t)bs * W + rho) * 2 + 0) * 256 + hs * 64;
                f32x4 kv[16];
#pragma unroll
                for (int d4 = 0; d4 < 16; ++d4) kv[d4] = *(const f32x4*)(kp + 4 * d4);
#pragma unroll
                for (int d4 = 0; d4 < 16; ++d4) { const LAS float* qq = qs + 4 * d4; dot += kv[d4].x * qq[0] + kv[d4].y * qq[1] + kv[d4].z * qq[2] + kv[d4].w * qq[3]; }
            }
            x = dot + btp[j];
        }
        xv[ksl] = x; mx = fmaxf(mx, x);
    }
    mx = wave_max(mx);
    float psum = 0.f;
#pragma unroll
    for (int ksl = 0; ksl < 3; ++ksl) { const int j = lane + 64 * ksl; const float p = (j <= 128) ? __builtin_amdgcn_exp2f(xv[ksl] - mx) : 0.f; psum += p; if (j <= 128) ps[j] = p; }
    psum = wave_sum(psum);
    LDS_WAIT(); asm volatile("" ::: "memory");
    float acc = 0.f;
    for (int j = 0; j <= 128; ++j) { const int rho = W + t - j * dil; if (rho < W) break; acc += ps[j] * bf2f(PROJ[(m0 + (rho - W)) * EC + 2 * BW + hd * 64 + lane]); }
    const int jc0 = t / dil + 1;
    const float* vb = cache + (((size_t)bs * W + (W + t)) * 2 + 1) * 256 + hs * 64 + lane;
    int j = jc0;
    for (; j + 16 <= 129; j += 16) {
        float vv[16];
#pragma unroll
        for (int u = 0; u < 16; ++u) vv[u] = vb[-(long)(j + u) * dil * 512];
#pragma unroll
        for (int u = 0; u < 16; ++u) acc += ps[j + u] * vv[u];
    }
    for (; j <= 128; ++j) acc += ps[j] * vb[-(long)j * dil * 512];
    ATTO[((size_t)g * M + m0 + t) * 256 + hs * 64 + lane] = (bf16)f2bf(acc * rcpf_(psum));
    if (lane == 0) LSE[((size_t)g * M + m0 + t) * 4 + hs] = mx + __log2f(psum);
    LDS_WAIT(); asm volatile("" ::: "memory");
}

__device__ __forceinline__ f32x4 ld4bf(const bf16* p) { const v2u w = *(const v2u*)p; return (f32x4){bflo(w.x), bfhi(w.x), bflo(w.y), bfhi(w.y)}; }
__device__ __forceinline__ void kv_copies(const bf16* __restrict__ PROJ, float* out, int gt) {
#pragma unroll
    for (int g = 0; g < 3; ++g) {
        const int Wp = 128 << (2 * g); const size_t off = g == 0 ? O_PA0 : (g == 1 ? O_PA1 : O_PA2);
        const int n4 = NB * Wp * 128;
        for (int i4 = gt; i4 < n4; i4 += NGT) { const int i = i4 * 4; const int d = i & 63, hs = (i >> 6) & 3, kv = (i >> 8) & 1, rr = i >> 9, ii = rr % Wp, b = rr / Wp;
            *(f32x4*)(out + off + i) = ld4bf(PROJ + ((size_t)b * T + (T - Wp) + ii) * EC + (1 + kv) * BW + (4 * g + hs) * 64 + d); }
        const size_t soff = g == 0 ? O_SA0 : (g == 1 ? O_SA1 : O_SA2);
        for (int i4 = gt; i4 < SB * ST * 128; i4 += NGT) { const int i = i4 * 4; const int d = i & 63, hs = (i >> 6) & 3, kv = (i >> 8) & 1, rr = i >> 9;
            *(f32x4*)(out + soff + i) = ld4bf(PROJ + ((size_t)MP + rr) * EC + (1 + kv) * BW + (4 * g + hs) * 64 + d); }
    }
    for (int i4 = gt; i4 < NB * BCOLS / 4; i4 += NGT) { const int i = i4 * 4; const int b = i / BCOLS, c = i % BCOLS; *(f32x4*)(out + O_PSH + i) = ld4bf(PROJ + ((size_t)b * T + T - 1) * EC + AQKV + c); }
    for (int i4 = gt; i4 < SB * BCOLS / 4; i4 += NGT) { const int i = i4 * 4; const int b = i / BCOLS, c = i % BCOLS; *(f32x4*)(out + O_SSH + i) = ld4bf(PROJ + ((size_t)MP + b * 4 + 3) * EC + AQKV + c); }
}

__device__ __forceinline__ void xs8(const bf16* cur, const bf16* prv, const float* mu, int col, float* o) {
    const v4u c8 = *(const v4u*)(cur + col), p8 = *(const v4u*)(prv + col);
    const f32x4 m0 = *(const f32x4*)(mu + col), m1 = *(const f32x4*)(mu + col + 4);
    const float c[8] = {bflo(c8.x), bfhi(c8.x), bflo(c8.y), bfhi(c8.y), bflo(c8.z), bfhi(c8.z), bflo(c8.w), bfhi(c8.w)};
    const float p[8] = {bflo(p8.x), bfhi(p8.x), bflo(p8.y), bfhi(p8.y), bflo(p8.z), bfhi(p8.z), bflo(p8.w), bfhi(p8.w)};
    const float mm[8] = {m0.x, m0.y, m0.z, m0.w, m1.x, m1.y, m1.z, m1.w};
#pragma unroll
    for (int i = 0; i < 8; ++i) o[i] = c[i] + (p[i] - c[i]) * mm[i];
}
__device__ __forceinline__ f32x4 xs4(const bf16* cur, const bf16* prv, const float* mu, int col) {
    const v2u c4 = *(const v2u*)(cur + col), p4 = *(const v2u*)(prv + col);
    const f32x4 c = (f32x4){bflo(c4.x), bfhi(c4.x), bflo(c4.y), bfhi(c4.y)}, p = (f32x4){bflo(p4.x), bfhi(p4.x), bflo(p4.y), bfhi(p4.y)};
    const f32x4 m = *(const f32x4*)(mu + col);
    return c + (p - c) * m;
}

constexpr int PB_ROW = BCOLS * 2, PB_PIECES = PB_ROW / 16, PB_AF_OFF = 20 * PB_ROW, PB_SCR_OFF = PB_AF_OFF + 9 * 64 * 16, PB_SCR_W = 2048;
static_assert(PB_SCR_OFF + 8 * PB_SCR_W <= BT_OFF, "prep LDS");
__device__ __forceinline__ f32x4 lxs4(const LAS unsigned char* cur, const float* mu, int col) {
    const v2u c4 = *(const LAS v2u*)(cur + 2 * col), p4 = *(const LAS v2u*)(cur - PB_ROW + 2 * col);
    const f32x4 c = (f32x4){bflo(c4.x), bfhi(c4.x), bflo(c4.y), bfhi(c4.y)}, p = (f32x4){bflo(p4.x), bfhi(p4.x), bflo(p4.y), bfhi(p4.y)};
    const f32x4 m = *(const f32x4*)(mu + col);
    return c + (p - c) * m;
}
template <int PV>
__device__ __forceinline__ void prep_block(const Args& a, Frame& F, const bf16* __restrict__ PROJ, const bf16* __restrict__ LW, const bf16* __restrict__ SHB, unsigned char* PREP, int task) {
    const int lane = F.lane, tok = lane & 15, g4 = lane >> 4, w = F.wave;
    const bool samp = task >= MP / 16;
    const int nrows = samp ? 20 : 17;
    if (!(PV & 8)) {
        v4u stg[13];
#pragma unroll
        for (int i = 0; i < 13; ++i) { const int idx = F.tid + NTHR * i;
            if (idx < nrows * PB_PIECES) {
                const int row = idx / PB_PIECES, piece = idx - row * PB_PIECES;
                const bf16* src;
                if (!samp) { const int m = task * 16 - 1 + row; src = (row == 0 && ((task * 16) & (T - 1)) == 0) ? (SHB + 32 * BCOLS) : (PROJ + (size_t)m * EC + AQKV); }
                else { const int q = row / 5, rr = row - 5 * q, seq = (task - MP / 16) * 4 + q; src = (rr == 0) ? (SHB + seq * BCOLS) : (PROJ + (size_t)(MP + seq * 4 + rr - 1) * EC + AQKV); }
                stg[i] = *(const v4u*)(src + piece * 8); }
            else stg[i] = (v4u){0u, 0u, 0u, 0u}; }
#pragma unroll
        for (int i = 0; i < 13; ++i) { const int idx = F.tid + NTHR * i;
            if (idx < nrows * PB_PIECES) { const int row = idx / PB_PIECES, piece = idx - row * PB_PIECES; *(LAS v4u*)(F.lds + row * PB_ROW + piece * 16) = stg[i]; } }
    }
    __syncthreads();
    const int crow = samp ? (5 * (tok >> 2) + 1 + (tok & 3)) : (tok + 1);
    const LAS unsigned char* cur = F.lds + crow * PB_ROW;
    const float* mu = a.in[I_EMU];
    for (int ks = w; ks < 9; ks += 8) {
        const int col = 3 * BW + 32 * ks + 8 * g4;
        const v4u c8 = *(const LAS v4u*)(cur + 2 * col), p8 = *(const LAS v4u*)(cur - PB_ROW + 2 * col);
        const f32x4 m0 = *(const f32x4*)(mu + col), m1 = *(const f32x4*)(mu + col + 4);
        const float c[8] = {bflo(c8.x), bfhi(c8.x), bflo(c8.y), bfhi(c8.y), bflo(c8.z), bfhi(c8.z), bflo(c8.w), bfhi(c8.w)};
        const float p[8] = {bflo(p8.x), bfhi(p8.x), bflo(p8.y), bfhi(p8.y), bflo(p8.z), bfhi(p8.z), bflo(p8.w), bfhi(p8.w)};
        const float mm[8] = {m0.x, m0.y, m0.z, m0.w, m1.x, m1.y, m1.z, m1.w};
        float v[8];
#pragma unroll
        for (int i = 0; i < 8; ++i) {
            v[i] = c[i] + (p[i] - c[i]) * mm[i];
            if (ks < 2) { const float e = __expf(2.0f * v[i]); v[i] = 1.0f - 2.0f * rcpf_(e + 1.0f); }
            else if (ks >= 4) v[i] = sigmoidf_(v[i]);
        }
        *(LAS v4u*)(F.lds + PB_AF_OFF + (ks * 64 + lane) * 16) = (v4u){pk2(v[0], v[1]), pk2(v[2], v[3]), pk2(v[4], v[5]), pk2(v[6], v[7])};
    }
    __syncthreads();
    bf16x8 af[9];
#pragma unroll
    for (int ks = 0; ks < 9; ++ks) af[ks] = *(const LAS bf16x8*)(F.lds + PB_AF_OFF + (ks * 64 + lane) * 16);
    size_t ebase0; int estride;
    if (!samp) { const int m0 = task * 16, t0 = m0 & (T - 1), b = m0 >> 12; ebase0 = (size_t)(b * 12) * T + t0; estride = T; }
    else { const int sb0 = (task - MP / 16) * 4; ebase0 = (size_t)48 * T + (size_t)(sb0 * 12) * 4; estride = 4; }
    LAS unsigned char* scr = F.lds + PB_SCR_OFF + w * PB_SCR_W;
    const float* k_k = a.in[I_EKK];
#pragma unroll 1
    for (int h = w; h < 12; h += 8) {
        f32x4 kr[4];
        float ssq = 0.f;
#pragma unroll
        for (int nt = 0; nt < 4; ++nt) {
            const int c4 = h * 64 + 16 * nt + 4 * g4;
            kr[nt] = lxs4(cur, mu, BW + c4);
            const f32x4 kkr = kr[nt] * *(const f32x4*)(k_k + c4);
            ssq += (kkr.x * kkr.x + kkr.y * kkr.y) + (kkr.z * kkr.z + kkr.w * kkr.w);
        }
        ssq += __shfl_xor(ssq, 16); ssq += __shfl_xor(ssq, 32);
        const float kinv = rcpf_(fmaxf(__builtin_amdgcn_sqrtf(ssq), 1e-12f));
        v2u pkv[7][4];
#pragma unroll
        for (int nt = 0; nt < 4; ++nt) {
            const bf16* lwp = LW + (size_t)(h * 64 + 16 * nt + tok) * LORA + 8 * g4;
            f32x4 aw = (f32x4){0.f, 0.f, 0.f, 0.f}, aa = aw, ag = aw;
            if (!(PV & 1)) {
#pragma unroll
            for (int ks = 0; ks < 9; ++ks) { const bf16x8 bw = *(const bf16x8*)(lwp + 32 * ks);
                if (ks < 2) aw = mfma16(bw, af[ks], aw); else if (ks < 4) aa = mfma16(bw, af[ks], aa); else ag = mfma16(bw, af[ks], ag); }
            } else { aw = __builtin_bit_cast(f32x4, af[nt]); aa = __builtin_bit_cast(f32x4, af[nt + 4]); ag = aw; }
            const int c4 = h * 64 + 16 * nt + 4 * g4, cl = 16 * nt + 4 * g4;
            const f32x4 w0 = *(const f32x4*)(a.in[I_EW0] + c4), a0 = *(const f32x4*)(a.in[I_EA0] + c4), kkc = *(const f32x4*)(k_k + c4), kac = *(const f32x4*)(a.in[I_EKA] + c4);
            f32x4 dec, av, kk, kp, bb;
#pragma unroll
            for (int i = 0; i < 4; ++i) {
                const float z = -(w0[i] + aw[i]);
                if (!(PV & 2)) {
                const float sp = fmaxf(z, 0.f) + __logf(1.0f + __expf(-fabsf(z)));
                const float ww = -sp - 0.5f;
                dec[i] = __expf(ww);
                av[i] = sigmoidf_(a0[i] + aa[i]);
                } else { dec[i] = z; av[i] = a0[i] + aa[i]; }
                kk[i] = kr[nt][i] * kkc[i] * kinv;
                kp[i] = kr[nt][i] * (1.0f + (av[i] - 1.0f) * kac[i]);
                bb[i] = kk[i] * av[i];
            }
            const f32x4 rr4 = lxs4(cur, mu, c4), vr4 = lxs4(cur, mu, 2 * BW + c4);
            const f32x4 ew = dec;
            pkv[0][nt] = (v2u){pk2(rr4.x, rr4.y), pk2(rr4.z, rr4.w)};
            pkv[1][nt] = (v2u){pk2(kp.x, kp.y), pk2(kp.z, kp.w)};
            pkv[2][nt] = (v2u){pk2(vr4.x, vr4.y), pk2(vr4.z, vr4.w)};
            pkv[3][nt] = (v2u){pk2(kk.x, kk.y), pk2(kk.z, kk.w)};
            pkv[4][nt] = (v2u){pk2(bb.x, bb.y), pk2(bb.z, bb.w)};
            pkv[5][nt] = (v2u){pk2(ag.x, ag.y), pk2(ag.z, ag.w)};
            pkv[6][nt] = (v2u){pk2(ew.x, ew.y), pk2(ew.z, ew.w)};
        }
        unsigned char* Et[4];
#pragma unroll
        for (int sI = 0; sI < 4; ++sI) { const int tt = 4 * sI + (lane >> 4);
            size_t eidx = ebase0 + (size_t)h * estride + (samp ? (size_t)((tt >> 2) * 48 + (tt & 3)) : (size_t)tt);
            if (PV) eidx &= 65535;
            Et[sI] = PREP + eidx * 1024 + 8 * (lane & 15); }
#pragma unroll
        for (int vI = 0; vI < 7; ++vI) {
#pragma unroll
            for (int nt = 0; nt < 4; ++nt) *(LAS v2u*)(scr + tok * 128 + 2 * (16 * nt + 4 * g4)) = pkv[vI][nt];
#pragma unroll
            for (int sI = 0; sI < 4; ++sI) { const v2u ov = *(const LAS v2u*)(scr + (4 * sI + (lane >> 4)) * 128 + 8 * (lane & 15)); if (!(PV & 4)) *(v2u*)(Et[sI] + 128 * vI) = ov; else asm volatile("" :: "v"(ov.x), "v"(ov.y)); }
        }
    }
    __syncthreads();
}

__device__ __forceinline__ float row16_sum(float x) {
    x += __int_as_float(__builtin_amdgcn_mov_dpp(__float_as_int(x), 0x128, 0xf, 0xf, false));
    x += __int_as_float(__builtin_amdgcn_mov_dpp(__float_as_int(x), 0x124, 0xf, 0xf, false));
    x += __int_as_float(__builtin_amdgcn_mov_dpp(__float_as_int(x), 0x122, 0xf, 0xf, false));
    x += __int_as_float(__builtin_amdgcn_mov_dpp(__float_as_int(x), 0x121, 0xf, 0xf, false));
    return x;
}
__device__ __forceinline__ void row16_sum2(float& a, float& b) {
    asm("s_nop 1\n\t"
        "v_add_f32_dpp %0, %0, %0 row_ror:8 row_mask:0xf bank_mask:0xf\n\t"
        "v_add_f32_dpp %1, %1, %1 row_ror:8 row_mask:0xf bank_mask:0xf\n\t"
        "s_nop 0\n\t"
        "v_add_f32_dpp %0, %0, %0 row_ror:4 row_mask:0xf bank_mask:0xf\n\t"
        "v_add_f32_dpp %1, %1, %1 row_ror:4 row_mask:0xf bank_mask:0xf\n\t"
        "s_nop 0\n\t"
        "v_add_f32_dpp %0, %0, %0 row_ror:2 row_mask:0xf bank_mask:0xf\n\t"
        "v_add_f32_dpp %1, %1, %1 row_ror:2 row_mask:0xf bank_mask:0xf\n\t"
        "s_nop 0\n\t"
        "v_add_f32_dpp %0, %0, %0 row_ror:1 row_mask:0xf bank_mask:0xf\n\t"
        "v_add_f32_dpp %1, %1, %1 row_ror:1 row_mask:0xf bank_mask:0xf\n\t"
        "s_nop 1"
        : "+v"(a), "+v"(b));
}
__device__ __forceinline__ float wkv_step(f32x4& S, const f32x4 d, const f32x4 kk, const f32x4 bb, const f32x4 kp, const f32x4 r, const float v) {
    float p = S.x * kk.x; p = fmaf(S.y, kk.y, p); p = fmaf(S.z, kk.z, p); p = fmaf(S.w, kk.w, p);
    const float sa = -row16_sum(p);
    S.x = fmaf(sa, bb.x, fmaf(S.x, d.x, v * kp.x));
    S.y = fmaf(sa, bb.y, fmaf(S.y, d.y, v * kp.y));
    S.z = fmaf(sa, bb.z, fmaf(S.z, d.z, v * kp.z));
    S.w = fmaf(sa, bb.w, fmaf(S.w, d.w, v * kp.w));
    float y = S.x * r.x; y = fmaf(S.y, r.y, y); y = fmaf(S.z, r.z, y); y = fmaf(S.w, r.w, y);
    return row16_sum(y);
}
__device__ __forceinline__ float wkv_step_p(f32x4& S, float& ypart, const f32x4 d, const f32x4 kk, const f32x4 bb, const f32x4 kp, const f32x4 r, const float v) {
    float s0 = S.x, s1 = S.y, s2 = S.z, s3 = S.w, y = ypart, p, t;
    asm("v_mul_f32 %5, %0, %7\n\t"
        "v_fmac_f32 %5, %1, %8\n\t"
        "v_fmac_f32 %5, %2, %9\n\t"
        "v_fmac_f32 %5, %3, %10\n\t"
        "v_mul_f32 %6, %27, %19\n\t"
        "v_add_f32_dpp %4, %4, %4 row_ror:8 row_mask:0xf bank_mask:0xf\n\t"
        "v_add_f32_dpp %5, %5, %5 row_ror:8 row_mask:0xf bank_mask:0xf\n\t"
        "v_fma_f32 %0, %0, %11, %6\n\t"
        "v_add_f32_dpp %4, %4, %4 row_ror:4 row_mask:0xf bank_mask:0xf\n\t"
        "v_add_f32_dpp %5, %5, %5 row_ror:4 row_mask:0xf bank_mask:0xf\n\t"
        "v_mul_f32 %6, %27, %20\n\t"
        "v_add_f32_dpp %4, %4, %4 row_ror:2 row_mask:0xf bank_mask:0xf\n\t"
        "v_add_f32_dpp %5, %5, %5 row_ror:2 row_mask:0xf bank_mask:0xf\n\t"
        "v_fma_f32 %1, %1, %12, %6\n\t"
        "v_add_f32_dpp %4, %4, %4 row_ror:1 row_mask:0xf bank_mask:0xf\n\t"
        "v_add_f32_dpp %5, %5, %5 row_ror:1 row_mask:0xf bank_mask:0xf\n\t"
        "v_mul_f32 %6, %27, %21\n\t"
        "v_fma_f32 %2, %2, %13, %6\n\t"
        "v_mul_f32 %6, %27, %22\n\t"
        "v_fma_f32 %3, %3, %14, %6\n\t"
        "v_fma_f32 %0, -%5, %15, %0\n\t"
        "v_fma_f32 %1, -%5, %16, %1\n\t"
        "v_fma_f32 %2, -%5, %17, %2\n\t"
        "v_fma_f32 %3, -%5, %18, %3\n\t"
        "v_mul_f32 %6, %0, %23\n\t"
        "v_fmac_f32 %6, %1, %24\n\t"
        "v_fmac_f32 %6, %2, %25\n\t"
        "v_fmac_f32 %6, %3, %26"
        : "+v"(s0), "+v"(s1), "+v"(s2), "+v"(s3), "+v"(y), "=&v"(p), "=&v"(t)
        : "v"(kk.x), "v"(kk.y), "v"(kk.z), "v"(kk.w), "v"(d.x), "v"(d.y), "v"(d.z), "v"(d.w), "v"(bb.x), "v"(bb.y), "v"(bb.z), "v"(bb.w),
          "v"(kp.x), "v"(kp.y), "v"(kp.z), "v"(kp.w), "v"(r.x), "v"(r.y), "v"(r.z), "v"(r.w), "v"(v));
    S.x = s0; S.y = s1; S.z = s2; S.w = s3;
    ypart = t;
    return y;
}
__device__ __forceinline__ f32x4 ld_bf4(const unsigned char* p) { const v2u w = *(const v2u*)p; return (f32x4){bflo(w.x), bfhi(w.x), bflo(w.y), bfhi(w.y)}; }

constexpr int WK_TCH = 32, WK_STEP_F = 336, WK_BUF_F = WK_TCH * WK_STEP_F;
constexpr int WK_NG = WK_TCH * 84;
__device__ __forceinline__ void wkv_fetch(v2u (&raw)[11], const unsigned char* Eb, int c, int li, int rowq) {
    const unsigned char* Ec = Eb + (size_t)c * WK_TCH * 1024;
#pragma unroll
    for (int i = 0; i < 11; ++i) { const int gi = li + 256 * i;
        if (gi < WK_NG) { const int st = gi / 84, gg = gi % 84; int off;
            if (gg < 16) off = 768 + 8 * gg; else if (gg < 32) off = 384 + 8 * (gg - 16); else if (gg < 48) off = 512 + 8 * (gg - 32);
            else if (gg < 64) off = 128 + 8 * (gg - 48); else if (gg < 80) off = 8 * (gg - 64); else off = 256 + 2 * (16 * rowq + 4 * (gg - 80));
            raw[i] = *(const v2u*)(Ec + (size_t)st * 1024 + off); }
        else raw[i] = (v2u){0u, 0u}; }
}
__device__ __forceinline__ void wkv_put(const v2u (&raw)[11], LAS float* L, int c, int li) {
    LAS float* buf = L + (c & 1) * WK_BUF_F;
#pragma unroll
    for (int i = 0; i < 11; ++i) { const int gi = li + 256 * i;
        if (gi < WK_NG) { const int st = gi / 84, gg = gi % 84; LAS float* sp = buf + st * WK_STEP_F;
            f32x4 v = (f32x4){bflo(raw[i].x), bfhi(raw[i].x), bflo(raw[i].y), bfhi(raw[i].y)};
            if (gg < 16) { v.x = __expf(-v.x); v.y = __expf(-v.y); v.z = __expf(-v.z); v.w = __expf(-v.w); }
            *(LAS f32x4*)(sp + 4 * gg) = v; } }
}
__device__ __forceinline__ void wkv_phase(const Args& a, Frame& F, unsigned char* PREP, bf16* PROJ) {
    if (F.bid < 192) {
        const int chain = F.bid >> 2, rowq = F.bid & 3, b = chain / 12, h = chain % 12;
        LAS float* L = (LAS float*)F.lds;
        const unsigned char* Eb = PREP + (size_t)chain * T * 1024;
        const bool loader = F.wave >= 4; const int li = F.tid - 256;
        f32x4 S = (f32x4){0.f, 0.f, 0.f, 0.f};
        const int k4 = F.lane & 15, rloc = 4 * (F.wave & 3) + (F.lane >> 4);
        constexpr int NCH = T / WK_TCH;
        float ypart = 0.f, yreg = 0.f;
        float* ybase = (float*)(PROJ + ((size_t)b * T + k4) * EC) + 1152 + h * 64 + 16 * rowq + rloc;
        v2u raw[11];
        if (loader) { wkv_fetch(raw, Eb, 0, li, rowq); wkv_put(raw, L, 0, li); wkv_fetch(raw, Eb, 1, li, rowq); }
        __syncthreads();
        for (int c = 0; c < NCH; ++c) {
            if (loader) { if (c + 1 < NCH) wkv_put(raw, L, c + 1, li); if (c + 2 < NCH) wkv_fetch(raw, Eb, c + 2, li, rowq); }
            else {
                const LAS float* buf = L + (c & 1) * WK_BUF_F;
                f32x4 od[2], okk[2], obb[2], okp[2], orr[2]; float ov[2];
                od[0] = *(const LAS f32x4*)(buf + 4 * k4); okk[0] = *(const LAS f32x4*)(buf + 64 + 4 * k4); obb[0] = *(const LAS f32x4*)(buf + 128 + 4 * k4);
                okp[0] = *(const LAS f32x4*)(buf + 192 + 4 * k4); orr[0] = *(const LAS f32x4*)(buf + 256 + 4 * k4); ov[0] = buf[320 + rloc];
#pragma unroll
                for (int s = 0; s < WK_TCH; ++s) {
                    if (s + 1 < WK_TCH) { const LAS float* sp = buf + (s + 1) * WK_STEP_F; const int nb = (s + 1) & 1;
                        od[nb] = *(const LAS f32x4*)(sp + 4 * k4); okk[nb] = *(const LAS f32x4*)(sp + 64 + 4 * k4); obb[nb] = *(const LAS f32x4*)(sp + 128 + 4 * k4);
                        okp[nb] = *(const LAS f32x4*)(sp + 192 + 4 * k4); orr[nb] = *(const LAS f32x4*)(sp + 256 + 4 * k4); ov[nb] = sp[320 + rloc]; }
                    const int cb = s & 1;
                    const float yprev = wkv_step_p(S, ypart, od[cb], okk[cb], obb[cb], okp[cb], orr[cb], ov[cb]);
                    yreg = (k4 == ((s + 15) & 15)) ? yprev : yreg;
                    if ((s & 15) == 0 && (c > 0 || s > 0)) ybase[(size_t)(32 * c + s - 16) * (EC / 2)] = yreg;
                }
            }
            __syncthreads();
        }
        if (!loader) {
            float dummy = 0.f; row16_sum2(ypart, dummy);
            yreg = (k4 == 15) ? ypart : yreg;
            ybase[(size_t)(T - 16) * (EC / 2)] = yreg;
            *(f32x4*)(a.out + O_PWKV + ((size_t)chain * 64 + 16 * rowq + rloc) * 64 + 4 * k4) = S;
        }
    } else {
        const int w = (F.bid - 192) * NWAVES + F.wave; const int k4 = F.lane & 15;
        for (int st = w; st < 384 * 16; st += 64 * NWAVES) {
            const int sc = st >> 4, rg = st & 15, row = 4 * rg + (F.lane >> 4), bs = sc / 12, h = sc % 12;
            f32x4 S = *(const f32x4*)(a.in[I_SWKV] + ((size_t)sc * 64 + row) * 64 + 4 * k4);
#pragma unroll
            for (int t = 0; t < 4; ++t) {
                const unsigned char* E = PREP + ((size_t)48 * T + (size_t)sc * 4 + t) * 1024;
                f32x4 d = ld_bf4(E + 768 + 8 * k4); d.x = __expf(-d.x); d.y = __expf(-d.y); d.z = __expf(-d.z); d.w = __expf(-d.w);
                const f32x4 kk = ld_bf4(E + 384 + 8 * k4), bb = ld_bf4(E + 512 + 8 * k4), kp = ld_bf4(E + 128 + 8 * k4), r = ld_bf4(E + 8 * k4);
                const float v = bf2f(*(const bf16*)(E + 256 + 2 * row));
                const float y = wkv_step(S, d, kk, bb, kp, r, v);
                if (k4 == 0) ((float*)(PROJ + ((size_t)MP + bs * 4 + t) * EC))[1152 + h * 64 + row] = y;
            }
            *(f32x4*)(a.out + O_SWKV + ((size_t)sc * 64 + row) * 64 + 4 * k4) = S;
        }
        p0_convert_items(a, (LAS float*)(F.lds + F.wave * 16384), F.lane, P0_I_IN, P0_NITEMS, w, 64 * NWAVES);
    }
}

constexpr int REC_BYTES = 12800, REC_PHT = 0, REC_RB = 8192, REC_PST = 10240, REC_HT = 12288;
constexpr size_t REC_CHAIN = (size_t)256 * REC_BYTES;
constexpr size_t WS_REQUIRED = WS_END + 2 * REC_CHAIN + (size_t)56 * REC_BYTES;
static_assert(11 * REC_CHAIN <= (size_t)MPAD * D * 2 + 0 || true, "");
static_assert(10 * REC_CHAIN + (size_t)100 * REC_BYTES <= (size_t)MPAD * D * 2 && 20 * REC_CHAIN <= (size_t)M * D * 4 && 5 * REC_CHAIN <= (size_t)32 * 8 * 128 * 128 * 4, "record placement");
__device__ __forceinline__ unsigned char* rec_ptr(unsigned char* ws, float* out, int chain, int ck) {
    const size_t o = (size_t)ck * REC_BYTES;
    if (chain < 10) return ws + WS_BUF0 + (size_t)chain * REC_CHAIN + o;
    if (chain < 20) return ws + WS_BUF1 + (size_t)(chain - 10) * REC_CHAIN + o;
    if (chain < 40) return (unsigned char*)out + (size_t)(chain - 20) * REC_CHAIN + o;
    if (chain < 45) return (unsigned char*)(out + O_SC) + (size_t)(chain - 40) * REC_CHAIN + o;
    if (chain < 47) return ws + WS_END + (size_t)(chain - 45) * REC_CHAIN + o;
    if (ck < 100) return ws + WS_BUF0 + 10 * REC_CHAIN + o;
    if (ck < 200) return ws + WS_BUF1 + 10 * REC_CHAIN + (size_t)(ck - 100) * REC_BYTES;
    return ws + WS_END + 2 * REC_CHAIN + (size_t)(ck - 200) * REC_BYTES;
}
constexpr size_t WS_YS = WS_SQ;
static_assert((size_t)MS * BW * 4 <= (size_t)MS * 3 * 1024 * 4, "YS region");
constexpr int CP_RT = 0, CP_X = 2304, CP_MAB = CP_X + 9216, CP_TT = CP_MAB + 1024, CP_PC = CP_TT + 1024, CP_BYTES = CP_PC + 256;
static_assert(8 * CP_BYTES <= RING_BYTES, "chunk precompute LDS");
__device__ __forceinline__ bf16x8 frag_lo(float x, float y, float z, float w) { return __builtin_bit_cast(bf16x8, (v4u){pk2(x, y), pk2(z, w), 0u, 0u}); }
__device__ __forceinline__ bf16x8 frag_lo4(f32x4 v) { return frag_lo(v.x, v.y, v.z, v.w); }
__device__ __forceinline__ int kpos(int k) { return (k & ~31) | (((k >> 2) & 3) << 3) | (((k >> 4) & 1) << 2) | (k & 3); }

__device__ __forceinline__ void wkv_chunk_core(unsigned char* __restrict__ REC, LAS unsigned char* scr, LAS unsigned char* scm, int lane, const float eLC) {
    const int tl = lane & 15, g4 = lane >> 4, c = lane;
    f32x4 Mab = (f32x4){0.f, 0.f, 0.f, 0.f}, MakT = Mab, Nrb = Mab, Nrk = Mab;
#pragma unroll
    for (int ks = 0; ks < 2; ++ks) {
        const int fo = tl * 144 + 64 * ks + 16 * g4;
        const bf16x8 fA = *(const LAS bf16x8*)(scr + CP_X + 0 * 2304 + fo), fB = *(const LAS bf16x8*)(scr + CP_X + 1 * 2304 + fo), fK = *(const LAS bf16x8*)(scr + CP_X + 2 * 2304 + fo), fR = *(const LAS bf16x8*)(scr + CP_RT + fo);
        Mab = mfma16(fB, fA, Mab);
        MakT = mfma16(fA, fK, MakT);
        Nrb = mfma16(fB, fR, Nrb);
        Nrk = mfma16(fK, fR, Nrk);
    }
#pragma unroll
    for (int i = 0; i < 4; ++i) { const int row = 4 * g4 + i;
        if (!(row < tl)) Mab[i] = 0.f;
        if (!(tl < row)) MakT[i] = 0.f;
        if (!(row <= tl)) { Nrb[i] = 0.f; Nrk[i] = 0.f; } }
    *(LAS f32x4*)(scm + 0 + (tl * 16 + 4 * g4) * 4) = Mab;
    float Trow[16];
#pragma unroll
    for (int t = 0; t < 16; ++t) {
        float acc = (t == tl) ? 1.0f : 0.0f;
        if (t > 0) {
            const LAS float* col = (const LAS float*)(scm + 0 + t * 64);
#pragma unroll
            for (int tp = 0; tp < t; ++tp) acc = fmaf(Trow[tp], col[tp], acc);
        }
        Trow[t] = acc;
    }
#pragma unroll
    for (int t = 0; t < 16; ++t) *(LAS float*)(scm + 1024 + (t * 16 + tl) * 4) = Trow[t];
    const bf16x8 Tf = frag_lo4(*(const LAS f32x4*)(scm + 1024 + (tl * 16 + 4 * g4) * 4));
    {
        unsigned short ra_[16], rb_[16], rk_[16];
#pragma unroll
        for (int t = 0; t < 16; ++t) { ra_[t] = *(const LAS unsigned short*)(scr + CP_X + 0 * 2304 + t * 144 + 2 * c); rb_[t] = *(const LAS unsigned short*)(scr + CP_X + 1 * 2304 + t * 144 + 2 * c);
            rk_[t] = *(const LAS unsigned short*)(scr + CP_X + 2 * 2304 + t * 144 + 2 * c); }
        unsigned wa[8], wb[8], wk[8];
#pragma unroll
        for (int i = 0; i < 8; ++i) { wa[i] = (unsigned)ra_[2 * i] | ((unsigned)ra_[2 * i + 1] << 16);
            wb[i] = pk2(bf2f(rb_[2 * i]) * eLC, bf2f(rb_[2 * i + 1]) * eLC); wk[i] = pk2(bf2f(rk_[2 * i]) * eLC, bf2f(rk_[2 * i + 1]) * eLC); }
        asm volatile("" ::: "memory");
        LAS unsigned char* ra = scr + CP_X + c * 48;
        *(LAS v4u*)(ra) = (v4u){wa[0], wa[1], wa[2], wa[3]}; *(LAS v4u*)(ra + 16) = (v4u){wa[4], wa[5], wa[6], wa[7]};
        *(LAS v4u*)(ra + 3072) = (v4u){wb[0], wb[1], wb[2], wb[3]}; *(LAS v4u*)(ra + 3072 + 16) = (v4u){wb[4], wb[5], wb[6], wb[7]};
        *(LAS v4u*)(ra + 6144) = (v4u){wk[0], wk[1], wk[2], wk[3]}; *(LAS v4u*)(ra + 6144 + 16) = (v4u){wk[4], wk[5], wk[6], wk[7]};
        *(LAS float*)(scm + 2048 + 4 * c) = eLC;
    }
    f32x4 Abar[4];
#pragma unroll
    for (int nt = 0; nt < 4; ++nt) { const v2u w = *(const LAS v2u*)(scr + CP_X + (16 * nt + tl) * 48 + 8 * g4);
        Abar[nt] = mfma16(Tf, __builtin_bit_cast(bf16x8, (v4u){w.x, w.y, 0u, 0u}), (f32x4){0.f, 0.f, 0.f, 0.f}); }
    const bf16x8 fMakT = frag_lo4(MakT), fNrb = frag_lo4(Nrb);
    const f32x4 GT = mfma16(Tf, fMakT, (f32x4){0.f, 0.f, 0.f, 0.f});
    const bf16x8 fGT = frag_lo4(GT);
    unsigned char* R = REC;
    { const f32x4 Hm = mfma16(fGT, fNrb, Nrk);
      *(v2u*)(R + REC_HT + tl * 32 + 8 * g4) = (v2u){pk2(Hm.x, Hm.y), pk2(Hm.z, Hm.w)}; }
    bf16x8 fAb[4];
#pragma unroll
    for (int kt = 0; kt < 4; ++kt) fAb[kt] = frag_lo4(Abar[kt]);
#pragma unroll
    for (int kt = 0; kt < 4; ++kt) {
        f32x4 rb = mfma16(fAb[kt], fNrb, (f32x4){0.f, 0.f, 0.f, 0.f});
        const v2u rw = *(const LAS v2u*)(scr + CP_RT + tl * 144 + 2 * (16 * kt + 4 * g4));
        rb.x += bflo(rw.x); rb.y += bfhi(rw.x); rb.z += bflo(rw.y); rb.w += bfhi(rw.y);
        *(v2u*)(R + REC_RB + tl * 128 + 2 * kpos(16 * kt + 4 * g4)) = (v2u){pk2(rb.x, rb.y), pk2(rb.z, rb.w)};
    }
#pragma unroll
    for (int nt = 0; nt < 4; ++nt) {
        const v2u bw = *(const LAS v2u*)(scr + CP_X + 3072 + (16 * nt + tl) * 48 + 8 * g4);
        const bf16x8 fBc = __builtin_bit_cast(bf16x8, (v4u){bw.x, bw.y, 0u, 0u});
        const float pc = *(const LAS float*)(scm + 2048 + 4 * (16 * nt + tl));
        f32x4 ph[4];
#pragma unroll
        for (int kt = 0; kt < 4; ++kt) { ph[kt] = mfma16(fAb[kt], fBc, (f32x4){0.f, 0.f, 0.f, 0.f});
            if (kt == nt) { if (4 * g4 + 0 == tl) ph[kt].x += pc; if (4 * g4 + 1 == tl) ph[kt].y += pc; if (4 * g4 + 2 == tl) ph[kt].z += pc; if (4 * g4 + 3 == tl) ph[kt].w += pc; } }
        unsigned char* prow = R + REC_PHT + (16 * nt + tl) * 128;
        *(v4u*)(prow + 2 * (8 * g4)) = (v4u){pk2(ph[0].x, ph[0].y), pk2(ph[0].z, ph[0].w), pk2(ph[1].x, ph[1].y), pk2(ph[1].z, ph[1].w)};
        *(v4u*)(prow + 2 * (32 + 8 * g4)) = (v4u){pk2(ph[2].x, ph[2].y), pk2(ph[2].z, ph[2].w), pk2(ph[3].x, ph[3].y), pk2(ph[3].z, ph[3].w)};
        f32x4 ps = mfma16(fGT, fBc, (f32x4){0.f, 0.f, 0.f, 0.f});
        const v2u kw = *(const LAS v2u*)(scr + CP_X + 6144 + (16 * nt + tl) * 48 + 8 * g4);
        ps.x += bflo(kw.x); ps.y += bfhi(kw.x); ps.z += bflo(kw.y); ps.w += bfhi(kw.y);
        *(v2u*)(R + REC_PST + (16 * nt + tl) * 32 + 8 * g4) = (v2u){pk2(ps.x, ps.y), pk2(ps.z, ps.w)};
    }
}

constexpr int FZ_L = 0, FZ_LROW = 576, FZ_R = 17 * 576, FZ_RROW = 384, FZ_BYTES = 17 * 960;
constexpr int FZ_TILES = 4096, FZ_SMALL = 0;
static_assert(8 * FZ_BYTES <= RING_BYTES && FZ_TILES + 2304 + 9216 <= FZ_BYTES && FZ_R + 3 * 2048 <= FZ_BYTES, "fused prep LDS");
__device__ __forceinline__ void wkv_prep_issue(v4u (&stg)[16], const bf16* __restrict__ PROJ, const bf16* __restrict__ SHB, int chain, int ck, int lane) {
    const int b = chain / 12, h = chain % 12; const size_t m0 = (size_t)b * T + (size_t)ck * 16;
#pragma unroll
    for (int i = 0; i < 16; ++i) { int p = lane + 64 * i; p = p < 1020 ? p : 1019;
        const int row = p / 60, q = p - row * 60;
        const int col = q < 36 ? (3 * BW + 8 * q) : (q < 44 ? (h * 64 + 8 * (q - 36)) : (q < 52 ? (BW + h * 64 + 8 * (q - 44)) : (2 * BW + h * 64 + 8 * (q - 52))));
        const bf16* src = (row == 0 && ck == 0) ? (SHB + 32 * BCOLS) : (PROJ + (m0 - 1 + row) * EC + AQKV);
        stg[i] = *(const v4u*)(src + col); }
}
template <int NOCORE>
__device__ __forceinline__ void wkv_prep_chunk(const Args& a, v4u (&stg)[16], const bf16* __restrict__ PROJ, const bf16* __restrict__ LW, const bf16* __restrict__ SHB, unsigned char* PREP, unsigned char* REC,
                                               LAS unsigned char* area, int chain, int ck, int nchain, int nck, int lane_in) {
    int lane = lane_in; asm volatile("" : "+v"(lane)); __builtin_assume(lane >= 0 && lane < 64);
    const int tok = lane & 15, g4 = lane >> 4, b = chain / 12, h = chain % 12;
    const size_t m0 = (size_t)b * T + (size_t)ck * 16;
#pragma unroll
    for (int i = 0; i < 16; ++i) { int p = lane + 64 * i; p = p < 1020 ? p : 1019; const int row = p / 60, q = p - row * 60;
        *(LAS v4u*)(area + (q < 36 ? (FZ_L + row * FZ_LROW + q * 16) : (FZ_R + row * FZ_RROW + (q - 36) * 16))) = stg[i]; }
    asm volatile("" ::: "memory");
    wkv_prep_issue(stg, PROJ, SHB, nchain, nck, lane);
    const float* mu = a.in[I_EMU];
    bf16x8 af[9];
    {
        const LAS unsigned char* curL = area + FZ_L + (tok + 1) * FZ_LROW;
#pragma unroll
        for (int ks = 0; ks < 9; ++ks) {
            const int col = 3 * BW + 32 * ks + 8 * g4;
            const v4u c8 = *(const LAS v4u*)(curL + 64 * ks + 16 * g4), p8 = *(const LAS v4u*)(curL - FZ_LROW + 64 * ks + 16 * g4);
            const f32x4 m0v = *(const f32x4*)(mu + col), m1v = *(const f32x4*)(mu + col + 4);
            const float cc[8] = {bflo(c8.x), bfhi(c8.x), bflo(c8.y), bfhi(c8.y), bflo(c8.z), bfhi(c8.z), bflo(c8.w), bfhi(c8.w)};
            const float pp[8] = {bflo(p8.x), bfhi(p8.x), bflo(p8.y), bfhi(p8.y), bflo(p8.z), bfhi(p8.z), bflo(p8.w), bfhi(p8.w)};
            const float mm[8] = {m0v.x, m0v.y, m0v.z, m0v.w, m1v.x, m1v.y, m1v.z, m1v.w};
            float v[8];
#pragma unroll
            for (int i = 0; i < 8; ++i) {
                v[i] = cc[i] + (pp[i] - cc[i]) * mm[i];
                if (ks < 2) { const float e = __expf(2.0f * v[i]); v[i] = 1.0f - 2.0f * rcpf_(e + 1.0f); }
                else if (ks >= 4) v[i] = sigmoidf_(v[i]);
            }
            af[ks] = __builtin_bit_cast(bf16x8, (v4u){pk2(v[0], v[1]), pk2(v[2], v[3]), pk2(v[4], v[5]), pk2(v[6], v[7])});
            if (ks % 3 == 2) asm volatile("" ::: "memory");
        }
    }
    const LAS unsigned char* curR = area + FZ_R + (tok + 1) * FZ_RROW;
#define FZ_XS4(which, cl_) ({ const v2u c4_ = *(const LAS v2u*)(curR + 128 * (which) + 2 * (cl_)), p4_ = *(const LAS v2u*)(curR - FZ_RROW + 128 * (which) + 2 * (cl_)); \
        const f32x4 cv_ = (f32x4){bflo(c4_.x), bfhi(c4_.x), bflo(c4_.y), bfhi(c4_.y)}, pv_ = (f32x4){bflo(p4_.x), bfhi(p4_.x), bflo(p4_.y), bfhi(p4_.y)}; \
        cv_ + (pv_ - cv_) * *(const f32x4*)(mu + (which) * BW + h * 64 + (cl_)); })
    const float* k_k = a.in[I_EKK];
    f32x4 kr[4];
    float ssq = 0.f;
#pragma unroll
    for (int nt = 0; nt < 4; ++nt) {
        const int cl = 16 * nt + 4 * g4;
        kr[nt] = FZ_XS4(1, cl);
        const f32x4 kkr = kr[nt] * *(const f32x4*)(k_k + h * 64 + cl);
        ssq += (kkr.x * kkr.x + kkr.y * kkr.y) + (kkr.z * kkr.z + kkr.w * kkr.w);
    }
    ssq += __shfl_xor(ssq, 16); ssq += __shfl_xor(ssq, 32);
    const float kinv = rcpf_(fmaxf(__builtin_amdgcn_sqrtf(ssq), 1e-12f));
    v2u pk_kk[4], pk_b[4], pk_ew[4];
    LAS unsigned char* tbw = area + tok * 128 + 8 * g4;
#pragma unroll
    for (int nt = 0; nt < 4; ++nt) {
        const bf16* lwp = LW + (size_t)(h * 64 + 16 * nt + tok) * LORA + 8 * g4;
        f32x4 aw = (f32x4){0.f, 0.f, 0.f, 0.f}, aa = aw, ag = aw;
#pragma unroll
        for (int ks = 0; ks < 9; ++ks) { const bf16x8 bw = *(const bf16x8*)(lwp + 32 * ks);
            if (ks < 2) aw = mfma16(bw, af[ks], aw); else if (ks < 4) aa = mfma16(bw, af[ks], aa); else ag = mfma16(bw, af[ks], ag); }
        const int cl = 16 * nt + 4 * g4, c4 = h * 64 + cl;
        const f32x4 w0 = *(const f32x4*)(a.in[I_EW0] + c4), a0 = *(const f32x4*)(a.in[I_EA0] + c4), kkc = *(const f32x4*)(k_k + c4), kac = *(const f32x4*)(a.in[I_EKA] + c4);
        f32x4 ew, av, kk, kp, bb;
#pragma unroll
        for (int i = 0; i < 4; ++i) {
            const float z = -(w0[i] + aw[i]);
            const float sp = fmaxf(z, 0.f) + __logf(1.0f + __expf(-fabsf(z)));
            ew[i] = __expf(-sp - 0.5f);
            av[i] = sigmoidf_(a0[i] + aa[i]);
            kk[i] = kr[nt][i] * kkc[i] * kinv;
            kp[i] = kr[nt][i] * (1.0f + (av[i] - 1.0f) * kac[i]);
            bb[i] = kk[i] * av[i];
        }
        const f32x4 rr4 = FZ_XS4(0, cl), vr4 = FZ_XS4(2, cl);
        *(LAS v2u*)(tbw + 0 * 2048 + 32 * nt) = (v2u){pk2(rr4.x, rr4.y), pk2(rr4.z, rr4.w)};
        *(LAS v2u*)(tbw + 1 * 2048 + 32 * nt) = (v2u){pk2(kp.x, kp.y), pk2(kp.z, kp.w)};
        *(LAS v2u*)(tbw + 2 * 2048 + 32 * nt) = (v2u){pk2(vr4.x, vr4.y), pk2(vr4.z, vr4.w)};
        *(LAS v2u*)(tbw + 3 * 2048 + 32 * nt) = (v2u){pk2(ag.x, ag.y), pk2(ag.z, ag.w)};
        pk_kk[nt] = (v2u){pk2(kk.x, kk.y), pk2(kk.z, kk.w)};
        pk_b[nt] = (v2u){pk2(bb.x, bb.y), pk2(bb.z, bb.w)};
        pk_ew[nt] = (v2u){pk2(ew.x, ew.y), pk2(ew.z, ew.w)};
        asm volatile("" ::: "memory");
    }
#undef FZ_XS4
    {
        LAS unsigned char* tbr = area + FZ_R + tok * 128 + 8 * g4;
#pragma unroll
        for (int nt = 0; nt < 4; ++nt) { *(LAS v2u*)(tbr + 0 * 2048 + 32 * nt) = pk_kk[nt]; *(LAS v2u*)(tbr + 1 * 2048 + 32 * nt) = pk_b[nt]; *(LAS v2u*)(tbr + 2 * 2048 + 32 * nt) = pk_ew[nt]; }
    }
#pragma unroll
    for (int sI = 0; sI < 4; ++sI) { const int tt = 4 * sI + (lane >> 4);
        unsigned char* Et = PREP + ((size_t)chain * T + (size_t)ck * 16 + tt) * 1024 + 8 * (lane & 15);
        const LAS unsigned char* tbs = area + tt * 128 + 8 * (lane & 15);
        *(v2u*)(Et + 0) = *(const LAS v2u*)(tbs + 0 * 2048); *(v2u*)(Et + 128) = *(const LAS v2u*)(tbs + 1 * 2048);
        *(v2u*)(Et + 256) = *(const LAS v2u*)(tbs + 2 * 2048); *(v2u*)(Et + 640) = *(const LAS v2u*)(tbs + 3 * 2048); }
    const int c = lane;
    float eLCv;
    {
        unsigned short s_r[16], s_kp[16], s_kk[16], s_b[16], s_ew[16];
        const LAS unsigned short* t_r = (const LAS unsigned short*)(area + 0 * 2048) + c; const LAS unsigned short* t_kp = (const LAS unsigned short*)(area + 1 * 2048) + c;
        const LAS unsigned short* t_kk = (const LAS unsigned short*)(area + FZ_R + 0 * 2048) + c; const LAS unsigned short* t_b = (const LAS unsigned short*)(area + FZ_R + 1 * 2048) + c;
        const LAS unsigned short* t_ew = (const LAS unsigned short*)(area + FZ_R + 2 * 2048) + c;
#pragma unroll
        for (int t = 0; t < 16; ++t) { s_r[t] = t_r[t * 64]; s_kp[t] = t_kp[t * 64]; s_kk[t] = t_kk[t * 64]; s_b[t] = t_b[t * 64]; s_ew[t] = t_ew[t * 64]; }
        asm volatile("" ::: "memory");
        LAS unsigned char* scr0 = area + FZ_TILES;
        float L = 0.f;
#pragma unroll
        for (int t = 0; t < 16; ++t) {
            const float eprev = __expf(L);
            L -= bf2f(s_ew[t]);
            const float e = __expf(L), einv = rcpf_(e);
            *(LAS unsigned short*)(scr0 + CP_X + 0 * 2304 + t * 144 + 2 * c) = (unsigned short)f2bf(-bf2f(s_kk[t]) * eprev);
            *(LAS unsigned short*)(scr0 + CP_X + 1 * 2304 + t * 144 + 2 * c) = (unsigned short)f2bf(bf2f(s_b[t]) * einv);
            *(LAS unsigned short*)(scr0 + CP_X + 2 * 2304 + t * 144 + 2 * c) = (unsigned short)f2bf(bf2f(s_kp[t]) * einv);
            *(LAS unsigned short*)(scr0 + CP_RT + t * 144 + 2 * c) = (unsigned short)f2bf(bf2f(s_r[t]) * e);
        }
        eLCv = __expf(L);
    }
    LAS unsigned char* scr = area + FZ_TILES;
    if (!NOCORE) wkv_chunk_core(REC, scr, area + FZ_SMALL, lane, eLCv); else if (eLCv == 12345.678f) *(float*)REC = eLCv;
}

constexpr int SQ_D = 6, SQ_SLOT = 16384;
static_assert(SQ_D * SQ_SLOT <= RING_BYTES, "sequential pass LDS");
__device__ __forceinline__ void wkv_seq_issue(LAS unsigned char* slot, const unsigned char* R, const unsigned char* E0, int lw, int lane) {
#pragma unroll
    for (int i = 0; i < 4; ++i) {
        int q = lw * 4 + i; q = q > 14 ? 12 : q;
        const unsigned char* src;
        if (q < 10) { const int row = 8 * (q & 7) + (lane >> 3), pc = (lane & 7) ^ (row & 7); src = R + (q < 8 ? REC_PHT : REC_RB) + row * 128 + pc * 16; }
        else if (q < 12) src = R + REC_PST + (q - 10) * 1024 + lane * 16;
        else if (q == 12) src = R + REC_HT + (lane & 31) * 16;
        else src = E0 + (size_t)(8 * (q - 13) + (lane >> 3)) * 1024 + 256 + (lane & 7) * 16;
        __builtin_amdgcn_global_load_lds((const unsigned*)src, (LAS unsigned*)(slot + q * 1024), 16, 0, 0);
    }
}
__device__ __forceinline__ void wkv_phase2(const Args& a, Frame& F, unsigned char* PREP, float* YS) {
    if (F.bid < 48) {
        const int chain = F.bid;
        unsigned char* Eb = PREP + (size_t)chain * T * 1024;
        if (F.wave >= 4) {
            const int lw = F.wave - 4;
#pragma unroll
            for (int j = 0; j < SQ_D - 1; ++j) wkv_seq_issue(F.lds + j * SQ_SLOT, rec_ptr(a.ws, a.out, chain, j), Eb + (size_t)j * 16 * 1024, lw, F.lane);
            asm volatile("s_waitcnt vmcnt(16)" ::: "memory");
            __builtin_amdgcn_s_barrier();
            for (int ck = 0; ck < 256; ++ck) {
                int cn = ck + SQ_D - 1; cn = cn < 256 ? cn : 255;
                wkv_seq_issue(F.lds + ((ck + SQ_D - 1) % SQ_D) * SQ_SLOT, rec_ptr(a.ws, a.out, chain, cn), Eb + (size_t)cn * 16 * 1024, lw, F.lane);
                asm volatile("s_waitcnt vmcnt(16)" ::: "memory");
                __builtin_amdgcn_s_barrier();
            }
            asm volatile("s_waitcnt vmcnt(0)" ::: "memory");
        } else {
            const int w = F.wave, tl = F.lane & 15, g4 = F.lane >> 4;
            f32x4 S[4];
#pragma unroll
            for (int i = 0; i < 4; ++i) S[i] = (f32x4){0.f, 0.f, 0.f, 0.f};
            __builtin_amdgcn_s_barrier();
            for (int ck = 0; ck < 256; ++ck) {
                const LAS unsigned char* buf = F.lds + (ck % SQ_D) * SQ_SLOT;
                bf16x8 sf[2];
#pragma unroll
                for (int ks = 0; ks < 2; ++ks) sf[ks] = __builtin_bit_cast(bf16x8, (v4u){pk2(S[2 * ks].x, S[2 * ks].y), pk2(S[2 * ks].z, S[2 * ks].w), pk2(S[2 * ks + 1].x, S[2 * ks + 1].y), pk2(S[2 * ks + 1].z, S[2 * ks + 1].w)});
                const LAS unsigned short* vp = (const LAS unsigned short*)(buf + 13 * 1024) + (4 * g4) * 64 + 16 * w + tl;
                const bf16x8 vf = __builtin_bit_cast(bf16x8, (v4u){(unsigned)vp[0] | ((unsigned)vp[64] << 16), (unsigned)vp[128] | ((unsigned)vp[192] << 16), 0u, 0u});
                f32x4 y = (f32x4){0.f, 0.f, 0.f, 0.f};
#pragma unroll
                for (int ks = 0; ks < 2; ++ks) y = mfma16(*(const LAS bf16x8*)(buf + 8192 + (tl >> 3) * 1024 + (tl & 7) * 128 + (((4 * ks + g4) ^ (tl & 7)) << 4)), sf[ks], y);
                { const v2u hw = *(const LAS v2u*)(buf + 12288 + tl * 32 + 8 * g4); y = mfma16(__builtin_bit_cast(bf16x8, (v4u){hw.x, hw.y, 0u, 0u}), vf, y); }
#pragma unroll
                for (int i = 0; i < 4; ++i) *(float*)(Eb + ((size_t)ck * 16 + 4 * g4 + i) * 1024 + 384 + 4 * (16 * w + tl)) = y[i];
#pragma unroll
                for (int kt = 0; kt < 4; ++kt) {
                    const int row = 16 * kt + tl;
                    f32x4 sn = (f32x4){0.f, 0.f, 0.f, 0.f};
#pragma unroll
                    for (int ks = 0; ks < 2; ++ks) sn = mfma16(*(const LAS bf16x8*)(buf + (row >> 3) * 1024 + (row & 7) * 128 + (((4 * ks + g4) ^ (row & 7)) << 4)), sf[ks], sn);
                    const v2u pw = *(const LAS v2u*)(buf + 10240 + row * 32 + 8 * g4);
                    S[kt] = mfma16(__builtin_bit_cast(bf16x8, (v4u){pw.x, pw.y, 0u, 0u}), vf, sn);
                }
                __builtin_amdgcn_s_barrier();
            }
#pragma unroll
            for (int kt = 0; kt < 4; ++kt) *(f32x4*)(a.out + O_PWKV + ((size_t)chain * 64 + 16 * w + tl) * 64 + 16 * kt + 4 * g4) = S[kt];
        }
    } else {
        const int w = (F.bid - 48) * NWAVES + F.wave; const int k4 = F.lane & 15;
        for (int st = w; st < 384 * 16; st += 208 * NWAVES) {
            const int sc = st >> 4, rg = st & 15, row = 4 * rg + (F.lane >> 4), bs = sc / 12, h = sc % 12;
            f32x4 S = *(const f32x4*)(a.in[I_SWKV] + ((size_t)sc * 64 + row) * 64 + 4 * k4);
#pragma unroll
            for (int t = 0; t < 4; ++t) {
                const unsigned char* E = PREP + ((size_t)48 * T + (size_t)sc * 4 + t) * 1024;
                f32x4 d = ld_bf4(E + 768 + 8 * k4); d.x = __expf(-d.x); d.y = __expf(-d.y); d.z = __expf(-d.z); d.w = __expf(-d.w);
                const f32x4 kk = ld_bf4(E + 384 + 8 * k4), bb = ld_bf4(E + 512 + 8 * k4), kp = ld_bf4(E + 128 + 8 * k4), r = ld_bf4(E + 8 * k4);
                const float v = bf2f(*(const bf16*)(E + 256 + 2 * row));
                const float y = wkv_step(S, d, kk, bb, kp, r, v);
                if (k4 == 0) YS[((size_t)bs * 4 + t) * BW + h * 64 + row] = y;
            }
            *(f32x4*)(a.out + O_SWKV + ((size_t)sc * 64 + row) * 64 + 4 * k4) = S;
        }
        p0_convert_items(a, (LAS float*)(F.lds + F.wave * 16384), F.lane, P0_I_IN, P0_NITEMS, w, 208 * NWAVES);
    }
}

__device__ __forceinline__ void mix_phase(const Args& a, Frame& F, const unsigned char* PREP, const float* YS, const bf16* ATTO, const float* LSE, bf16* MIX) {
    const int u = F.lane >> 4, cq = F.lane & 15;
    for (int m = F.gw; m < M; m += NGW) {
        bf16* orow = MIX + (size_t)m * D;
        size_t e0; int es;
        if (m < MP) { e0 = (size_t)((m >> 12) * 12) * T + (m & (T - 1)); es = T; } else { const int s = m - MP; e0 = (size_t)48 * T + (size_t)((s >> 2) * 12) * 4 + (s & 3); es = 4; }
#pragma unroll
        for (int it = 0; it < 3; ++it) {
            const int h = 4 * it + u, c = h * 64 + 4 * cq;
            const unsigned char* E = PREP + (e0 + (size_t)h * es) * 1024 + 8 * cq;
            const f32x4 y = (m < MP) ? *(const f32x4*)(E - 8 * cq + 384 + 16 * cq) : *(const f32x4*)(YS + (size_t)(m - MP) * BW + c);
            const f32x4 r = ld_bf4(E), kp = ld_bf4(E + 128), v = ld_bf4(E + 256), g = ld_bf4(E + 640);
            const f32x4 lw = *(const f32x4*)(a.in[I_ELNW] + c), lb = *(const f32x4*)(a.in[I_ELNB] + c), rk = *(const f32x4*)(a.in[I_ERK] + c);
            const float mean = row16_sum((y.x + y.y) + (y.z + y.w)) * (1.0f / 64.0f);
            const f32x4 dy = y - mean;
            const float var = row16_sum((dy.x * dy.x + dy.y * dy.y) + (dy.z * dy.z + dy.w * dy.w)) * (1.0f / 64.0f);
            const float rs = __builtin_amdgcn_rsqf(var + LNX_EPS);
            const f32x4 rkk = r * kp * rk;
            const float bsum = row16_sum((rkk.x + rkk.y) + (rkk.z + rkk.w));
            const f32x4 o = (dy * rs * lw + lb + v * bsum) * g;
            *(v2u*)(orow + 256 + c) = (v2u){pk2(o.x, o.y), pk2(o.z, o.w)};
        }
        {
            const int hs = u, c = hs * 64 + 4 * cq;
            const float l0 = LSE[((size_t)0 * M + m) * 4 + hs], l1 = LSE[((size_t)1 * M + m) * 4 + hs], l2 = LSE[((size_t)2 * M + m) * 4 + hs];
            const f32x4 a0 = ld_bf4((const unsigned char*)(ATTO + ((size_t)0 * M + m) * 256 + c)), a1 = ld_bf4((const unsigned char*)(ATTO + ((size_t)1 * M + m) * 256 + c)), a2 = ld_bf4((const unsigned char*)(ATTO + ((size_t)2 * M + m) * 256 + c));
            const float mx = fmaxf(l0, fmaxf(l1, l2));
            const float w0 = __builtin_amdgcn_exp2f(l0 - mx), w1 = __builtin_amdgcn_exp2f(l1 - mx), w2 = __builtin_amdgcn_exp2f(l2 - mx);
            const float inv = rcpf_(w0 + w1 + w2);
            const f32x4 o = (a0 * w0 + a1 * w1 + a2 * w2) * inv;
            *(v2u*)(orow + c) = (v2u){pk2(o.x, o.y), pk2(o.z, o.w)};
        }
    }
}

constexpr int HG_QROW = 272, HG_TROW = 40;
constexpr int HG_QE = 0, HG_KE = 16 * HG_QROW, HG_KDT = 2 * 16 * HG_QROW, HG_VT = HG_KDT + 128 * HG_TROW, HG_EBL = HG_VT + 128 * HG_TROW, HG_GS = HG_EBL + 512, HG_BUF = HG_GS + 2048;
constexpr int HG_BASE = 16384;
constexpr size_t WS_O = WS_B;
constexpr size_t WS_XCH = WS_B + (size_t)80 * MiB;
constexpr size_t WS_XP = WS_XCH + (size_t)256 * 65536;
static_assert(WS_O + (size_t)M * D * 4 <= WS_XCH && WS_XP + 256 * 512 <= WS_END, "region B (layer 1)");

template <bool FULL>
__device__ __forceinline__ void hgrn_chunks(Frame& F, const bf16* __restrict__ PC, const float* __restrict__ LB, float* __restrict__ O, f32x4 (&S)[8], float& Lsum, int b, int h, int seg) {
    const int tid = F.tid, c = tid & 127, j = tid >> 7, w = F.wave, tl = F.lane & 15, g4 = F.lane >> 4;
    const int pos = (c & ~31) | (((c >> 2) & 3) << 3) | (((c >> 4) & 1) << 2) | (c & 3);
    const float lb = LB[h * 128 + c];
    const size_t mseg = (size_t)b * T + (size_t)seg * 512;
    const bf16* prow = PC + (mseg + 4 * j) * CC + h * 128 + c;
    unsigned short fw[4], iw[4], qw[4], fn[4], in_[4], qn[4];
#pragma unroll
    for (int i = 0; i < 4; ++i) { fn[i] = prow[(size_t)i * CC + 1024]; in_[i] = prow[(size_t)i * CC + 2048]; qn[i] = FULL ? prow[(size_t)i * CC] : (unsigned short)0; }
    for (int n = 0; n < 32; ++n) {
        LAS unsigned char* buf = F.lds + HG_BASE + (n & 1) * HG_BUF;
#pragma unroll
        for (int i = 0; i < 4; ++i) { fw[i] = fn[i]; iw[i] = in_[i]; qw[i] = qn[i]; }
        if (n + 1 < 32) { const bf16* pn = prow + (size_t)(n + 1) * 16 * CC;
#pragma unroll
            for (int i = 0; i < 4; ++i) { fn[i] = pn[(size_t)i * CC + 1024]; in_[i] = pn[(size_t)i * CC + 2048]; if (FULL) qn[i] = pn[(size_t)i * CC]; } }
        float fg[4], pre[4]; float loc = 0.f;
#pragma unroll
        for (int i = 0; i < 4; ++i) { fg[i] = lb + (1.0f - lb) * sigmoidf_(bf2f(fw[i])); loc += __logf(fg[i]); pre[i] = loc; }
        LAS float* GS = (LAS float*)(buf + HG_GS);
        GS[j * 128 + c] = loc;
        __syncthreads();
        const float g0 = GS[c], g1 = GS[128 + c], g2 = GS[256 + c], g3 = GS[384 + c];
        const float off = (j > 0 ? g0 : 0.f) + (j > 1 ? g1 : 0.f) + (j > 2 ? g2 : 0.f);
        const float tot = (g0 + g1) + (g2 + g3);
        const float ebl = __expf(tot);
        Lsum += tot;
        float kd[4];
#pragma unroll
        for (int i = 0; i < 4; ++i) {
            const float bt = off + pre[i];
            const float eb = __expf(bt), en = rcpf_(eb);
            const float ke = (1.0f - fg[i]) * en;
            kd[i] = ke * ebl;
            if (FULL) {
                const float qe = siluf_(bf2f(qw[i])) * eb;
                *(LAS unsigned short*)(buf + HG_QE + (4 * j + i) * HG_QROW + 2 * pos) = (unsigned short)f2bf(qe);
                *(LAS unsigned short*)(buf + HG_KE + (4 * j + i) * HG_QROW + 2 * pos) = (unsigned short)f2bf(ke);
            }
        }
        *(LAS v2u*)(buf + HG_KDT + c * HG_TROW + 8 * j) = (v2u){pk2(kd[0], kd[1]), pk2(kd[2], kd[3])};
        *(LAS v2u*)(buf + HG_VT + c * HG_TROW + 8 * j) = (v2u){(unsigned)iw[0] | ((unsigned)iw[1] << 16), (unsigned)iw[2] | ((unsigned)iw[3] << 16)};
        if (j == 0) *(LAS float*)(buf + HG_EBL + 4 * c) = ebl;
        __syncthreads();
        const v2u vv = *(const LAS v2u*)(buf + HG_VT + (16 * w + tl) * HG_TROW + 8 * g4);
        const bf16x8 vf = __builtin_bit_cast(bf16x8, (v4u){vv.x, vv.y, 0u, 0u});
        if (FULL) {
            bf16x8 qf[4];
#pragma unroll
            for (int ks = 0; ks < 4; ++ks) qf[ks] = *(const LAS bf16x8*)(buf + HG_QE + tl * HG_QROW + 64 * ks + 16 * g4);
            f32x4 att = (f32x4){0.f, 0.f, 0.f, 0.f};
#pragma unroll
            for (int ks = 0; ks < 4; ++ks) att = mfma16(*(const LAS bf16x8*)(buf + HG_KE + tl * HG_QROW + 64 * ks + 16 * g4), qf[ks], att);
            if (4 * g4 + 0 > tl) att.x = 0.f;
            if (4 * g4 + 1 > tl) att.y = 0.f;
            if (4 * g4 + 2 > tl) att.z = 0.f;
            if (4 * g4 + 3 > tl) att.w = 0.f;
            const bf16x8 pB = __builtin_bit_cast(bf16x8, (v4u){pk2(att.x, att.y), pk2(att.z, att.w), 0u, 0u});
            f32x4 o = (f32x4){0.f, 0.f, 0.f, 0.f};
#pragma unroll
            for (int ks = 0; ks < 4; ++ks) {
                const bf16x8 sf = __builtin_bit_cast(bf16x8, (v4u){pk2(S[2 * ks].x, S[2 * ks].y), pk2(S[2 * ks].z, S[2 * ks].w), pk2(S[2 * ks + 1].x, S[2 * ks + 1].y), pk2(S[2 * ks + 1].z, S[2 * ks + 1].w)});
                o = mfma16(sf, qf[ks], o);
            }
            o = mfma16(vf, pB, o);
            *(f32x4*)(O + (mseg + (size_t)n * 16 + tl) * D + h * 128 + 16 * w + 4 * g4) = o;
        }
#pragma unroll
        for (int kt = 0; kt < 8; ++kt) {
            const v2u kw = *(const LAS v2u*)(buf + HG_KDT + (16 * kt + tl) * HG_TROW + 8 * g4);
            const f32x4 e4 = *(const LAS f32x4*)(buf + HG_EBL + 4 * (16 * kt + 4 * g4));
            S[kt] = S[kt] * e4;
            S[kt] = mfma16(__builtin_bit_cast(bf16x8, (v4u){kw.x, kw.y, 0u, 0u}), vf, S[kt]);
        }
    }
}

template <class BarT>
__device__ __forceinline__ void hgrn_fused(const Args& a, Frame& F, const bf16* __restrict__ PC, unsigned char* ws, const BarT& bar) {
    const float* LB = (const float*)(ws + WS_TAB + 8192);
    float* O = (float*)(ws + WS_O);
    {
        const int bs = F.bid >> 3, h = F.bid & 7;
        LAS float* Lq = (LAS float*)F.lds; LAS float* Lf = Lq + 512; LAS float* Lv = Lf + 512; LAS float* Lr = Lv + 512;
        { const int t = F.tid >> 7, k = F.tid & 127; const bf16* pr = PC + ((size_t)MP + bs * 4 + t) * CC + h * 128 + k; const float lb = LB[h * 128 + k];
          Lq[F.tid] = siluf_(bf2f(pr[0])); Lf[F.tid] = lb + (1.0f - lb) * sigmoidf_(bf2f(pr[1024])); Lv[F.tid] = bf2f(pr[2048]); }
        __syncthreads();
        const int v = F.tid & 127, kq = F.tid >> 7;
        float o0 = 0.f, o1 = 0.f, o2 = 0.f, o3 = 0.f;
        const float v0 = Lv[v], v1 = Lv[128 + v], v2 = Lv[256 + v], v3 = Lv[384 + v];
        const size_t sbase = ((size_t)(bs * 8 + h) * 128) * 128;
        for (int kk = 0; kk < 32; ++kk) { const int k = 32 * kq + kk;
            float s = a.in[I_SC][sbase + (size_t)k * 128 + v];
            float fg;
            fg = Lf[k]; s = fg * s + (1.0f - fg) * v0; o0 += Lq[k] * s;
            fg = Lf[128 + k]; s = fg * s + (1.0f - fg) * v1; o1 += Lq[128 + k] * s;
            fg = Lf[256 + k]; s = fg * s + (1.0f - fg) * v2; o2 += Lq[256 + k] * s;
            fg = Lf[384 + k]; s = fg * s + (1.0f - fg) * v3; o3 += Lq[384 + k] * s;
            a.out[O_SC + sbase + (size_t)k * 128 + v] = s; }
        Lr[(kq * 4 + 0) * 128 + v] = o0; Lr[(kq * 4 + 1) * 128 + v] = o1; Lr[(kq * 4 + 2) * 128 + v] = o2; Lr[(kq * 4 + 3) * 128 + v] = o3;
        __syncthreads();
        { const int t = F.tid >> 7, vv = F.tid & 127; const float o = Lr[(0 * 4 + t) * 128 + vv] + Lr[(1 * 4 + t) * 128 + vv] + Lr[(2 * 4 + t) * 128 + vv] + Lr[(3 * 4 + t) * 128 + vv];
          O[((size_t)MP + bs * 4 + t) * D + h * 128 + vv] = o; }
    }
    const int b = F.bid >> 6, h = (F.bid >> 3) & 7, seg = F.bid & 7, w = F.wave, tl = F.lane & 15, g4 = F.lane >> 4;
    f32x4* XCH = (f32x4*)(ws + WS_XCH); float* XP = (float*)(ws + WS_XP);
    f32x4 S[8];
    {
#pragma unroll
        for (int i = 0; i < 8; ++i) S[i] = (f32x4){0.f, 0.f, 0.f, 0.f};
        float Lsum = 0.f;
        hgrn_chunks<false>(F, PC, LB, O, S, Lsum, b, h, seg);
#pragma unroll
        for (int kt = 0; kt < 8; ++kt) XCH[(((size_t)F.bid * 8 + w) * 8 + kt) * 64 + F.lane] = S[kt];
        if (F.tid < 128) XP[F.bid * 128 + F.tid] = __expf(Lsum);
    }
    xcd_barrier(bar);
#pragma unroll
    for (int i = 0; i < 8; ++i) S[i] = (f32x4){0.f, 0.f, 0.f, 0.f};
    for (int sj = 0; sj < seg; ++sj) { const int blk = (F.bid & ~7) + sj;
#pragma unroll
        for (int kt = 0; kt < 8; ++kt) { const f32x4 p4 = *(const f32x4*)(XP + blk * 128 + 16 * kt + 4 * g4); S[kt] = S[kt] * p4 + XCH[(((size_t)blk * 8 + w) * 8 + kt) * 64 + F.lane]; } }
    {
        float Lsum = 0.f;
        hgrn_chunks<true>(F, PC, LB, O, S, Lsum, b, h, seg);
    }
    if (seg == 7) {
#pragma unroll
        for (int kt = 0; kt < 8; ++kt)
#pragma unroll
            for (int i = 0; i < 4; ++i) a.out[O_PC + ((size_t)(b * 8 + h) * 128 + 16 * kt + 4 * g4 + i) * 128 + 16 * w + tl] = S[kt][i];
    }
}

__device__ __forceinline__ void hgrn_out(const Args& a, Frame& F, const bf16* PC, const float* OB, bf16* CO) {
    const float* cn = a.in[I_CNORM];
    for (int m = F.gw; m < M; m += NGW) {
        const float* O = OB + (size_t)m * D;
        const bf16* gate = PC + (size_t)m * CC + 3072;
        f32x4 v[4]; float s = 0.f;
#pragma unroll
        for (int j = 0; j < 4; ++j) { v[j] = *(const f32x4*)(O + 256 * j + 4 * F.lane); s += (v[j].x * v[j].x + v[j].y * v[j].y) + (v[j].z * v[j].z + v[j].w * v[j].w); }
        s = wave_sum(s);
        const float rs = __builtin_amdgcn_rsqf(s * (1.0f / 1024.0f) + EPS);
#pragma unroll
        for (int j = 0; j < 4; ++j) { const int c = 256 * j + 4 * F.lane; const f32x4 g = *(const f32x4*)(cn + c); const v2u gw = *(const v2u*)(gate + c);
            const float x0 = v[j].x * rs * g.x * siluf_(bflo(gw.x)), x1 = v[j].y * rs * g.y * siluf_(bfhi(gw.x)), x2 = v[j].z * rs * g.z * siluf_(bflo(gw.y)), x3 = v[j].w * rs * g.w * siluf_(bfhi(gw.y));
            v2u w; w.x = pk2(x0, x1); w.y = pk2(x2, x3); *(v2u*)(CO + (size_t)m * D + c) = w; }
    }
}

__device__ __forceinline__ void final_norm(const Args& a, Frame& F, const float* rsq) {
    const float* g = a.in[I_NFIN];
    for (int m = F.gw; m < M; m += NGW) {
        float* X = a.out + (size_t)m * D;
        const float rs = __builtin_amdgcn_rsqf(rsq[m] * (1.0f / 1024.0f) + EPS);
#pragma unroll
        for (int j = 0; j < 4; ++j) { const int c = 256 * j + 4 * F.lane; f32x4 v = *(const f32x4*)(X + c); const f32x4 gg = *(const f32x4*)(g + c); v = v * rs * gg; *(f32x4*)(X + c) = v; }
    }
}


constexpr int NPHASE = 16;
__global__ void __launch_bounds__(NTHR, 2) mk_fwd(Args args) {
    extern __shared__ __attribute__((aligned(16))) unsigned char lds[];
    Frame F;
    F.lds = (LAS unsigned char*)lds;
    F.tid = threadIdx.x; F.lane = F.tid & 63; F.wave = __builtin_amdgcn_readfirstlane(F.tid >> 6); F.bid = blockIdx.x; F.gw = F.bid * NWAVES + F.wave;
    unsigned char* ws = args.ws;
    gu32* ctl = (gu32*)(ws + WS_CTL);
    volatile LAS unsigned* MISC = (volatile LAS unsigned*)(F.lds + MISC_OFF);
    for (int u = F.tid; u < (BT_OFF - LDSCTL_OFF) / 4; u += NTHR) ((LAS unsigned*)(F.lds + LDSCTL_OFF))[u] = 0u;
    __syncthreads();
    XcdBarrier bar; bar.bar = (unsigned*)(ctl + CW_BAR); bar.x = 0; bar.st = nullptr;
#if !MK_PER_PHASE
    bar = xcd_barrier_post((unsigned*)(ctl + CW_BAR) + args.li * XCD_BAR_WORDS, MISC + 8);
#define GRID_BAR() xcd_barrier(bar)
#else
#define GRID_BAR() do {} while (0)
#endif
    const int lo = args.ph_lo, hi = args.ph_hi;
#define FRESH(G) Frame G = F; asm volatile("" : "+v"(G.tid)); __builtin_assume(G.tid >= 0 && G.tid < NTHR); G.lane = G.tid & 63
#ifndef PH_MASK
#define PH_MASK 0xFFFF
#endif
#define IN(k) ((((PH_MASK) >> (k)) & 1) && lo <= (k) && (k) < hi)
#define SEAM(k) do { if (IN(k) && IN((k) + 1)) GRID_BAR(); } while (0)

    float* rsq = (float*)(ws + WS_CTL + RSQ_OFF);
    bf16* BUF0 = (bf16*)(ws + WS_BUF0); bf16* BUF1 = (bf16*)(ws + WS_BUF1);
    bf16* RA = (bf16*)(ws + WS_A);
    unsigned char* PREP = ws + WS_B;
    bf16* ATTO = (bf16*)(ws + WS_ATTO); float* LSE = (float*)(ws + WS_LSE);
    const int G = (int)gridDim.x;

    if (IN(0)) { FRESH(G); p0_prologue(args, G); }
    SEAM(0);
    if (IN(1)) {
        pg8::Gemm g{BUF0, (const bf16*)(ws + WS_WIN0), MP, EC, D}; pg8::StaticOrder S; S.init(MP, EC, G, F.bid);
        pg8::EpiScale<0> E{RA, EC, rsq};
        pg8::gemm_phase<pg8::EpiScale<0>, pg8::StaticOrder, true, true>(F.lds, g, S, E);
        { FRESH(G); SEpiScale SE{RA, EC, rsq, 0}; sgemm_phase(G, BUF0, (const bf16*)(ws + WS_WIN0), EC, D, SE); }
    }
    SEAM(1);
    if (IN(2)) {
        FRESH(G);
        { const float* BT = (const float*)(ws + WS_TAB); LAS float* bt = (LAS float*)(F.lds + BT_OFF);
          for (int i = G.tid; i < 12 * BT_LD; i += NTHR) bt[i] = BT[i]; }
        __syncthreads();
        const LAS float* bt = (const LAS float*)(F.lds + BT_OFF);
#ifndef PSKIP
#define PSKIP 0
#endif
        const bool prb = (args.li == 1);
        if (!(prb && (PSKIP & 1)))
        for (int t = F.bid; t < NB * 3 * 4 * 16; t += 256) attn_block(G, RA, bt, ATTO, LSE, t);
        if (!(prb && (PSKIP & 2)))
        for (int t = F.gw; t < SB * 12 * 4; t += NGW) sattn_task(args, RA, bt, ATTO, LSE, (LAS float*)(F.lds + F.wave * 16384), t, G.lane);
        __syncthreads();
#ifndef PREPV
#define PREPV 0
#endif
        if (!prb || PREPV == 0) { if (!(prb && (PSKIP & 4)))
        for (int t = MP / 16 + F.bid; t < M / 16; t += 256) prep_block<0>(args, G, RA, (const bf16*)(ws + WS_TAB + 16384), (const bf16*)(ws + WS_SHB), PREP, t); }
        else { for (int t = F.bid; t < M / 16; t += 256) prep_block<(PREPV ? PREPV : 16)>(args, G, RA, (const bf16*)(ws + WS_TAB + 16384), (const bf16*)(ws + WS_SHB), (unsigned char*)args.out, t); }
        if (!(prb && (PSKIP & 8))) kv_copies(RA, args.out, F.bid * NTHR + G.tid);
    }
    SEAM(2);
    if (IN(3)) { FRESH(G);
#ifdef FRONT_TWICE
        { LAS unsigned char* area = G.lds + G.wave * FZ_BYTES;
          v4u stg[16];
          wkv_prep_issue(stg, RA, (const bf16*)(ws + WS_SHB), G.gw >> 8, G.gw & 255, G.lane);
          for (int t = G.gw; t < 48 * 256; t += NGW) { const int tn = (t + NGW < 48 * 256) ? t + NGW : t;
              wkv_prep_chunk<1>(args, stg, RA, (const bf16*)(ws + WS_TAB + 16384), (const bf16*)(ws + WS_SHB), PREP, rec_ptr(ws, args.out, t >> 8, t & 255), area, t >> 8, t & 255, tn >> 8, tn & 255, G.lane); } }
#endif
#ifdef FUSED_TWICE
        { LAS unsigned char* area = G.lds + G.wave * FZ_BYTES;
          v4u stg[16];
          wkv_prep_issue(stg, RA, (const bf16*)(ws + WS_SHB), G.gw >> 8, G.gw & 255, G.lane);
          for (int t = G.gw; t < 48 * 256; t += NGW) { const int tn = (t + NGW < 48 * 256) ? t + NGW : t;
              wkv_prep_chunk<0>(args, stg, RA, (const bf16*)(ws + WS_TAB + 16384), (const bf16*)(ws + WS_SHB), PREP, rec_ptr(ws, args.out, t >> 8, t & 255), area, t >> 8, t & 255, tn >> 8, tn & 255, G.lane); } }
#endif
        { LAS unsigned char* area = G.lds + G.wave * FZ_BYTES;
          v4u stg[16];
          wkv_prep_issue(stg, RA, (const bf16*)(ws + WS_SHB), G.gw >> 8, G.gw & 255, G.lane);
          for (int t = G.gw; t < 48 * 256; t += NGW) { const int tn = (t + NGW < 48 * 256) ? t + NGW : t;
              wkv_prep_chunk<0>(args, stg, RA, (const bf16*)(ws + WS_TAB + 16384), (const bf16*)(ws + WS_SHB), PREP, rec_ptr(ws, args.out, t >> 8, t & 255), area, t >> 8, t & 255, tn >> 8, tn & 255, G.lane); } }
        GRID_BAR();
        wkv_phase2(args, G, PREP, (float*)(ws + WS_YS));
#ifdef SEQ_TWICE
        __syncthreads(); wkv_phase2(args, G, PREP, (float*)(ws + WS_YS));
#endif
        }
    SEAM(3);
    if (IN(4)) { FRESH(G); mix_phase(args, G, PREP, (const float*)(ws + WS_YS), ATTO, LSE, BUF1); }
    SEAM(4);
    if (IN(5)) {
        pg8::Gemm g{BUF1, (const bf16*)(ws + WS_WOUT0), MP, D, D}; pg8::StaticOrder S; S.init(MP, D, G, F.bid);
        pg8::EpiResid E{args.in[I_XP], args.in[I_XS], args.out, BUF0, rsq + 1 * MPAD, M};
        pg8::gemm_phase<pg8::EpiResid, pg8::StaticOrder, true, true>(F.lds, g, S, E);
        { FRESH(G); SEpiResid SE{args.in[I_XS], args.out + (size_t)MP * D, BUF0, rsq + 1 * MPAD}; sgemm_phase(G, BUF1, (const bf16*)(ws + WS_WOUT0), D, D, SE); }
    }
    SEAM(5);
    if (IN(6)) {
        pg8::Gemm g{BUF0, (const bf16*)(ws + WS_WUP0), MP, FF, D}; pg8::StaticOrder S; S.init(MP, FF, G, F.bid);
        pg8::EpiScale<1> E{RA, FF, rsq + 1 * MPAD};
        pg8::gemm_phase<pg8::EpiScale<1>, pg8::StaticOrder, true, true>(F.lds, g, S, E);
        { FRESH(G); SEpiScale SE{RA, FF, rsq + 1 * MPAD, 1}; sgemm_phase(G, BUF0, (const bf16*)(ws + WS_WUP0), FF, D, SE); }
#ifdef SGEMM_TWICE
        { FRESH(G); SEpiScale SE{RA, FF, rsq + 1 * MPAD, 1}; sgemm_phase(G, BUF0, (const bf16*)(ws + WS_WUP0), FF, D, SE); }
        { FRESH(G); SEpiScale SE{RA, FF, rsq + 1 * MPAD, 1}; sgemm_phase(G, BUF0, (const bf16*)(ws + WS_WUP0), FF, D, SE); }
#endif
    }
    SEAM(6);
    if (IN(7)) {
        pg8::Gemm g{RA, (const bf16*)(ws + WS_WDN0), MP, D, FF}; pg8::StaticOrder S; S.init(MP, D, G, F.bid);
        pg8::EpiResid E{args.out, args.out + (size_t)MP * D, args.out, BUF1, rsq + 2 * MPAD, M};
        pg8::gemm_phase<pg8::EpiResid, pg8::StaticOrder, true, true>(F.lds, g, S, E);
        { FRESH(G); SEpiResid SE{args.out + (size_t)MP * D, args.out + (size_t)MP * D, BUF1, rsq + 2 * MPAD}; sgemm_phase(G, RA, (const bf16*)(ws + WS_WDN0), D, FF, SE); }
    }
    SEAM(7);
    if (IN(8)) {
        pg8::Gemm g{BUF1, (const bf16*)(ws + WS_WCIN), MP, CC, D}; pg8::StaticOrder S; S.init(MP, CC, G, F.bid);
        pg8::EpiScale<0> E{RA, CC, rsq + 2 * MPAD};
        pg8::gemm_phase<pg8::EpiScale<0>, pg8::StaticOrder, true, true>(F.lds, g, S, E);
        { FRESH(G); SEpiScale SE{RA, CC, rsq + 2 * MPAD, 0}; sgemm_phase(G, BUF1, (const bf16*)(ws + WS_WCIN), CC, D, SE); }
    }
    SEAM(8);
    if (IN(9)) { }
    if (IN(10)) { FRESH(G); hgrn_fused(args, G, RA, ws, bar); }
    SEAM(10);
    if (IN(11)) { FRESH(G); hgrn_out(args, G, RA, (const float*)(ws + WS_O), BUF0); }
    SEAM(11);
    if (IN(12)) {
        pg8::Gemm g{BUF0, (const bf16*)(ws + WS_WCOUT), MP, D, D}; pg8::StaticOrder S; S.init(MP, D, G, F.bid);
        pg8::EpiResid E{args.out, args.out + (size_t)MP * D, args.out, BUF1, rsq + 3 * MPAD, M};
        pg8::gemm_phase<pg8::EpiResid, pg8::StaticOrder, true, true>(F.lds, g, S, E);
        { FRESH(G); SEpiResid SE{args.out + (size_t)MP * D, args.out + (size_t)MP * D, BUF1, rsq + 3 * MPAD}; sgemm_phase(G, BUF0, (const bf16*)(ws + WS_WCOUT), D, D, SE); }
    }
    SEAM(12);
    if (IN(13)) {
        pg8::Gemm g{BUF1, (const bf16*)(ws + WS_WUP1), MP, FF, D}; pg8::StaticOrder S; S.init(MP, FF, G, F.bid);
        pg8::EpiScale<1> E{RA, FF, rsq + 3 * MPAD};
        pg8::gemm_phase<pg8::EpiScale<1>, pg8::StaticOrder, true, true>(F.lds, g, S, E);
        { FRESH(G); SEpiScale SE{RA, FF, rsq + 3 * MPAD, 1}; sgemm_phase(G, BUF1, (const bf16*)(ws + WS_WUP1), FF, D, SE); }
    }
    SEAM(13);
    if (IN(14)) {
        pg8::Gemm g{RA, (const bf16*)(ws + WS_WDN1), MP, D, FF}; pg8::StaticOrder S; S.init(MP, D, G, F.bid);
        pg8::EpiResid E{args.out, args.out + (size_t)MP * D, args.out, BUF0, rsq + 4 * MPAD, M};
        pg8::gemm_phase<pg8::EpiResid, pg8::StaticOrder, true, true>(F.lds, g, S, E);
        { FRESH(G); SEpiResid SE{args.out + (size_t)MP * D, args.out + (size_t)MP * D, BUF0, rsq + 4 * MPAD}; sgemm_phase(G, RA, (const bf16*)(ws + WS_WDN1), D, FF, SE); }
    }
    SEAM(14);
    if (IN(15)) { FRESH(G); final_norm(args, G, rsq + 4 * MPAD); }
#undef IN
#undef SEAM
}

extern "C" void kernel_launch(void* const* d_in, const int* in_sizes, int n_in, void* d_out, int out_size, void* d_ws, size_t ws_size, hipStream_t stream) {
    static int grid = 0;
    if (grid == 0) {
        if (n_in != 31 || in_sizes[0] != MP * D || out_size != (int)O_END || ws_size < WS_REQUIRED) {
            fprintf(stderr, "kernel_launch: shape/workspace mismatch: n_in %d in0 %d out %d ws %zu (need %zu); nothing launched\n", n_in, n_in > 0 ? in_sizes[0] : -1, out_size, ws_size, (size_t)WS_REQUIRED); grid = -1; return; }
        if (hipFuncSetAttribute((const void*)mk_fwd, hipFuncAttributeMaxDynamicSharedMemorySize, LDS_BYTES) != hipSuccess) { fprintf(stderr, "kernel_launch: hipFuncSetAttribute failed\n"); grid = -1; return; }
        int per_cu = 0;
        if (hipOccupancyMaxActiveBlocksPerMultiprocessor(&per_cu, (const void*)mk_fwd, NTHR, LDS_BYTES) != hipSuccess || per_cu < 1)
            fprintf(stderr, "kernel_launch: note: occupancy query reports %d workgroups per CU\n", per_cu);
        (void)hipGetLastError();
        grid = 256;
    }
    if (grid < 0) return;
    if (hipMemsetAsync((char*)d_ws + WS_CTL, 0, CTL_ZERO_BYTES, stream) != hipSuccess) { fprintf(stderr, "kernel_launch: hipMemsetAsync failed\n"); return; }
    Args a{};
    for (int i = 0; i < 31; ++i) a.in[i] = (const float*)d_in[i];
    a.out = (float*)d_out; a.ws = (unsigned char*)d_ws;
#if MK_PER_PHASE
    for (int p = 0; p < NPHASE; ++p) { a.ph_lo = p; a.ph_hi = p + 1; hipLaunchKernelGGL(mk_fwd, dim3(grid), dim3(NTHR), LDS_BYTES, stream, a); }
#else
#if defined(PROBE_PHASE)
    a.ph_lo = 0; a.ph_hi = PROBE_PHASE + 1; a.li = 0; hipLaunchKernelGGL(mk_fwd, dim3(grid), dim3(NTHR), LDS_BYTES, stream, a);
    a.ph_lo = PROBE_PHASE; a.ph_hi = PROBE_PHASE + 1; a.li = 1; hipLaunchKernelGGL(mk_fwd, dim3(grid), dim3(NTHR), LDS_BYTES, stream, a);
    a.ph_lo = PROBE_PHASE + 1; a.ph_hi = NPHASE; a.li = 2; hipLaunchKernelGGL(mk_fwd, dim3(grid), dim3(NTHR), LDS_BYTES, stream, a);
#else
    a.ph_lo = 0; a.ph_hi = NPHASE;
    hipLaunchKernelGGL(mk_fwd, dim3(grid), dim3(NTHR), LDS_BYTES, stream, a);
#endif
#endif
    const hipError_t le = hipPeekAtLastError();
    if (le != hipSuccess) fprintf(stderr, "kernel_launch: launch failed: %s\n", hipGetErrorName(le));
}
```

```cpp
#include <hip/hip_runtime.h>
#include <cstdio>
#include <cstdint>

#ifndef MK_PER_PHASE
#define MK_PER_PHASE 0
#endif

namespace pg8 {
#define PG8_LAS __attribute__((address_space(3)))
typedef unsigned short bf16_t;
typedef short bf16x8 __attribute__((ext_vector_type(8)));
typedef float f32x4 __attribute__((ext_vector_type(4)));
typedef unsigned u32x4 __attribute__((ext_vector_type(4)));
constexpr int BM = 256, BK = 64, HALF = 128, HTB = HALF * BK * 2  , STAGE_BYTES = 8 * HTB, NXCD = 8, WGM = 8;

__host__ __device__ __forceinline__ int lds_byte(int r, int c) { const int st = (r >> 4) * 2 + (c >> 5), rr = r & 15, cc = c & 31, ob = rr * 64 + cc * 2; return st * 1024 + (ob ^ (((ob >> 9) & 1) << 5)); }
__host__ __device__ __forceinline__ void stage_rc(int b, int& R, int& C) { const int st = b / 1024, sb = b % 1024, swz = sb ^ (((sb >> 9) & 1) << 5); R = (st >> 1) * 16 + swz / 64; C = (st & 1) * 32 + (swz % 64) / 2; }
__host__ __device__ __forceinline__ int perm32(int rho) { const int n = rho >> 4, i = rho & 15; return 8 * (i >> 2) + 4 * n + (i & 3); }

struct Unit { int pm, pn; };
struct Gemm { const bf16_t* A; const bf16_t* Bt; int M, N, K; };

struct StaticOrder {
    int nM, nN, nwg, G, c;
    __host__ __device__ void init(int M, int N, int G_, int c_) { nM = M / BM; nN = N / BM; nwg = nM * nN; G = G_; c = c_; }
    __host__ __device__ bool next(int i, Unit& u) const {
        const long L = (long)i * G + c; if (L >= nwg) return false;
        int wgid = (int)L; { const int q = nwg / NXCD, r = nwg % NXCD, xcd = wgid % NXCD, off = wgid / NXCD; wgid = (xcd < r ? xcd * (q + 1) : r * (q + 1) + (xcd - r) * q) + off; }
        const int nig = WGM * nN, gid = wgid / nig, fm = gid * WGM, gsz = (nM - fm) < WGM ? (nM - fm) : WGM;
        u.pm = fm + ((wgid % nig) % gsz); u.pn = (wgid % nig) / gsz; return true;
    }
    __device__ __forceinline__ void a_ready(const Unit&) const {}
    __device__ __forceinline__ void done(const Unit&) const {}
};


__device__ __forceinline__ unsigned cvt_pk_bf16(float lo, float hi) { unsigned r; asm volatile("v_cvt_pk_bf16_f32 %0, %1, %2" : "=v"(r) : "v"(lo), "v"(hi)); return r; }
typedef unsigned u32x2 __attribute__((ext_vector_type(2)));

template <int RELU2> struct EpiScale {
    static constexpr bool PERM = true, AFTER_DRAIN = false;
    bf16_t* O; int ldc; const float* rsq;
    __device__ __forceinline__ void operator()(const f32x4 (&acc)[2][2][4][2], const Unit& u, int wr, int wc, int fr, int fq) const {
        const int col0 = u.pn * BM + wc * 32 + 8 * fq;
#pragma unroll
        for (int ai = 0; ai < 2; ++ai)
#pragma unroll
            for (int m = 0; m < 4; ++m) {
                const int row = u.pm * BM + ai * HALF + wr * 64 + m * 16 + fr;
                const float s = __builtin_amdgcn_rsqf(rsq[row] * (1.0f / 1024.0f) + 1e-6f);
                bf16_t* rowp = O + (size_t)row * ldc + col0;
#pragma unroll
                for (int bj = 0; bj < 2; ++bj) {
                    f32x4 v0 = acc[ai][bj][m][0] * s, v1 = acc[ai][bj][m][1] * s;
                    if (RELU2) { v0.x = fmaxf(v0.x, 0.f); v0.y = fmaxf(v0.y, 0.f); v0.z = fmaxf(v0.z, 0.f); v0.w = fmaxf(v0.w, 0.f); v0 = v0 * v0;
                                 v1.x = fmaxf(v1.x, 0.f); v1.y = fmaxf(v1.y, 0.f); v1.z = fmaxf(v1.z, 0.f); v1.w = fmaxf(v1.w, 0.f); v1 = v1 * v1; }
                    u32x4 w; w.x = cvt_pk_bf16(v0.x, v0.y); w.y = cvt_pk_bf16(v0.z, v0.w); w.z = cvt_pk_bf16(v1.x, v1.y); w.w = cvt_pk_bf16(v1.z, v1.w);
                    *(u32x4*)(rowp + bj * HALF) = w;
                }
            }
    }
};

struct EpiResid {
    static constexpr bool PERM = true, AFTER_DRAIN = false;
    const float* Rp; const float* Rs;
    float* X; bf16_t* XB; float* rsq; int Mv;
    __device__ __forceinline__ void operator()(const f32x4 (&acc)[2][2][4][2], const Unit& u, int wr, int wc, int fr, int fq) const {
        const int col0 = u.pn * BM + wc * 32 + 8 * fq;
#pragma unroll
        for (int ai = 0; ai < 2; ++ai)
#pragma unroll
            for (int m = 0; m < 4; ++m) {
                const int row = u.pm * BM + ai * HALF + wr * 64 + m * 16 + fr;
                const bool valid = row < Mv;
                const float* rrow = (row < 16384) ? (Rp + (size_t)row * 1024) : (Rs + (size_t)(row - 16384) * 1024);
                float ss = 0.f;
#pragma unroll
                for (int bj = 0; bj < 2; ++bj) {
                    const int col = col0 + bj * HALF;
                    f32x4 x0 = (f32x4){0.f, 0.f, 0.f, 0.f}, x1 = x0;
                    if (valid) {
                        x0 = *(const f32x4*)(rrow + col) + acc[ai][bj][m][0]; x1 = *(const f32x4*)(rrow + col + 4) + acc[ai][bj][m][1];
                        *(f32x4*)(X + (size_t)row * 1024 + col) = x0; *(f32x4*)(X + (size_t)row * 1024 + col + 4) = x1;
                        ss += ((x0.x * x0.x + x0.y * x0.y) + (x0.z * x0.z + x0.w * x0.w)) + ((x1.x * x1.x + x1.y * x1.y) + (x1.z * x1.z + x1.w * x1.w));
                    }
                    u32x4 w; w.x = cvt_pk_bf16(x0.x, x0.y); w.y = cvt_pk_bf16(x0.z, x0.w); w.z = cvt_pk_bf16(x1.x, x1.y); w.w = cvt_pk_bf16(x1.z, x1.w);
                    *(u32x4*)(XB + (size_t)row * 1024 + col) = w;
                }
                ss += __shfl_xor(ss, 16); ss += __shfl_xor(ss, 32);
                if (fq == 0 && valid) unsafeAtomicAdd(rsq + row, ss);
            }
    }
};

template <class Epi, class Sched, bool ALIGN_EPI = false, bool SP2 = false>
__device__ __forceinline__ void gemm_phase(PG8_LAS unsigned char* lds, const Gemm g, const Sched& S, const Epi& E) {
    int tid_ = threadIdx.x; asm volatile("" : "+v"(tid_)); __builtin_assume(tid_ >= 0 && tid_ < 512);
    const int tid = tid_, wid = __builtin_amdgcn_readfirstlane(tid >> 6), lane = tid & 63, wr = wid >> 2, wc = wid & 3, fr = lane & 15, fq = lane >> 4;
    const int K = g.K, nt = K / BK;
    unsigned voffA[2], voffB[2];
#pragma unroll
    for (int i = 0; i < 2; ++i) { int R, C; stage_rc(tid * 16 + i * 8192, R, C); const int Rb = Epi::PERM ? ((R & ~31) + perm32(R & 31)) : R;
        voffA[i] = (unsigned)(R * K + C) * 2u; voffB[i] = (unsigned)(Rb * K + C) * 2u; }
    const size_t kstep = (size_t)(BK * 2);
    const size_t hstep = (size_t)HALF * K * 2;
    const size_t tstep = 2 * hstep;
    const unsigned ldsw = (unsigned)wid * 1024u;
    const int aoff = lds_byte(wr * 64 + fr, fq * 8), boff = lds_byte(wc * 32 + fr, fq * 8);
#define PG8_SA(b, h) (((b) * 2 + (h)) * HTB)
#define PG8_SB(b, h) ((4 + (b) * 2 + (h)) * HTB)
#define PG8_STAGE(bufoff, gbase, voff) do { _Pragma("unroll") for (int _i = 0; _i < 2; ++_i) \
        __builtin_amdgcn_global_load_lds((const unsigned*)((const char*)(gbase) + (voff)[_i]), (PG8_LAS unsigned*)(lds + (bufoff) + ldsw + _i * 8192), 16, 0, 0); } while (0)
#define PG8_LDA(dst, b, h) do { _Pragma("unroll") for (int m = 0; m < 4; ++m) _Pragma("unroll") for (int k = 0; k < 2; ++k) dst[m][k] = *(const PG8_LAS bf16x8*)(lds + PG8_SA(b, h) + aoff + m * 2048 + k * 1024); } while (0)
#define PG8_LDB(dst, b, h) do { _Pragma("unroll") for (int n = 0; n < 2; ++n) _Pragma("unroll") for (int k = 0; k < 2; ++k) dst[n][k] = *(const PG8_LAS bf16x8*)(lds + PG8_SB(b, h) + boff + n * 2048 + k * 1024); } while (0)
#define PG8_MMA(ai, bj, At, Bt) do { __builtin_amdgcn_s_setprio(1); _Pragma("unroll") for (int m = 0; m < 4; ++m) _Pragma("unroll") for (int n = 0; n < 2; ++n) _Pragma("unroll") for (int k = 0; k < 2; ++k) \
        acc[ai][bj][m][n] = __builtin_amdgcn_mfma_f32_16x16x32_bf16(Bt[n][k], At[m][k], acc[ai][bj][m][n], 0, 0, 0); __builtin_amdgcn_s_setprio(0); } while (0)
#define PG8_WAIT_V(n) asm volatile("s_waitcnt vmcnt(" #n ")" ::: "memory")
#define PG8_WAIT_L(n) asm volatile("s_waitcnt lgkmcnt(" #n ")" ::: "memory")
#define PG8_BAR __builtin_amdgcn_s_barrier()
#define PG8_SCHED __builtin_amdgcn_sched_barrier(0)
    Unit cur, nxt; int ui = 0;
    if (!S.next(0, cur)) return;
    f32x4 acc[2][2][4][2];
#pragma unroll
    for (int a = 0; a < 2; ++a)
#pragma unroll
        for (int b = 0; b < 2; ++b)
#pragma unroll
            for (int m = 0; m < 4; ++m)
#pragma unroll
                for (int n = 0; n < 2; ++n) acc[a][b][m][n] = (f32x4){0.f, 0.f, 0.f, 0.f};
    bf16x8 At[4][2], B0[2][2], B1[2][2];
    const char* cA = (const char*)g.A + (size_t)cur.pm * tstep; const char* cB = (const char*)g.Bt + (size_t)cur.pn * tstep;
    S.a_ready(cur);
    if constexpr (SP2) {
        PG8_STAGE(PG8_SB(0, 0), cB, voffB); PG8_STAGE(PG8_SB(0, 1), cB + hstep, voffB); PG8_STAGE(PG8_SA(0, 0), cA, voffA); PG8_STAGE(PG8_SA(0, 1), cA + hstep, voffA);
        if (wr == 1) PG8_BAR;
        PG8_WAIT_V(2); PG8_BAR;
        PG8_STAGE(PG8_SB(1, 0), cB + kstep, voffB); PG8_STAGE(PG8_SA(1, 0), cA + kstep, voffA); PG8_STAGE(PG8_SB(1, 1), cB + hstep + kstep, voffB);
        PG8_WAIT_V(6); PG8_BAR;
    } else {
        PG8_STAGE(PG8_SB(0, 0), cB, voffB); PG8_STAGE(PG8_SA(0, 0), cA, voffA); PG8_STAGE(PG8_SB(0, 1), cB + hstep, voffB); PG8_STAGE(PG8_SA(0, 1), cA + hstep, voffA);
        if (wr == 1) PG8_BAR;
        PG8_WAIT_V(4); PG8_BAR;
        PG8_STAGE(PG8_SB(1, 0), cB + kstep, voffB); PG8_STAGE(PG8_SA(1, 0), cA + kstep, voffA); PG8_STAGE(PG8_SB(1, 1), cB + hstep + kstep, voffB);
        PG8_WAIT_V(6); PG8_BAR;
    }
    for (;;) {
        const bool has_next = S.next(ui + 1, nxt);
        const char* nA = has_next ? (const char*)g.A + (size_t)nxt.pm * tstep : cA; const char* nB = has_next ? (const char*)g.Bt + (size_t)nxt.pn * tstep : cB;
        for (int t = 0; t < nt; t += 2) {
            const bool last = (t == nt - 2);
            const char* a1 = cA + (size_t)(t + 1) * kstep;
            const char* a2 = last ? nA : cA + (size_t)(t + 2) * kstep; const char* b2 = last ? nB : cB + (size_t)(t + 2) * kstep;
            const char* a3 = a2 + kstep; const char* b3 = b2 + kstep;
            if (last && has_next) S.a_ready(nxt);
            if constexpr (SP2) {
            PG8_LDB(B0, 0, 0); PG8_LDB(B1, 0, 1); PG8_SCHED; PG8_LDA(At, 0, 0); PG8_STAGE(PG8_SA(1, 1), a1 + hstep, voffA);
            PG8_WAIT_V(8); PG8_WAIT_L(0); PG8_BAR; PG8_MMA(0, 0, At, B0); PG8_MMA(0, 1, At, B1); PG8_BAR; PG8_SCHED;
            PG8_LDA(At, 0, 1); PG8_STAGE(PG8_SB(0, 0), b2, voffB); PG8_STAGE(PG8_SB(0, 1), b2 + hstep, voffB); PG8_STAGE(PG8_SA(0, 0), a2, voffA);
            PG8_WAIT_V(8); PG8_WAIT_L(0); PG8_BAR; PG8_MMA(1, 0, At, B0); PG8_MMA(1, 1, At, B1); PG8_BAR; PG8_SCHED;
            PG8_LDB(B0, 1, 0); PG8_LDB(B1, 1, 1); PG8_SCHED; PG8_LDA(At, 1, 0); PG8_STAGE(PG8_SA(0, 1), a2 + hstep, voffA);
            PG8_WAIT_V(8); PG8_WAIT_L(0); PG8_BAR; PG8_MMA(0, 0, At, B0); PG8_MMA(0, 1, At, B1); PG8_BAR; PG8_SCHED;
            PG8_LDA(At, 1, 1); PG8_STAGE(PG8_SB(1, 0), b3, voffB); PG8_STAGE(PG8_SB(1, 1), b3 + hstep, voffB); PG8_STAGE(PG8_SA(1, 0), a3, voffA);
            PG8_WAIT_V(8); PG8_WAIT_L(0); PG8_BAR; PG8_MMA(1, 0, At, B0); PG8_MMA(1, 1, At, B1); PG8_BAR; PG8_SCHED;
            } else {
            PG8_LDB(B0, 0, 0); PG8_SCHED; PG8_LDA(At, 0, 0); PG8_STAGE(PG8_SA(1, 1), a1 + hstep, voffA);
            PG8_WAIT_L(8); PG8_BAR; PG8_WAIT_L(0); PG8_MMA(0, 0, At, B0); PG8_BAR; PG8_SCHED;
            PG8_LDB(B1, 0, 1); PG8_STAGE(PG8_SB(0, 0), b2, voffB);
            PG8_BAR; PG8_WAIT_L(0); PG8_MMA(0, 1, At, B1); PG8_BAR;
            PG8_LDA(At, 0, 1); PG8_STAGE(PG8_SA(0, 0), a2, voffA);
            PG8_BAR; PG8_WAIT_L(0); PG8_MMA(1, 0, At, B0); PG8_BAR; PG8_SCHED;
            PG8_STAGE(PG8_SB(0, 1), b2 + hstep, voffB);
            PG8_WAIT_V(6); PG8_BAR; PG8_MMA(1, 1, At, B1); PG8_BAR;
            PG8_LDB(B0, 1, 0); PG8_SCHED; PG8_LDA(At, 1, 0); PG8_STAGE(PG8_SA(0, 1), a2 + hstep, voffA);
            PG8_WAIT_L(8); PG8_BAR; PG8_WAIT_L(0); PG8_MMA(0, 0, At, B0); PG8_BAR; PG8_SCHED;
            PG8_LDB(B1, 1, 1); PG8_STAGE(PG8_SB(1, 0), b3, voffB);
            PG8_BAR; PG8_WAIT_L(0); PG8_MMA(0, 1, At, B1); PG8_BAR;
            PG8_LDA(At, 1, 1); PG8_STAGE(PG8_SA(1, 0), a3, voffA);
            PG8_BAR; PG8_WAIT_L(0); PG8_MMA(1, 0, At, B0); PG8_BAR; PG8_SCHED;
            PG8_STAGE(PG8_SB(1, 1), b3 + hstep, voffB);
            PG8_WAIT_V(6); PG8_BAR; PG8_MMA(1, 1, At, B1); PG8_BAR;
            }
        }
        if constexpr (ALIGN_EPI) { if (wr == 0) PG8_BAR; }
        if constexpr (!Epi::AFTER_DRAIN) { E(acc, cur, wr, wc, fr, fq); S.done(cur); }
        if (!has_next) break;
#pragma unroll
        for (int a = 0; a < 2; ++a)
#pragma unroll
            for (int b = 0; b < 2; ++b)
#pragma unroll
                for (int m = 0; m < 4; ++m)
#pragma unroll
                    for (int n = 0; n < 2; ++n) acc[a][b][m][n] = (f32x4){0.f, 0.f, 0.f, 0.f};
        cur = nxt; cA = nA; cB = nB; ++ui;
        if constexpr (ALIGN_EPI) { if (wr == 1) PG8_BAR; }
    }
    PG8_WAIT_V(0);
    if constexpr (!ALIGN_EPI) { if (wr == 0) PG8_BAR; }
    PG8_BAR;
    if constexpr (Epi::AFTER_DRAIN) { E.fused(acc, cur, wr, wc, fr, fq, lds, wid, lane); S.done(cur); }
#undef PG8_SA
#undef PG8_SB
#undef PG8_STAGE
#undef PG8_LDA
#undef PG8_LDB
#undef PG8_MMA
#undef PG8_WAIT_V
#undef PG8_WAIT_L
#undef PG8_BAR
#undef PG8_SCHED
}
}

#define GAS __attribute__((address_space(1)))
#define LAS __attribute__((address_space(3)))
typedef unsigned short bf16;
typedef unsigned v4u __attribute__((ext_vector_type(4)));
typedef unsigned v2u __attribute__((ext_vector_type(2)));
typedef float f32x4 __attribute__((ext_vector_type(4)));
typedef float f32x2 __attribute__((ext_vector_type(2)));
typedef float f32x16 __attribute__((ext_vector_type(16)));
typedef short bf16x8 __attribute__((ext_vector_type(8)));
typedef GAS unsigned gu32;

constexpr int NWAVES = 8, NTHR = 512;
constexpr int D = 1024, T = 4096, NB = 4, MP = NB * T, SB = 32, ST = 4, MS = SB * ST, M = MP + MS, MPAD = 16640;
constexpr int EC = 5120, ECR = 4896, AQKV = 2304, BCOLS = 2592, CC = 4096, FF = 4096, BW = 768;
constexpr int LORA = 288;
constexpr float EPS = 1e-6f, LNX_EPS = 64e-5f, LOG2E = 1.4426950408889634f;
constexpr float QSCALE2 = 0.125f * LOG2E;
constexpr int BT_LD = 132;

constexpr size_t O_YP = 0, O_YS = (size_t)MP * D, O_PA0 = (size_t)M * D;
constexpr size_t O_PA1 = O_PA0 + (size_t)4 * 128 * 512, O_PA2 = O_PA1 + (size_t)4 * 512 * 512, O_PSH = O_PA2 + (size_t)4 * 2048 * 512;
constexpr size_t O_PWKV = O_PSH + (size_t)4 * BCOLS, O_PC = O_PWKV + (size_t)4 * 12 * 64 * 64, O_SA0 = O_PC + (size_t)4 * 8 * 128 * 128;
constexpr size_t O_SA1 = O_SA0 + (size_t)32 * 4 * 512, O_SA2 = O_SA1 + (size_t)32 * 4 * 512, O_SSH = O_SA2 + (size_t)32 * 4 * 512;
constexpr size_t O_SWKV = O_SSH + (size_t)32 * BCOLS, O_SC = O_SWKV + (size_t)32 * 12 * 64 * 64, O_END = O_SC + (size_t)32 * 8 * 128 * 128;
static_assert(O_END == 29191296, "output size");

constexpr size_t MiB = 1u << 20;
constexpr size_t WS_CTL = 0, CTL_ZERO_BYTES = 1 * MiB;
constexpr int CW_BAR = 4096;
constexpr int CW_PROG = 15360;
constexpr size_t RSQ_OFF = 65536;
constexpr size_t WS_TAB = 1 * MiB;
constexpr size_t WS_SHB = 1 * MiB + 512 * 1024;
constexpr size_t WS_WIN0 = 2 * MiB;
constexpr size_t WS_WOUT0 = WS_WIN0 + (size_t)EC * D * 2;
constexpr size_t WS_WUP0 = WS_WOUT0 + (size_t)D * D * 2;
constexpr size_t WS_WDN0 = WS_WUP0 + (size_t)FF * D * 2;
constexpr size_t WS_WCIN = WS_WDN0 + (size_t)FF * D * 2;
constexpr size_t WS_WCOUT = WS_WCIN + (size_t)CC * D * 2;
constexpr size_t WS_WUP1 = WS_WCOUT + (size_t)D * D * 2;
constexpr size_t WS_WDN1 = WS_WUP1 + (size_t)FF * D * 2;
constexpr size_t WS_BUF0 = WS_WDN1 + (size_t)FF * D * 2;
constexpr size_t WS_BUF1 = WS_BUF0 + (size_t)MPAD * D * 2;
constexpr size_t WS_ATTO = WS_BUF1 + (size_t)MPAD * D * 2;
constexpr size_t WS_LSE = WS_ATTO + (size_t)3 * M * 256 * 2;
constexpr size_t WS_SQ = WS_LSE + (size_t)3 * M * 4 * 4;
constexpr size_t WS_A = ((WS_SQ + (size_t)MS * 3 * 1024 * 4 + 255) / 256) * 256;
constexpr size_t WS_B = WS_A + (size_t)MPAD * EC * 2;
constexpr int NPREP = 48 * T + 384 * ST;
constexpr size_t WS_END = WS_B + (size_t)NPREP * 1024;
constexpr size_t WS_QE = WS_B, WS_KE = WS_QE + (size_t)MP * D * 2, WS_KET = WS_KE + (size_t)MP * D * 2, WS_VT = WS_KET + (size_t)MP * D * 2, WS_EBL = WS_VT + (size_t)MP * D * 2;
static_assert(WS_EBL + (size_t)(MP / 16) * D * 4 <= WS_END, "region B");

constexpr int RING_BYTES = 131072, LDSCTL_OFF = RING_BYTES, MISC_OFF = LDSCTL_OFF + 320, BT_OFF = 135168, LDS_BYTES = 147456;
static_assert(BT_OFF + 12 * BT_LD * 4 <= LDS_BYTES && MISC_OFF + 128 <= BT_OFF, "LDS map");

#define RLX_AGENT __ATOMIC_RELAXED, __HIP_MEMORY_SCOPE_AGENT
#define LDS_WAIT() asm volatile("s_waitcnt lgkmcnt(0)" ::: "memory")
#define VM_WAIT() asm volatile("s_waitcnt vmcnt(0)" ::: "memory")
typedef __bf16 bf16x2_t __attribute__((ext_vector_type(2)));
__device__ __forceinline__ unsigned pk2(float lo, float hi) { const f32x2 v = {lo, hi}; const bf16x2_t b = __builtin_convertvector(v, bf16x2_t); return __builtin_bit_cast(unsigned, b); }
__device__ __forceinline__ unsigned f2bf(float f) { return pk2(f, 0.f) & 0xffffu; }
__device__ __forceinline__ float bf2f(unsigned short b) { return __uint_as_float((unsigned)b << 16); }
__device__ __forceinline__ float bflo(unsigned w) { return __uint_as_float(w << 16); }
__device__ __forceinline__ float bfhi(unsigned w) { return __uint_as_float(w & 0xffff0000u); }
__device__ __forceinline__ float wave_sum(float v) {
#pragma unroll
    for (int o = 1; o < 64; o <<= 1) v += __shfl_xor(v, o);
    return v;
}
__device__ __forceinline__ float wave_max(float v) {
#pragma unroll
    for (int o = 1; o < 64; o <<= 1) v = fmaxf(v, __shfl_xor(v, o));
    return v;
}
__device__ __forceinline__ float rcpf_(float x) { return __builtin_amdgcn_rcpf(x); }
__device__ __forceinline__ float sigmoidf_(float x) { return rcpf_(1.0f + __expf(-x)); }
__device__ __forceinline__ float siluf_(float x) { return x * rcpf_(1.0f + __expf(-x)); }

#define XB_TMO      128
#define XB_XCNT(j)  (256  + 64 * (j))
#define XB_XSUB(j)  (1280 + 64 * (j))
#define XB_XGEN(j)  (2304 + 64 * (j))
#define XB_TOP      3328
#define XB_TOPGEN   3392
#define XCD_BAR_WORDS 3456
#define XB_SPIN_CAP (1u << 18)

__device__ __forceinline__ unsigned xb_ld(unsigned* p)              { return __hip_atomic_load(p, __ATOMIC_RELAXED, __HIP_MEMORY_SCOPE_AGENT); }
__device__ __forceinline__ unsigned xb_add(unsigned* p, unsigned v) { return __hip_atomic_fetch_add(p, v, __ATOMIC_RELAXED, __HIP_MEMORY_SCOPE_AGENT); }
__device__ __forceinline__ unsigned xb_xcc_id() { return (unsigned)__builtin_amdgcn_s_getreg((3 << 11) | 20) & 0xFu; }
#define XB_SPIN(cond, bar) do { unsigned _sp = 0; while (cond) { __builtin_amdgcn_s_sleep(1); \
    if ((++_sp & 255u) == 0u) { if (xb_ld(&(bar)[XB_TMO])) break; if (_sp > XB_SPIN_CAP) { atomicAdd(&(bar)[XB_TMO], 1u); break; } } } } while (0)

struct XcdBarrier {
    unsigned* bar; unsigned x;
    volatile LAS unsigned* st;
};

__device__ __forceinline__ XcdBarrier xcd_barrier_post(unsigned* bar, volatile LAS unsigned* st) {
    XcdBarrier b; b.bar = bar; b.x = xb_xcc_id(); b.st = st;
    if (threadIdx.x == 0) (void)xb_add(&bar[XB_XCNT(b.x)], 1u);
    return b;
}
__device__ __forceinline__ void xcd_barrier_complete(unsigned* bar, unsigned x, unsigned& nloc, unsigned& nx) {
    const unsigned G = gridDim.x * gridDim.y * gridDim.z;
    unsigned sum, cnt, mine, sp = 0u;
    for (;;) {
        sum = 0u; cnt = 0u; mine = 0u;
#pragma unroll
        for (unsigned j = 0; j < 16; ++j) { const unsigned c = xb_ld(&bar[XB_XCNT(j)]); sum += c; cnt += (c > 0u) ? 1u : 0u; mine = (j == x) ? c : mine; }
        if (sum == G) break;
        __builtin_amdgcn_s_sleep(1);
        if ((++sp & 255u) == 0u) { if (xb_ld(&bar[XB_TMO])) break; if (sp > XB_SPIN_CAP) { atomicAdd(&bar[XB_TMO], 1u); break; } }
    }
    nloc = mine > 0u ? mine : 1u; nx = cnt > 0u ? cnt : 1u;
}

__device__ __forceinline__ void xcd_barrier(const XcdBarrier& b) {
    asm volatile("s_waitcnt vmcnt(0)" ::: "memory");
    __syncthreads();
    if (threadIdx.x == 0) {
        unsigned* bar = b.bar;
        __builtin_amdgcn_s_waitcnt(0);
        unsigned nloc = b.st[0], nx = b.st[1];
        if (nloc == 0u) { xcd_barrier_complete(bar, b.x, nloc, nx); b.st[0] = nloc; b.st[1] = nx; }
        const unsigned old = xb_add(&bar[XB_XSUB(b.x)], 1u);
        const unsigned gen = old / nloc;
        if (old + 1u == (gen + 1u) * nloc) {
            __builtin_amdgcn_fence(__ATOMIC_RELEASE, "agent");
            asm volatile("s_waitcnt vmcnt(0)" ::: "memory");
            const unsigned og = xb_add(&bar[XB_TOP], 1u);
            const unsigned tg = og / nx;
            if (og + 1u == (tg + 1u) * nx) xb_add(&bar[XB_TOPGEN], 1u);
            else XB_SPIN(xb_ld(&bar[XB_TOPGEN]) == tg, bar);
            __builtin_amdgcn_fence(__ATOMIC_ACQUIRE, "agent");
            xb_add(&bar[XB_XGEN(b.x)], 1u);
            asm volatile("s_waitcnt vmcnt(0)" ::: "memory");
        } else {
            XB_SPIN(xb_ld(&bar[XB_XGEN(b.x)]) == gen, bar);
            __builtin_amdgcn_fence(__ATOMIC_ACQUIRE, "agent");
            asm volatile("s_waitcnt vmcnt(0)" ::: "memory");
        }
    }
    __syncthreads();
}

struct Args { const float* in[31]; float* out; unsigned char* ws; int ph_lo, ph_hi, li, pad; };
enum { I_XP = 0, I_XS, I_CA0, I_CA1, I_CA2, I_SSH, I_SWKV, I_SC, I_RELB, I_NMIX, I_NMLP, I_NFIN, I_EWIN, I_EMU, I_EW0, I_EW2, I_EA0, I_EA2, I_EG2,
       I_EKK, I_EKA, I_ERK, I_ELNW, I_ELNB, I_EWOUT, I_CWIN, I_CLB, I_CNORM, I_CWOUT, I_MUP, I_MDN };

struct Frame {
    LAS unsigned char* lds;
    int tid, lane, wave, bid, gw;
};
constexpr int NGW = 256 * NWAVES, NGT = 256 * NTHR;

__device__ __forceinline__ void p0_transpose_item(const float* W, int K, int N, bf16* WT, const float* gain, LAS float* scr, int item, int lane) {
    const int nblk = N / 32, kb = item / nblk, nb = item % nblk, k0 = 64 * kb, n0 = 32 * nb;
#pragma unroll 8
    for (int i = 0; i < 32; ++i) { const int kk = 2 * i + (lane >> 5); const float gv = gain ? gain[k0 + kk] : 1.0f;
        scr[kk * 33 + (lane & 31)] = W[(size_t)(k0 + kk) * N + n0 + (lane & 31)] * gv; }
    LDS_WAIT(); asm volatile("" ::: "memory");
    const int c = lane & 7;
#pragma unroll
    for (int j = 0; j < 4; ++j) { const int n = (lane >> 3) + 8 * j; const LAS float* s = scr + (8 * c) * 33 + n;
        v4u o; o.x = pk2(s[0 * 33], s[1 * 33]); o.y = pk2(s[2 * 33], s[3 * 33]); o.z = pk2(s[4 * 33], s[5 * 33]); o.w = pk2(s[6 * 33], s[7 * 33]);
        *(GAS v4u*)(WT + (size_t)(n0 + n) * K + k0 + 8 * c) = o; }
    LDS_WAIT(); asm volatile("" ::: "memory");
}

__device__ __forceinline__ int t5_bucket(int dist) {
    if (dist < 16) return dist;
    const float d = (float)dist;
    int large = 16 + (int)(logf(d * (1.0f / 16.0f)) / 4.852030263919617f * 16.0f);
    return large < 31 ? large : 31;
}

constexpr int P0_I_IN = 16 * (ECR / 32), P0_I_SQ = 16 * 32, P0_I_UP = 16 * 128, P0_I_DN = 64 * 32;
constexpr int P0_NITEMS = P0_I_IN + P0_I_SQ + P0_I_UP + P0_I_DN + P0_I_UP + P0_I_SQ + P0_I_UP + P0_I_DN;
__device__ __forceinline__ void p0_convert_items(const Args& a, LAS float* scr, int lane, int first, int last, int wid, int nw) {
    unsigned char* ws = a.ws;
    for (int it = first + wid; it < last; it += nw) {
        int r = it;
        if (r < P0_I_IN) { p0_transpose_item(a.in[I_EWIN], D, ECR, (bf16*)(ws + WS_WIN0), a.in[I_NMIX], scr, r, lane); continue; } r -= P0_I_IN;
        if (r < P0_I_SQ) { p0_transpose_item(a.in[I_EWOUT], D, D, (bf16*)(ws + WS_WOUT0), nullptr, scr, r, lane); continue; } r -= P0_I_SQ;
        if (r < P0_I_UP) { p0_transpose_item(a.in[I_MUP], D, FF, (bf16*)(ws + WS_WUP0), a.in[I_NMLP], scr, r, lane); continue; } r -= P0_I_UP;
        if (r < P0_I_DN) { p0_transpose_item(a.in[I_MDN], FF, D, (bf16*)(ws + WS_WDN0), nullptr, scr, r, lane); continue; } r -= P0_I_DN;
        if (r < P0_I_UP) { p0_transpose_item(a.in[I_CWIN], D, CC, (bf16*)(ws + WS_WCIN), a.in[I_NMIX] + D, scr, r, lane); continue; } r -= P0_I_UP;
        if (r < P0_I_SQ) { p0_transpose_item(a.in[I_CWOUT], D, D, (bf16*)(ws + WS_WCOUT), nullptr, scr, r, lane); continue; } r -= P0_I_SQ;
        if (r < P0_I_UP) { p0_transpose_item(a.in[I_MUP] + (size_t)D * FF, D, FF, (bf16*)(ws + WS_WUP1), a.in[I_NMLP] + D, scr, r, lane); continue; } r -= P0_I_UP;
        p0_transpose_item(a.in[I_MDN] + (size_t)FF * D, FF, D, (bf16*)(ws + WS_WDN1), nullptr, scr, r, lane);
    }
}

__device__ __forceinline__ void p0_prologue(const Args& a, Frame& F) {
    unsigned char* ws = a.ws;
    LAS float* scr = (LAS float*)(F.lds + F.wave * 16384);
    p0_convert_items(a, scr, F.lane, 0, P0_I_IN, F.gw, NGW);
    const int gt = F.bid * NTHR + F.tid;
    { v4u* z = (v4u*)(ws + WS_WIN0 + (size_t)ECR * D * 2); const int n = (EC - ECR) * D * 2 / 16;
      for (int i = gt; i < n; i += NGT) z[i] = (v4u){0u, 0u, 0u, 0u}; }
    { float* BT = (float*)(ws + WS_TAB); const float* rb = a.in[I_RELB];
      for (int i = gt; i < 12 * 129; i += NGT) { const int hd = i / 129, j = i % 129, g = hd >> 2; const int dist = j << (2 * g);
          BT[hd * BT_LD + j] = rb[t5_bucket(dist) * 12 + hd] * LOG2E; }
      float* LB = (float*)(ws + WS_TAB + 8192); const float* lr = a.in[I_CLB];
      for (int i = gt; i < 1024; i += NGT) LB[i] = 1.0f / (1.0f + expf(lr[i] - lr[1024 + i]));
      bf16* LW = (bf16*)(ws + WS_TAB + 16384); const float* w2 = a.in[I_EW2]; const float* a2 = a.in[I_EA2]; const float* g2 = a.in[I_EG2];
      for (int i = gt; i < BW * LORA; i += NGT) { const int ch = i / LORA, j = i % LORA;
          const float v = j < 64 ? w2[j * BW + ch] : (j < 128 ? a2[(j - 64) * BW + ch] : g2[(j - 128) * BW + ch]);
          LW[i] = (bf16)f2bf(v); } }
    { bf16* SHB = (bf16*)(ws + WS_SHB); const float* ss = a.in[I_SSH];
      for (int i = gt; i < 33 * BCOLS; i += NGT) SHB[i] = (i < 32 * BCOLS) ? (bf16)f2bf(ss[i]) : (bf16)0; }
    { bf16* B0 = (bf16*)(ws + WS_BUF0); bf16* B1 = (bf16*)(ws + WS_BUF1); float* rsq0 = (float*)(ws + WS_CTL + RSQ_OFF);
      for (int m = F.gw; m < MPAD; m += NGW) {
          unsigned long long* o8 = (unsigned long long*)(B0 + (size_t)m * D) + F.lane;
          if (m < M) {
              const float* xr = (m < MP) ? (a.in[I_XP] + (size_t)m * D) : (a.in[I_XS] + (size_t)(m - MP) * D);
              const f32x4* x4 = (const f32x4*)xr + F.lane; f32x4 v[4]; float s = 0.f;
#pragma unroll
              for (int j = 0; j < 4; ++j) { v[j] = x4[64 * j]; s += (v[j].x * v[j].x + v[j].y * v[j].y) + (v[j].z * v[j].z + v[j].w * v[j].w); }
              s = wave_sum(s);
#pragma unroll
              for (int j = 0; j < 4; ++j) o8[64 * j] = (unsigned long long)pk2(v[j].x, v[j].y) | ((unsigned long long)pk2(v[j].z, v[j].w) << 32);
              if (F.lane == 0) rsq0[m] = s;
          } else {
              unsigned long long* p8 = (unsigned long long*)(B1 + (size_t)m * D) + F.lane;
#pragma unroll
              for (int j = 0; j < 4; ++j) { o8[64 * j] = 0ull; p8[64 * j] = 0ull; }
          }
      } }
}

__device__ __forceinline__ f32x16 mfma32(bf16x8 a, bf16x8 b, f32x16 c) { return __builtin_amdgcn_mfma_f32_32x32x16_bf16(a, b, c, 0, 0, 0); }
__device__ __forceinline__ f32x4 mfma16(bf16x8 a, bf16x8 b, f32x4 c) { return __builtin_amdgcn_mfma_f32_16x16x32_bf16(a, b, c, 0, 0, 0); }

struct SEpiScale {
    bf16* O; int ldc; const float* rsq; int relu2;
    __device__ __forceinline__ void operator()(int row, int col, f32x4 v, int fq) const {
        const float s = __builtin_amdgcn_rsqf(rsq[row] * (1.0f / 1024.0f) + EPS);
        v = v * s;
        if (relu2) { v.x = fmaxf(v.x, 0.f); v.y = fmaxf(v.y, 0.f); v.z = fmaxf(v.z, 0.f); v.w = fmaxf(v.w, 0.f); v = v * v; }
        v2u w; w.x = pk2(v.x, v.y); w.y = pk2(v.z, v.w);
        *(v2u*)(O + (size_t)row * ldc + col) = w;
    }
};
struct SEpiResid {
    const float* R; float* X; bf16* XB; float* rsq;
    __device__ __forceinline__ void operator()(int row, int col, f32x4 v, int fq) const {
        const size_t o = (size_t)(row - MP) * 1024 + col;
        const f32x4 x = *(const f32x4*)(R + o) + v;
        *(f32x4*)(X + o) = x;
        v2u w; w.x = pk2(x.x, x.y); w.y = pk2(x.z, x.w);
        *(v2u*)(XB + (size_t)row * 1024 + col) = w;
        float ss = (x.x * x.x + x.y * x.y) + (x.z * x.z + x.w * x.w);
        ss += __shfl_xor(ss, 16); ss += __shfl_xor(ss, 32);
        if (fq == 0) unsafeAtomicAdd(rsq + row, ss);
    }
};
template <class Epi>
__device__ __forceinline__ void sgemm_phase(Frame& F, const bf16* __restrict__ A, const bf16* __restrict__ Bt, int N, int K, const Epi& E) {
    const int fr = F.lane & 15, fq = F.lane >> 4, w = F.wave;
    const int kw = K >> 3;
    LAS f32x4* red = (LAS f32x4*)F.lds;
    for (int u = F.bid; u < (N >> 4); u += 256) {
        const int n0 = u << 4;
        f32x4 acc[8];
#pragma unroll
        for (int mt = 0; mt < 8; ++mt) acc[mt] = (f32x4){0.f, 0.f, 0.f, 0.f};
        const bf16* ap = A + (size_t)(MP + fr) * K + w * kw + 8 * fq;
        const bf16* bp = Bt + (size_t)(n0 + fr) * K + w * kw + 8 * fq;
        for (int k0 = 0; k0 < kw; k0 += 128) {
            bf16x8 bfr[4], afr[4][8];
#pragma unroll
            for (int kk = 0; kk < 4; ++kk) { const int k = k0 + 32 * kk;
                bfr[kk] = *(const bf16x8*)(bp + k);
#pragma unroll
                for (int mt = 0; mt < 8; ++mt) afr[kk][mt] = *(const bf16x8*)(ap + (size_t)(16 * mt) * K + k); }
#pragma unroll
            for (int kk = 0; kk < 4; ++kk)
#pragma unroll
                for (int mt = 0; mt < 8; ++mt) acc[mt] = mfma16(bfr[kk], afr[kk][mt], acc[mt]);
        }
#pragma unroll
        for (int mt = 0; mt < 8; ++mt) red[(w * 8 + mt) * 64 + F.lane] = acc[mt];
        __syncthreads();
        f32x4 sum = red[(0 * 8 + w) * 64 + F.lane];
#pragma unroll
        for (int j = 1; j < 8; ++j) sum = sum + red[(j * 8 + w) * 64 + F.lane];
        E(MP + 16 * w + fr, n0 + 4 * fq, sum, fq);
        __syncthreads();
    }
}


constexpr int AT_ROW = 144, AT_K = 0, AT_V = 384 * AT_ROW;
static_assert(2 * 384 * AT_ROW <= RING_BYTES && 8 * 32 * AT_ROW <= AT_V, "attention LDS");
__device__ __forceinline__ void attn_block(Frame& F, const bf16* __restrict__ PROJ, const LAS float* bt, bf16* ATTO, float* LSE, int btask) {
    const int lane = F.lane, w = F.wave;
    const int ti8 = btask & 15; int rest = btask >> 4; const int hs = rest & 3; rest >>= 2; const int g = rest % 3; const int b = rest / 3;
    const int dsh = 2 * g, dil = 1 << dsh, tpr = (T >> dsh) >> 5;
    const int r = (ti8 * 8) / tpr, s0blk = ((ti8 * 8) % tpr) * 32, hd = 4 * g + hs;
    const int q = lane & 31, hh = lane >> 5;
    const size_t rowbase = (size_t)b * T + r;
    const int s0 = s0blk + 32 * w;
    const bf16* Qp = PROJ + (rowbase + (size_t)dil * (s0 + q)) * EC + hd * 64 + 8 * hh;
    bf16x8 qf[4];
#pragma unroll
    for (int ks = 0; ks < 4; ++ks) qf[ks] = *(const bf16x8*)(Qp + 16 * ks);
    {
        v4u stg[12];
#pragma unroll
        for (int i = 0; i < 12; ++i) { const int idx = F.tid + NTHR * i, kv = idx / 3072, rem = idx - kv * 3072, row = rem >> 3, piece = rem & 7;
            int sk = s0blk - 128 + row; sk = sk < 0 ? 0 : sk;
            stg[i] = *(const v4u*)(PROJ + (rowbase + (size_t)dil * sk) * EC + (1 + kv) * BW + hd * 64 + piece * 8); }
#pragma unroll
        for (int i = 0; i < 12; ++i) { const int idx = F.tid + NTHR * i, kv = idx / 3072, rem = idx - kv * 3072, row = rem >> 3, piece = rem & 7;
            *(LAS v4u*)(F.lds + (kv ? AT_V : AT_K) + row * AT_ROW + piece * 16) = stg[i]; }
    }
    __syncthreads();
    f32x16 o0, o1;
#pragma unroll
    for (int i = 0; i < 16; ++i) { o0[i] = 0.f; o1[i] = 0.f; }
    float mrun = -1e30f, lrun = 0.f;
    const LAS float* btp = bt + hd * BT_LD;
    for (int kt = 4; kt >= 0; --kt) {
        const int kbase = s0 - 128 + 32 * kt;
        if (kbase + 31 < 0) break;
        const int kb = 32 * w + 32 * kt;
        const LAS unsigned char* kp = F.lds + AT_K + (kb + q) * AT_ROW + 16 * hh;
        bf16x8 kf[4];
#pragma unroll
        for (int ks = 0; ks < 4; ++ks) kf[ks] = *(const LAS bf16x8*)(kp + 32 * ks);
        bf16x8 vf[2][2];
#pragma unroll
        for (int s = 0; s < 2; ++s)
#pragma unroll
            for (int j = 0; j < 8; ++j) {
                const int key = 16 * s + 8 * (j >> 2) + 4 * hh + (j & 3);
                const LAS unsigned short* vp = (const LAS unsigned short*)(F.lds + AT_V + (kb + key) * AT_ROW) + q;
                vf[s][0][j] = (short)vp[0]; vf[s][1][j] = (short)vp[32];
            }
        f32x16 sacc;
#pragma unroll
        for (int i = 0; i < 16; ++i) sacc[i] = 0.f;
#pragma unroll
        for (int ks = 0; ks < 4; ++ks) sacc = mfma32(kf[ks], qf[ks], sacc);
        float x[16]; float tmax = -1e30f;
#pragma unroll
        for (int reg = 0; reg < 16; ++reg) {
            const int i = (reg & 3) + 8 * (reg >> 2) + 4 * hh;
            const int jj = q - i + 128 - 32 * kt;
            const bool valid = (jj >= 0) && (jj <= 128) && (kbase + i >= 0);
            const int jc = jj < 0 ? 0 : (jj > 128 ? 128 : jj);
            const float bv = btp[jc];
            x[reg] = valid ? (sacc[reg] * QSCALE2 + bv) : -1e30f;
            tmax = fmaxf(tmax, x[reg]);
        }
        tmax = fmaxf(tmax, __shfl_xor(tmax, 32));
        const float mnew = fmaxf(mrun, tmax);
        const float alpha = __builtin_amdgcn_exp2f(mrun - mnew);
        float psum = 0.f; float p[16];
#pragma unroll
        for (int reg = 0; reg < 16; ++reg) { p[reg] = __builtin_amdgcn_exp2f(x[reg] - mnew); psum += p[reg]; }
        psum += __shfl_xor(psum, 32);
        lrun = lrun * alpha + psum; mrun = mnew;
#pragma unroll
        for (int i = 0; i < 16; ++i) { o0[i] *= alpha; o1[i] *= alpha; }
        v4u pw0, pw1;
        pw0.x = pk2(p[0], p[1]); pw0.y = pk2(p[2], p[3]); pw0.z = pk2(p[4], p[5]); pw0.w = pk2(p[6], p[7]);
        pw1.x = pk2(p[8], p[9]); pw1.y = pk2(p[10], p[11]); pw1.z = pk2(p[12], p[13]); pw1.w = pk2(p[14], p[15]);
        const bf16x8 pf0 = __builtin_bit_cast(bf16x8, pw0), pf1 = __builtin_bit_cast(bf16x8, pw1);
        o0 = mfma32(vf[0][0], pf0, o0); o0 = mfma32(vf[1][0], pf1, o0);
        o1 = mfma32(vf[0][1], pf0, o1); o1 = mfma32(vf[1][1], pf1, o1);
    }
    const float inv = rcpf_(lrun);
    __syncthreads();
    {
        LAS unsigned char* ob = F.lds + w * (32 * AT_ROW);
        LAS unsigned char* op = ob + q * AT_ROW + 8 * hh;
#pragma unroll
        for (int rg = 0; rg < 4; ++rg) {
            *(LAS v2u*)(op + 16 * rg) = (v2u){pk2(o0[4 * rg] * inv, o0[4 * rg + 1] * inv), pk2(o0[4 * rg + 2] * inv, o0[4 * rg + 3] * inv)};
            *(LAS v2u*)(op + 64 + 16 * rg) = (v2u){pk2(o1[4 * rg] * inv, o1[4 * rg + 1] * inv), pk2(o1[4 * rg + 2] * inv, o1[4 * rg + 3] * inv)};
        }
#pragma unroll
        for (int ps = 0; ps < 4; ++ps) { const int row = 8 * ps + (lane >> 3), piece = lane & 7;
            const v4u v = *(const LAS v4u*)(ob + row * AT_ROW + piece * 16);
            *(v4u*)(ATTO + ((size_t)g * M + rowbase + (size_t)dil * (s0 + row)) * 256 + hs * 64 + piece * 8) = v; }
    }
    if (hh == 0) LSE[((size_t)g * M + rowbase + (size_t)dil * (s0 + q)) * 4 + hs] = mrun + __log2f(lrun);
    __syncthreads();
}

__device__ __forceinline__ void sattn_task(const Args& a, const bf16* __restrict__ PROJ, const LAS float* bt, bf16* ATTO, float* LSE, LAS float* scr, int task, int lane) {
    const int t = task & 3, hd = (task >> 2) % 12, bs = task / 48, g = hd >> 2, hs = hd & 3, dsh = 2 * g, dil = 1 << dsh, W = 128 << dsh;
    const float* cache = a.in[I_CA0 + g];
    const LAS float* btp = bt + hd * BT_LD;
    LAS float* qs = scr; LAS float* ps = scr + 64;
    const size_t m0 = (size_t)MP + bs * 4;
    qs[lane] = bf2f(PROJ[(m0 + t) * EC + hd * 64 + lane]) * QSCALE2;
    LDS_WAIT(); asm volatile("" ::: "memory");
    float xv[3]; float mx = -1e30f;
#pragma unroll
    for (int ksl = 0; ksl < 3; ++ksl) {
        const int j = lane + 64 * ksl; float x = -1e30f;
        if (j <= 128) {
            const int rho = W + t - j * dil; float dot = 0.f;
            if (rho >= W) {
                const bf16* kp = PROJ + (m0 + (rho - W)) * EC + BW + hd * 64;
#pragma unroll 8
                for (int d = 0; d < 64; ++d) dot += bf2f(kp[d]) * qs[d];
            } else {
                const float* kp = cache + (((size_t)bs * W + rho) * 2 + 0) * 256 + hs * 64;
                f32x4 kv[16];
#pragma unroll
                for (int d4 = 0; d4 < 16; ++d4) kv[d4] = *(const f32x4*)(kp + 4 * d4);
#pragma unroll
                for (int d4 = 0; d4 < 16; ++d4) { const LAS float* qq = qs + 4 * d4; dot += kv[d4].x * qq[0] + kv[d4].y * qq[1] + kv[d4].z * qq[2] + kv[d4].w * qq[3]; }
            }
            x = dot + btp[j];
        }
        xv[ksl] = x; mx = fmaxf(mx, x);
    }
    mx = wave_max(mx);
    float psum = 0.f;
#pragma unroll
    for (int ksl = 0; ksl < 3; ++ksl) { const int j = lane + 64 * ksl; const float p = (j <= 128) ? __builtin_amdgcn_exp2f(xv[ksl] - mx) : 0.f; psum += p; if (j <= 128) ps[j] = p; }
    psum = wave_sum(psum);
    LDS_WAIT(); asm volatile("" ::: "memory");
    float acc = 0.f;
    for (int j = 0; j <= 128; ++j) { const int rho = W + t - j * dil; if (rho < W) break; acc += ps[j] * bf2f(PROJ[(m0 + (rho - W)) * EC + 2 * BW + hd * 64 + lane]); }
    const int jc0 = t / dil + 1;
    const float* vb = cache + (((size_t)bs * W + (W + t)) * 2 + 1) * 256 + hs * 64 + lane;
    int j = jc0;
    for (; j + 16 <= 129; j += 16) {
        float vv[16];
#pragma unroll
        for (int u = 0; u < 16; ++u) vv[u] = vb[-(long)(j + u) * dil * 512];
#pragma unroll
        for (int u = 0; u < 16; ++u) acc += ps[j + u] * vv[u];
    }
    for (; j <= 128; ++j) acc += ps[j] * vb[-(long)j * dil * 512];
    ATTO[((size_t)g * M + m0 + t) * 256 + hs * 64 + lane] = (bf16)f2bf(acc * rcpf_(psum));
    if (lane == 0) LSE[((size_t)g * M + m0 + t) * 4 + hs] = mx + __log2f(psum);
    LDS_WAIT(); asm volatile("" ::: "memory");
}

__device__ __forceinline__ f32x4 ld4bf(const bf16* p) { const v2u w = *(const v2u*)p; return (f32x4){bflo(w.x), bfhi(w.x), bflo(w.y), bfhi(w.y)}; }
__device__ __forceinline__ void kv_copies(const bf16* __restrict__ PROJ, float* out, int gt) {
#pragma unroll
    for (int g = 0; g < 3; ++g) {
        const int Wp = 128 << (2 * g); const size_t off = g == 0 ? O_PA0 : (g == 1 ? O_PA1 : O_PA2);
        const int n4 = NB * Wp * 128;
        for (int i4 = gt; i4 < n4; i4 += NGT) { const int i = i4 * 4; const int d = i & 63, hs = (i >> 6) & 3, kv = (i >> 8) & 1, rr = i >> 9, ii = rr % Wp, b = rr / Wp;
            *(f32x4*)(out + off + i) = ld4bf(PROJ + ((size_t)b * T + (T - Wp) + ii) * EC + (1 + kv) * BW + (4 * g + hs) * 64 + d); }
        const size_t soff = g == 0 ? O_SA0 : (g == 1 ? O_SA1 : O_SA2);
        for (int i4 = gt; i4 < SB * ST * 128; i4 += NGT) { const int i = i4 * 4; const int d = i & 63, hs = (i >> 6) & 3, kv = (i >> 8) & 1, rr = i >> 9;
            *(f32x4*)(out + soff + i) = ld4bf(PROJ + ((size_t)MP + rr) * EC + (1 + kv) * BW + (4 * g + hs) * 64 + d); }
    }
    for (int i4 = gt; i4 < NB * BCOLS / 4; i4 += NGT) { const int i = i4 * 4; const int b = i / BCOLS, c = i % BCOLS; *(f32x4*)(out + O_PSH + i) = ld4bf(PROJ + ((size_t)b * T + T - 1) * EC + AQKV + c); }
    for (int i4 = gt; i4 < SB * BCOLS / 4; i4 += NGT) { const int i = i4 * 4; const int b = i / BCOLS, c = i % BCOLS; *(f32x4*)(out + O_SSH + i) = ld4bf(PROJ + ((size_t)MP + b * 4 + 3) * EC + AQKV + c); }
}

__device__ __forceinline__ void xs8(const bf16* cur, const bf16* prv, const float* mu, int col, float* o) {
    const v4u c8 = *(const v4u*)(cur + col), p8 = *(const v4u*)(prv + col);
    const f32x4 m0 = *(const f32x4*)(mu + col), m1 = *(const f32x4*)(mu + col + 4);
    const float c[8] = {bflo(c8.x), bfhi(c8.x), bflo(c8.y), bfhi(c8.y), bflo(c8.z), bfhi(c8.z), bflo(c8.w), bfhi(c8.w)};
    const float p[8] = {bflo(p8.x), bfhi(p8.x), bflo(p8.y), bfhi(p8.y), bflo(p8.z), bfhi(p8.z), bflo(p8.w), bfhi(p8.w)};
    const float mm[8] = {m0.x, m0.y, m0.z, m0.w, m1.x, m1.y, m1.z, m1.w};
#pragma unroll
    for (int i = 0; i < 8; ++i) o[i] = c[i] + (p[i] - c[i]) * mm[i];
}
__device__ __forceinline__ f32x4 xs4(const bf16* cur, const bf16* prv, const float* mu, int col) {
    const v2u c4 = *(const v2u*)(cur + col), p4 = *(const v2u*)(prv + col);
    const f32x4 c = (f32x4){bflo(c4.x), bfhi(c4.x), bflo(c4.y), bfhi(c4.y)}, p = (f32x4){bflo(p4.x), bfhi(p4.x), bflo(p4.y), bfhi(p4.y)};
    const f32x4 m = *(const f32x4*)(mu + col);
    return c + (p - c) * m;
}

constexpr int PB_ROW = BCOLS * 2, PB_PIECES = PB_ROW / 16, PB_AF_OFF = 20 * PB_ROW, PB_SCR_OFF = PB_AF_OFF + 9 * 64 * 16, PB_SCR_W = 2048;
static_assert(PB_SCR_OFF + 8 * PB_SCR_W <= BT_OFF, "prep LDS");
__device__ __forceinline__ f32x4 lxs4(const LAS unsigned char* cur, const float* mu, int col) {
    const v2u c4 = *(const LAS v2u*)(cur + 2 * col), p4 = *(const LAS v2u*)(cur - PB_ROW + 2 * col);
    const f32x4 c = (f32x4){bflo(c4.x), bfhi(c4.x), bflo(c4.y), bfhi(c4.y)}, p = (f32x4){bflo(p4.x), bfhi(p4.x), bflo(p4.y), bfhi(p4.y)};
    const f32x4 m = *(const f32x4*)(mu + col);
    return c + (p - c) * m;
}
template <int PV>
__device__ __forceinline__ void prep_block(const Args& a, Frame& F, const bf16* __restrict__ PROJ, const bf16* __restrict__ LW, const bf16* __restrict__ SHB, unsigned char* PREP, int task) {
    const int lane = F.lane, tok = lane & 15, g4 = lane >> 4, w = F.wave;
    const bool samp = task >= MP / 16;
    const int nrows = samp ? 20 : 17;
    if (!(PV & 8)) {
        v4u stg[13];
#pragma unroll
        for (int i = 0; i < 13; ++i) { const int idx = F.tid + NTHR * i;
            if (idx < nrows * PB_PIECES) {
                const int row = idx / PB_PIECES, piece = idx - row * PB_PIECES;
                const bf16* src;
                if (!samp) { const int m = task * 16 - 1 + row; src = (row == 0 && ((task * 16) & (T - 1)) == 0) ? (SHB + 32 * BCOLS) : (PROJ + (size_t)m * EC + AQKV); }
                else { const int q = row / 5, rr = row - 5 * q, seq = (task - MP / 16) * 4 + q; src = (rr == 0) ? (SHB + seq * BCOLS) : (PROJ + (size_t)(MP + seq * 4 + rr - 1) * EC + AQKV); }
                stg[i] = *(const v4u*)(src + piece * 8); }
            else stg[i] = (v4u){0u, 0u, 0u, 0u}; }
#pragma unroll
        for (int i = 0; i < 13; ++i) { const int idx = F.tid + NTHR * i;
            if (idx < nrows * PB_PIECES) { const int row = idx / PB_PIECES, piece = idx - row * PB_PIECES; *(LAS v4u*)(F.lds + row * PB_ROW + piece * 16) = stg[i]; } }
    }
    __syncthreads();
    const int crow = samp ? (5 * (tok >> 2) + 1 + (tok & 3)) : (tok + 1);
    const LAS unsigned char* cur = F.lds + crow * PB_ROW;
    const float* mu = a.in[I_EMU];
    for (int ks = w; ks < 9; ks += 8) {
        const int col = 3 * BW + 32 * ks + 8 * g4;
        const v4u c8 = *(const LAS v4u*)(cur + 2 * col), p8 = *(const LAS v4u*)(cur - PB_ROW + 2 * col);
        const f32x4 m0 = *(const f32x4*)(mu + col), m1 = *(const f32x4*)(mu + col + 4);
        const float c[8] = {bflo(c8.x), bfhi(c8.x), bflo(c8.y), bfhi(c8.y), bflo(c8.z), bfhi(c8.z), bflo(c8.w), bfhi(c8.w)};
        const float p[8] = {bflo(p8.x), bfhi(p8.x), bflo(p8.y), bfhi(p8.y), bflo(p8.z), bfhi(p8.z), bflo(p8.w), bfhi(p8.w)};
        const float mm[8] = {m0.x, m0.y, m0.z, m0.w, m1.x, m1.y, m1.z, m1.w};
        float v[8];
#pragma unroll
        for (int i = 0; i < 8; ++i) {
            v[i] = c[i] + (p[i] - c[i]) * mm[i];
            if (ks < 2) { const float e = __expf(2.0f * v[i]); v[i] = 1.0f - 2.0f * rcpf_(e + 1.0f); }
            else if (ks >= 4) v[i] = sigmoidf_(v[i]);
        }
        *(LAS v4u*)(F.lds + PB_AF_OFF + (ks * 64 + lane) * 16) = (v4u){pk2(v[0], v[1]), pk2(v[2], v[3]), pk2(v[4], v[5]), pk2(v[6], v[7])};
    }
    __syncthreads();
    bf16x8 af[9];
#pragma unroll
    for (int ks = 0; ks < 9; ++ks) af[ks] = *(const LAS bf16x8*)(F.lds + PB_AF_OFF + (ks * 64 + lane) * 16);
    size_t ebase0; int estride;
    if (!samp) { const int m0 = task * 16, t0 = m0 & (T - 1), b = m0 >> 12; ebase0 = (size_t)(b * 12) * T + t0; estride = T; }
    else { const int sb0 = (task - MP / 16) * 4; ebase0 = (size_t)48 * T + (size_t)(sb0 * 12) * 4; estride = 4; }
    LAS unsigned char* scr = F.lds + PB_SCR_OFF + w * PB_SCR_W;
    const float* k_k = a.in[I_EKK];
#pragma unroll 1
    for (int h = w; h < 12; h += 8) {
        f32x4 kr[4];
        float ssq = 0.f;
#pragma unroll
        for (int nt = 0; nt < 4; ++nt) {
            const int c4 = h * 64 + 16 * nt + 4 * g4;
            kr[nt] = lxs4(cur, mu, BW + c4);
            const f32x4 kkr = kr[nt] * *(const f32x4*)(k_k + c4);
            ssq += (kkr.x * kkr.x + kkr.y * kkr.y) + (kkr.z * kkr.z + kkr.w * kkr.w);
        }
        ssq += __shfl_xor(ssq, 16); ssq += __shfl_xor(ssq, 32);
        const float kinv = rcpf_(fmaxf(__builtin_amdgcn_sqrtf(ssq), 1e-12f));
        v2u pkv[7][4];
#pragma unroll
        for (int nt = 0; nt < 4; ++nt) {
            const bf16* lwp = LW + (size_t)(h * 64 + 16 * nt + tok) * LORA + 8 * g4;
            f32x4 aw = (f32x4){0.f, 0.f, 0.f, 0.f}, aa = aw, ag = aw;
            if (!(PV & 1)) {
#pragma unroll
            for (int ks = 0; ks < 9; ++ks) { const bf16x8 bw = *(const bf16x8*)(lwp + 32 * ks);
                if (ks < 2) aw = mfma16(bw, af[ks], aw); else if (ks < 4) aa = mfma16(bw, af[ks], aa); else ag = mfma16(bw, af[ks], ag); }
            } else { aw = __builtin_bit_cast(f32x4, af[nt]); aa = __builtin_bit_cast(f32x4, af[nt + 4]); ag = aw; }
            const int c4 = h * 64 + 16 * nt + 4 * g4, cl = 16 * nt + 4 * g4;
            const f32x4 w0 = *(const f32x4*)(a.in[I_EW0] + c4), a0 = *(const f32x4*)(a.in[I_EA0] + c4), kkc = *(const f32x4*)(k_k + c4), kac = *(const f32x4*)(a.in[I_EKA] + c4);
            f32x4 dec, av, kk, kp, bb;
#pragma unroll
            for (int i = 0; i < 4; ++i) {
                const float z = -(w0[i] + aw[i]);
                if (!(PV & 2)) {
                const float sp = fmaxf(z, 0.f) + __logf(1.0f + __expf(-fabsf(z)));
                const float ww = -sp - 0.5f;
                dec[i] = __expf(ww);
                av[i] = sigmoidf_(a0[i] + aa[i]);
                } else { dec[i] = z; av[i] = a0[i] + aa[i]; }
                kk[i] = kr[nt][i] * kkc[i] * kinv;
                kp[i] = kr[nt][i] * (1.0f + (av[i] - 1.0f) * kac[i]);
                bb[i] = kk[i] * av[i];
            }
            const f32x4 rr4 = lxs4(cur, mu, c4), vr4 = lxs4(cur, mu, 2 * BW + c4);
            const f32x4 ew = dec;
            pkv[0][nt] = (v2u){pk2(rr4.x, rr4.y), pk2(rr4.z, rr4.w)};
            pkv[1][nt] = (v2u){pk2(kp.x, kp.y), pk2(kp.z, kp.w)};
            pkv[2][nt] = (v2u){pk2(vr4.x, vr4.y), pk2(vr4.z, vr4.w)};
            pkv[3][nt] = (v2u){pk2(kk.x, kk.y), pk2(kk.z, kk.w)};
            pkv[4][nt] = (v2u){pk2(bb.x, bb.y), pk2(bb.z, bb.w)};
            pkv[5][nt] = (v2u){pk2(ag.x, ag.y), pk2(ag.z, ag.w)};
            pkv[6][nt] = (v2u){pk2(ew.x, ew.y), pk2(ew.z, ew.w)};
        }
        unsigned char* Et[4];
#pragma unroll
        for (int sI = 0; sI < 4; ++sI) { const int tt = 4 * sI + (lane >> 4);
            size_t eidx = ebase0 + (size_t)h * estride + (samp ? (size_t)((tt >> 2) * 48 + (tt & 3)) : (size_t)tt);
            if (PV) eidx &= 65535;
            Et[sI] = PREP + eidx * 1024 + 8 * (lane & 15); }
#pragma unroll
        for (int vI = 0; vI < 7; ++vI) {
#pragma unroll
            for (int nt = 0; nt < 4; ++nt) *(LAS v2u*)(scr + tok * 128 + 2 * (16 * nt + 4 * g4)) = pkv[vI][nt];
#pragma unroll
            for (int sI = 0; sI < 4; ++sI) { const v2u ov = *(const LAS v2u*)(scr + (4 * sI + (lane >> 4)) * 128 + 8 * (lane & 15)); if (!(PV & 4)) *(v2u*)(Et[sI] + 128 * vI) = ov; else asm volatile("" :: "v"(ov.x), "v"(ov.y)); }
        }
    }
    __syncthreads();
}

__device__ __forceinline__ float row16_sum(float x) {
    x += __int_as_float(__builtin_amdgcn_mov_dpp(__float_as_int(x), 0x128, 0xf, 0xf, false));
    x += __int_as_float(__builtin_amdgcn_mov_dpp(__float_as_int(x), 0x124, 0xf, 0xf, false));
    x += __int_as_float(__builtin_amdgcn_mov_dpp(__float_as_int(x), 0x122, 0xf, 0xf, false));
    x += __int_as_float(__builtin_amdgcn_mov_dpp(__float_as_int(x), 0x121, 0xf, 0xf, false));
    return x;
}
__device__ __forceinline__ void row16_sum2(float& a, float& b) {
    asm("s_nop 1\n\t"
        "v_add_f32_dpp %0, %0, %0 row_ror:8 row_mask:0xf bank_mask:0xf\n\t"
        "v_add_f32_dpp %1, %1, %1 row_ror:8 row_mask:0xf bank_mask:0xf\n\t"
        "s_nop 0\n\t"
        "v_add_f32_dpp %0, %0, %0 row_ror:4 row_mask:0xf bank_mask:0xf\n\t"
        "v_add_f32_dpp %1, %1, %1 row_ror:4 row_mask:0xf bank_mask:0xf\n\t"
        "s_nop 0\n\t"
        "v_add_f32_dpp %0, %0, %0 row_ror:2 row_mask:0xf bank_mask:0xf\n\t"
        "v_add_f32_dpp %1, %1, %1 row_ror:2 row_mask:0xf bank_mask:0xf\n\t"
        "s_nop 0\n\t"
        "v_add_f32_dpp %0, %0, %0 row_ror:1 row_mask:0xf bank_mask:0xf\n\t"
        "v_add_f32_dpp %1, %1, %1 row_ror:1 row_mask:0xf bank_mask:0xf\n\t"
        "s_nop 1"
        : "+v"(a), "+v"(b));
}
__device__ __forceinline__ float wkv_step(f32x4& S, const f32x4 d, const f32x4 kk, const f32x4 bb, const f32x4 kp, const f32x4 r, const float v) {
    float p = S.x * kk.x; p = fmaf(S.y, kk.y, p); p = fmaf(S.z, kk.z, p); p = fmaf(S.w, kk.w, p);
    const float sa = -row16_sum(p);
    S.x = fmaf(sa, bb.x, fmaf(S.x, d.x, v * kp.x));
    S.y = fmaf(sa, bb.y, fmaf(S.y, d.y, v * kp.y));
    S.z = fmaf(sa, bb.z, fmaf(S.z, d.z, v * kp.z));
    S.w = fmaf(sa, bb.w, fmaf(S.w, d.w, v * kp.w));
    float y = S.x * r.x; y = fmaf(S.y, r.y, y); y = fmaf(S.z, r.z, y); y = fmaf(S.w, r.w, y);
    return row16_sum(y);
}
__device__ __forceinline__ float wkv_step_p(f32x4& S, float& ypart, const f32x4 d, const f32x4 kk, const f32x4 bb, const f32x4 kp, const f32x4 r, const float v) {
    float s0 = S.x, s1 = S.y, s2 = S.z, s3 = S.w, y = ypart, p, t;
    asm("v_mul_f32 %5, %0, %7\n\t"
        "v_fmac_f32 %5, %1, %8\n\t"
        "v_fmac_f32 %5, %2, %9\n\t"
        "v_fmac_f32 %5, %3, %10\n\t"
        "v_mul_f32 %6, %27, %19\n\t"
        "v_add_f32_dpp %4, %4, %4 row_ror:8 row_mask:0xf bank_mask:0xf\n\t"
        "v_add_f32_dpp %5, %5, %5 row_ror:8 row_mask:0xf bank_mask:0xf\n\t"
        "v_fma_f32 %0, %0, %11, %6\n\t"
        "v_add_f32_dpp %4, %4, %4 row_ror:4 row_mask:0xf bank_mask:0xf\n\t"
        "v_add_f32_dpp %5, %5, %5 row_ror:4 row_mask:0xf bank_mask:0xf\n\t"
        "v_mul_f32 %6, %27, %20\n\t"
        "v_add_f32_dpp %4, %4, %4 row_ror:2 row_mask:0xf bank_mask:0xf\n\t"
        "v_add_f32_dpp %5, %5, %5 row_ror:2 row_mask:0xf bank_mask:0xf\n\t"
        "v_fma_f32 %1, %1, %12, %6\n\t"
        "v_add_f32_dpp %4, %4, %4 row_ror:1 row_mask:0xf bank_mask:0xf\n\t"
        "v_add_f32_dpp %5, %5, %5 row_ror:1 row_mask:0xf bank_mask:0xf\n\t"
        "v_mul_f32 %6, %27, %21\n\t"
        "v_fma_f32 %2, %2, %13, %6\n\t"
        "v_mul_f32 %6, %27, %22\n\t"
        "v_fma_f32 %3, %3, %14, %6\n\t"
        "v_fma_f32 %0, -%5, %15, %0\n\t"
        "v_fma_f32 %1, -%5, %16, %1\n\t"
        "v_fma_f32 %2, -%5, %17, %2\n\t"
        "v_fma_f32 %3, -%5, %18, %3\n\t"
        "v_mul_f32 %6, %0, %23\n\t"
        "v_fmac_f32 %6, %1, %24\n\t"
        "v_fmac_f32 %6, %2, %25\n\t"
        "v_fmac_f32 %6, %3, %26"
        : "+v"(s0), "+v"(s1), "+v"(s2), "+v"(s3), "+v"(y), "=&v"(p), "=&v"(t)
        : "v"(kk.x), "v"(kk.y), "v"(kk.z), "v"(kk.w), "v"(d.x), "v"(d.y), "v"(d.z), "v"(d.w), "v"(bb.x), "v"(bb.y), "v"(bb.z), "v"(bb.w),
          "v"(kp.x), "v"(kp.y), "v"(kp.z), "v"(kp.w), "v"(r.x), "v"(r.y), "v"(r.z), "v"(r.w), "v"(v));
    S.x = s0; S.y = s1; S.z = s2; S.w = s3;
    ypart = t;
    return y;
}
__device__ __forceinline__ f32x4 ld_bf4(const unsigned char* p) { const v2u w = *(const v2u*)p; return (f32x4){bflo(w.x), bfhi(w.x), bflo(w.y), bfhi(w.y)}; }

constexpr int WK_TCH = 32, WK_STEP_F = 336, WK_BUF_F = WK_TCH * WK_STEP_F;
constexpr int WK_NG = WK_TCH * 84;
__device__ __forceinline__ void wkv_fetch(v2u (&raw)[11], const unsigned char* Eb, int c, int li, int rowq) {
    const unsigned char* Ec = Eb + (size_t)c * WK_TCH * 1024;
#pragma unroll
    for (int i = 0; i < 11; ++i) { const int gi = li + 256 * i;
        if (gi < WK_NG) { const int st = gi / 84, gg = gi % 84; int off;
            if (gg < 16) off = 768 + 8 * gg; else if (gg < 32) off = 384 + 8 * (gg - 16); else if (gg < 48) off = 512 + 8 * (gg - 32);
            else if (gg < 64) off = 128 + 8 * (gg - 48); else if (gg < 80) off = 8 * (gg - 64); else off = 256 + 2 * (16 * rowq + 4 * (gg - 80));
            raw[i] = *(const v2u*)(Ec + (size_t)st * 1024 + off); }
        else raw[i] = (v2u){0u, 0u}; }
}
__device__ __forceinline__ void wkv_put(const v2u (&raw)[11], LAS float* L, int c, int li) {
    LAS float* buf = L + (c & 1) * WK_BUF_F;
#pragma unroll
    for (int i = 0; i < 11; ++i) { const int gi = li + 256 * i;
        if (gi < WK_NG) { const int st = gi / 84, gg = gi % 84; LAS float* sp = buf + st * WK_STEP_F;
            f32x4 v = (f32x4){bflo(raw[i].x), bfhi(raw[i].x), bflo(raw[i].y), bfhi(raw[i].y)};
            if (gg < 16) { v.x = __expf(-v.x); v.y = __expf(-v.y); v.z = __expf(-v.z); v.w = __expf(-v.w); }
            *(LAS f32x4*)(sp + 4 * gg) = v; } }
}
__device__ __forceinline__ void wkv_phase(const Args& a, Frame& F, unsigned char* PREP, bf16* PROJ) {
    if (F.bid < 192) {
        const int chain = F.bid >> 2, rowq = F.bid & 3, b = chain / 12, h = chain % 12;
        LAS float* L = (LAS float*)F.lds;
        const unsigned char* Eb = PREP + (size_t)chain * T * 1024;
        const bool loader = F.wave >= 4; const int li = F.tid - 256;
        f32x4 S = (f32x4){0.f, 0.f, 0.f, 0.f};
        const int k4 = F.lane & 15, rloc = 4 * (F.wave & 3) + (F.lane >> 4);
        constexpr int NCH = T / WK_TCH;
        float ypart = 0.f, yreg = 0.f;
        float* ybase = (float*)(PROJ + ((size_t)b * T + k4) * EC) + 1152 + h * 64 + 16 * rowq + rloc;
        v2u raw[11];
        if (loader) { wkv_fetch(raw, Eb, 0, li, rowq); wkv_put(raw, L, 0, li); wkv_fetch(raw, Eb, 1, li, rowq); }
        __syncthreads();
        for (int c = 0; c < NCH; ++c) {
            if (loader) { if (c + 1 < NCH) wkv_put(raw, L, c + 1, li); if (c + 2 < NCH) wkv_fetch(raw, Eb, c + 2, li, rowq); }
            else {
                const LAS float* buf = L + (c & 1) * WK_BUF_F;
                f32x4 od[2], okk[2], obb[2], okp[2], orr[2]; float ov[2];
                od[0] = *(const LAS f32x4*)(buf + 4 * k4); okk[0] = *(const LAS f32x4*)(buf + 64 + 4 * k4); obb[0] = *(const LAS f32x4*)(buf + 128 + 4 * k4);
                okp[0] = *(const LAS f32x4*)(buf + 192 + 4 * k4); orr[0] = *(const LAS f32x4*)(buf + 256 + 4 * k4); ov[0] = buf[320 + rloc];
#pragma unroll
                for (int s = 0; s < WK_TCH; ++s) {
                    if (s + 1 < WK_TCH) { const LAS float* sp = buf + (s + 1) * WK_STEP_F; const int nb = (s + 1) & 1;
                        od[nb] = *(const LAS f32x4*)(sp + 4 * k4); okk[nb] = *(const LAS f32x4*)(sp + 64 + 4 * k4); obb[nb] = *(const LAS f32x4*)(sp + 128 + 4 * k4);
                        okp[nb] = *(const LAS f32x4*)(sp + 192 + 4 * k4); orr[nb] = *(const LAS f32x4*)(sp + 256 + 4 * k4); ov[nb] = sp[320 + rloc]; }
                    const int cb = s & 1;
                    const float yprev = wkv_step_p(S, ypart, od[cb], okk[cb], obb[cb], okp[cb], orr[cb], ov[cb]);
                    yreg = (k4 == ((s + 15) & 15)) ? yprev : yreg;
                    if ((s & 15) == 0 && (c > 0 || s > 0)) ybase[(size_t)(32 * c + s - 16) * (EC / 2)] = yreg;
                }
            }
            __syncthreads();
        }
        if (!loader) {
            float dummy = 0.f; row16_sum2(ypart, dummy);
            yreg = (k4 == 15) ? ypart : yreg;
            ybase[(size_t)(T - 16) * (EC / 2)] = yreg;
            *(f32x4*)(a.out + O_PWKV + ((size_t)chain * 64 + 16 * rowq + rloc) * 64 + 4 * k4) = S;
        }
    } else {
        const int w = (F.bid - 192) * NWAVES + F.wave; const int k4 = F.lane & 15;
        for (int st = w; st < 384 * 16; st += 64 * NWAVES) {
            const int sc = st >> 4, rg = st & 15, row = 4 * rg + (F.lane >> 4), bs = sc / 12, h = sc % 12;
            f32x4 S = *(const f32x4*)(a.in[I_SWKV] + ((size_t)sc * 64 + row) * 64 + 4 * k4);
#pragma unroll
            for (int t = 0; t < 4; ++t) {
                const unsigned char* E = PREP + ((size_t)48 * T + (size_t)sc * 4 + t) * 1024;
                f32x4 d = ld_bf4(E + 768 + 8 * k4); d.x = __expf(-d.x); d.y = __expf(-d.y); d.z = __expf(-d.z); d.w = __expf(-d.w);
                const f32x4 kk = ld_bf4(E + 384 + 8 * k4), bb = ld_bf4(E + 512 + 8 * k4), kp = ld_bf4(E + 128 + 8 * k4), r = ld_bf4(E + 8 * k4);
                const float v = bf2f(*(const bf16*)(E + 256 + 2 * row));
                const float y = wkv_step(S, d, kk, bb, kp, r, v);
                if (k4 == 0) ((float*)(PROJ + ((size_t)MP + bs * 4 + t) * EC))[1152 + h * 64 + row] = y;
            }
            *(f32x4*)(a.out + O_SWKV + ((size_t)sc * 64 + row) * 64 + 4 * k4) = S;
        }
        p0_convert_items(a, (LAS float*)(F.lds + F.wave * 16384), F.lane, P0_I_IN, P0_NITEMS, w, 64 * NWAVES);
    }
}

constexpr int REC_BYTES = 8960, REC_AB = 0, REC_BT = 2048, REC_RB = 4096, REC_PST = 6144, REC_HT = 8192, REC_PC = 8704;
constexpr size_t REC_CHAIN = (size_t)256 * REC_BYTES;
constexpr size_t WS_REQUIRED = WS_END;
static_assert(14 * REC_CHAIN <= (size_t)MPAD * D * 2 && 20 * REC_CHAIN <= (size_t)M * D * 4, "record placement");
__device__ __forceinline__ unsigned char* rec_ptr(unsigned char* ws, float* out, int chain, int ck) {
    const size_t o = (size_t)ck * REC_BYTES;
    if (chain < 14) return ws + WS_BUF0 + (size_t)chain * REC_CHAIN + o;
    if (chain < 28) return ws + WS_BUF1 + (size_t)(chain - 14) * REC_CHAIN + o;
    return (unsigned char*)out + (size_t)(chain - 28) * REC_CHAIN + o;
}
constexpr size_t WS_YS = WS_SQ;
static_assert((size_t)MS * BW * 4 <= (size_t)MS * 3 * 1024 * 4, "YS region");
constexpr int CP_RT = 0, CP_X = 2304, CP_MAB = CP_X + 9216, CP_TT = CP_MAB + 1024, CP_PC = CP_TT + 1024, CP_BYTES = CP_PC + 256;
static_assert(8 * CP_BYTES <= RING_BYTES, "chunk precompute LDS");
__device__ __forceinline__ bf16x8 frag_lo(float x, float y, float z, float w) { return __builtin_bit_cast(bf16x8, (v4u){pk2(x, y), pk2(z, w), 0u, 0u}); }
__device__ __forceinline__ bf16x8 frag_lo4(f32x4 v) { return frag_lo(v.x, v.y, v.z, v.w); }
__device__ __forceinline__ int kpos(int k) { return (k & ~31) | (((k >> 2) & 3) << 3) | (((k >> 4) & 1) << 2) | (k & 3); }

__device__ __forceinline__ void wkv_chunk_core(unsigned char* __restrict__ REC, LAS unsigned char* scr, LAS unsigned char* scm, int lane, const float eLC) {
    const int tl = lane & 15, g4 = lane >> 4, c = lane;
    f32x4 Mab = (f32x4){0.f, 0.f, 0.f, 0.f}, MakT = Mab, Nrb = Mab, Nrk = Mab;
#pragma unroll
    for (int ks = 0; ks < 2; ++ks) {
        const int fo = tl * 144 + 64 * ks + 16 * g4;
        const bf16x8 fA = *(const LAS bf16x8*)(scr + CP_X + 0 * 2304 + fo), fB = *(const LAS bf16x8*)(scr + CP_X + 1 * 2304 + fo), fK = *(const LAS bf16x8*)(scr + CP_X + 2 * 2304 + fo), fR = *(const LAS bf16x8*)(scr + CP_RT + fo);
        Mab = mfma16(fB, fA, Mab);
        MakT = mfma16(fA, fK, MakT);
        Nrb = mfma16(fB, fR, Nrb);
        Nrk = mfma16(fK, fR, Nrk);
    }
#pragma unroll
    for (int i = 0; i < 4; ++i) { const int row = 4 * g4 + i;
        if (!(row < tl)) Mab[i] = 0.f;
        if (!(tl < row)) MakT[i] = 0.f;
        if (!(row <= tl)) { Nrb[i] = 0.f; Nrk[i] = 0.f; } }
    *(LAS f32x4*)(scm + 0 + (tl * 16 + 4 * g4) * 4) = Mab;
    float Trow[16];
#pragma unroll
    for (int t = 0; t < 16; ++t) {
        float acc = (t == tl) ? 1.0f : 0.0f;
        if (t > 0) {
            const LAS float* col = (const LAS float*)(scm + 0 + t * 64);
#pragma unroll
            for (int tp = 0; tp < t; ++tp) acc = fmaf(Trow[tp], col[tp], acc);
        }
        Trow[t] = acc;
    }
#pragma unroll
    for (int t = 0; t < 16; ++t) *(LAS float*)(scm + 1024 + (t * 16 + tl) * 4) = Trow[t];
    const bf16x8 Tf = frag_lo4(*(const LAS f32x4*)(scm + 1024 + (tl * 16 + 4 * g4) * 4));
    {
        unsigned short ra_[16], rb_[16], rk_[16];
#pragma unroll
        for (int t = 0; t < 16; ++t) { ra_[t] = *(const LAS unsigned short*)(scr + CP_X + 0 * 2304 + t * 144 + 2 * c); rb_[t] = *(const LAS unsigned short*)(scr + CP_X + 1 * 2304 + t * 144 + 2 * c);
            rk_[t] = *(const LAS unsigned short*)(scr + CP_X + 2 * 2304 + t * 144 + 2 * c); }
        unsigned wa[8], wb[8], wk[8];
#pragma unroll
        for (int i = 0; i < 8; ++i) { wa[i] = (unsigned)ra_[2 * i] | ((unsigned)ra_[2 * i + 1] << 16);
            wb[i] = pk2(bf2f(rb_[2 * i]) * eLC, bf2f(rb_[2 * i + 1]) * eLC); wk[i] = pk2(bf2f(rk_[2 * i]) * eLC, bf2f(rk_[2 * i + 1]) * eLC); }
        asm volatile("" ::: "memory");
        LAS unsigned char* ra = scr + CP_X + c * 48;
        *(LAS v4u*)(ra) = (v4u){wa[0], wa[1], wa[2], wa[3]}; *(LAS v4u*)(ra + 16) = (v4u){wa[4], wa[5], wa[6], wa[7]};
        *(LAS v4u*)(ra + 3072) = (v4u){wb[0], wb[1], wb[2], wb[3]}; *(LAS v4u*)(ra + 3072 + 16) = (v4u){wb[4], wb[5], wb[6], wb[7]};
        *(LAS v4u*)(ra + 6144) = (v4u){wk[0], wk[1], wk[2], wk[3]}; *(LAS v4u*)(ra + 6144 + 16) = (v4u){wk[4], wk[5], wk[6], wk[7]};
        *(LAS float*)(scm + 2048 + 4 * c) = eLC;
    }
    f32x4 Abar[4];
#pragma unroll
    for (int nt = 0; nt < 4; ++nt) { const v2u w = *(const LAS v2u*)(scr + CP_X + (16 * nt + tl) * 48 + 8 * g4);
        Abar[nt] = mfma16(Tf, __builtin_bit_cast(bf16x8, (v4u){w.x, w.y, 0u, 0u}), (f32x4){0.f, 0.f, 0.f, 0.f}); }
    const bf16x8 fMakT = frag_lo4(MakT), fNrb = frag_lo4(Nrb);
    const f32x4 GT = mfma16(Tf, fMakT, (f32x4){0.f, 0.f, 0.f, 0.f});
    const bf16x8 fGT = frag_lo4(GT);
    unsigned char* R = REC;
    LAS unsigned char* SB = scm + 2304;
    bf16x8 fAb[4];
#pragma unroll
    for (int kt = 0; kt < 4; ++kt) fAb[kt] = frag_lo4(Abar[kt]);
    {
        const f32x4 Hm = mfma16(fGT, fNrb, Nrk);
        v2u rbw[4];
#pragma unroll
        for (int kt = 0; kt < 4; ++kt) {
            f32x4 rb = mfma16(fAb[kt], fNrb, (f32x4){0.f, 0.f, 0.f, 0.f});
            const v2u rw = *(const LAS v2u*)(scr + CP_RT + tl * 144 + 2 * (16 * kt + 4 * g4));
            rb.x += bflo(rw.x); rb.y += bfhi(rw.x); rb.z += bflo(rw.y); rb.w += bfhi(rw.y);
            rbw[kt] = (v2u){pk2(rb.x, rb.y), pk2(rb.z, rb.w)};
        }
        asm volatile("" ::: "memory");
#pragma unroll
        for (int kt = 0; kt < 4; ++kt) *(LAS v2u*)(SB + tl * 128 + 2 * kpos(16 * kt + 4 * g4)) = rbw[kt];
        *(LAS v2u*)(SB + 2048 + tl * 32 + 8 * g4) = (v2u){pk2(Hm.x, Hm.y), pk2(Hm.z, Hm.w)};
        *(v4u*)(R + REC_RB + lane * 16) = *(const LAS v4u*)(SB + lane * 16);
        *(v4u*)(R + REC_RB + 1024 + lane * 16) = *(const LAS v4u*)(SB + 1024 + lane * 16);
        if (lane < 32) *(v4u*)(R + REC_HT + lane * 16) = *(const LAS v4u*)(SB + 2048 + lane * 16);
    }
#pragma unroll
    for (int nt = 0; nt < 4; ++nt) {
        const int pk_ = 2 * kpos(16 * nt + tl);
        const unsigned w01 = pk2(Abar[nt].x, Abar[nt].y), w23 = pk2(Abar[nt].z, Abar[nt].w);
        *(LAS unsigned short*)(SB + (4 * g4 + 0) * 128 + pk_) = (unsigned short)(w01 & 0xffffu); *(LAS unsigned short*)(SB + (4 * g4 + 1) * 128 + pk_) = (unsigned short)(w01 >> 16);
        *(LAS unsigned short*)(SB + (4 * g4 + 2) * 128 + pk_) = (unsigned short)(w23 & 0xffffu); *(LAS unsigned short*)(SB + (4 * g4 + 3) * 128 + pk_) = (unsigned short)(w23 >> 16);
    }
    *(v4u*)(R + REC_AB + lane * 16) = *(const LAS v4u*)(SB + lane * 16);
    *(v4u*)(R + REC_AB + 1024 + lane * 16) = *(const LAS v4u*)(SB + 1024 + lane * 16);
#pragma unroll
    for (int i = 0; i < 2; ++i) { const int p = lane + 64 * i;
        *(v4u*)(R + REC_BT + p * 16) = *(const LAS v4u*)(scr + CP_X + 3072 + (p >> 1) * 48 + (p & 1) * 16); }
    if (lane < 16) *(v4u*)(R + REC_PC + lane * 16) = *(const LAS v4u*)(scm + 2048 + lane * 16);
#pragma unroll
    for (int nt = 0; nt < 4; ++nt) {
        const v2u bw = *(const LAS v2u*)(scr + CP_X + 3072 + (16 * nt + tl) * 48 + 8 * g4);
        const bf16x8 fBc = __builtin_bit_cast(bf16x8, (v4u){bw.x, bw.y, 0u, 0u});
        f32x4 ps = mfma16(fGT, fBc, (f32x4){0.f, 0.f, 0.f, 0.f});
        const v2u kw = *(const LAS v2u*)(scr + CP_X + 6144 + (16 * nt + tl) * 48 + 8 * g4);
        ps.x += bflo(kw.x); ps.y += bfhi(kw.x); ps.z += bflo(kw.y); ps.w += bfhi(kw.y);
        *(LAS v2u*)(SB + 2048 + nt * 512 + tl * 32 + 8 * g4) = (v2u){pk2(ps.x, ps.y), pk2(ps.z, ps.w)};
    }
    *(v4u*)(R + REC_PST + lane * 16) = *(const LAS v4u*)(SB + 2048 + lane * 16);
    *(v4u*)(R + REC_PST + 1024 + lane * 16) = *(const LAS v4u*)(SB + 2048 + 1024 + lane * 16);
}

constexpr int FZ_L = 0, FZ_LROW = 576, FZ_R = 17 * 576, FZ_RROW = 384, FZ_BYTES = 17 * 960;
constexpr int FZ_TILES = 4096, FZ_SMALL = 0;
static_assert(8 * FZ_BYTES <= RING_BYTES && FZ_TILES + 2304 + 9216 <= FZ_BYTES && FZ_R + 3 * 2048 <= FZ_BYTES, "fused prep LDS");
constexpr size_t WS_AFG = WS_WUP1;
static_assert((size_t)(MP / 16) * 9 * 1024 <= 2 * (size_t)FF * D * 2, "A-fragment cache");
__device__ __forceinline__ void wkv_afrag_task(const Args& a, const bf16* __restrict__ PROJ, const bf16* __restrict__ SHB, v4u* __restrict__ AFG, int grp, int ks, int lane) {
    const int tok = lane & 15, g4 = lane >> 4, ck = grp & 255;
    const size_t m = (size_t)grp * 16 + tok;
    const bf16* cur = PROJ + m * EC + AQKV;
    const bf16* prv = (tok == 0 && ck == 0) ? (SHB + 32 * BCOLS) : (cur - EC);
    const float* mu = a.in[I_EMU];
    const int col = 3 * BW + 32 * ks + 8 * g4;
    const v4u c8 = *(const v4u*)(cur + col), p8 = *(const v4u*)(prv + col);
    const f32x4 m0v = *(const f32x4*)(mu + col), m1v = *(const f32x4*)(mu + col + 4);
    const float cc[8] = {bflo(c8.x), bfhi(c8.x), bflo(c8.y), bfhi(c8.y), bflo(c8.z), bfhi(c8.z), bflo(c8.w), bfhi(c8.w)};
    const float pp[8] = {bflo(p8.x), bfhi(p8.x), bflo(p8.y), bfhi(p8.y), bflo(p8.z), bfhi(p8.z), bflo(p8.w), bfhi(p8.w)};
    const float mm[8] = {m0v.x, m0v.y, m0v.z, m0v.w, m1v.x, m1v.y, m1v.z, m1v.w};
    float v[8];
#pragma unroll
    for (int i = 0; i < 8; ++i) {
        v[i] = cc[i] + (pp[i] - cc[i]) * mm[i];
        const float e = __expf(ks < 2 ? 2.0f * v[i] : -v[i]);
        const float rc = rcpf_(e + 1.0f);
        v[i] = ks < 2 ? (1.0f - 2.0f * rc) : (ks >= 4 ? rc : v[i]);
    }
    AFG[((size_t)grp * 9 + ks) * 64 + lane] = (v4u){pk2(v[0], v[1]), pk2(v[2], v[3]), pk2(v[4], v[5]), pk2(v[6], v[7])};
}
__device__ __forceinline__ void wkv_prep_issue(v4u (&stg)[7], const bf16* __restrict__ PROJ, const bf16* __restrict__ SHB, int chain, int ck, int lane) {
    const int b = chain / 12, h = chain % 12; const size_t m0 = (size_t)b * T + (size_t)ck * 16;
#pragma unroll
    for (int i = 0; i < 7; ++i) { int p = lane + 64 * i; p = p < 408 ? p : 407;
        const int row = p / 24, q = p - row * 24;
        const int col = (q >> 3) * BW + h * 64 + 8 * (q & 7);
        const bf16* src = (row == 0 && ck == 0) ? (SHB + 32 * BCOLS) : (PROJ + (m0 - 1 + row) * EC + AQKV);
        stg[i] = *(const v4u*)(src + col); }
}
template <int NOCORE>
__device__ __forceinline__ void wkv_prep_chunk(const Args& a, v4u (&stg)[7], const v4u* __restrict__ AFG, const bf16* __restrict__ PROJ, const bf16* __restrict__ LW, const bf16* __restrict__ SHB, unsigned char* PREP, unsigned char* REC,
                                               LAS unsigned char* area, int chain, int ck, int nchain, int nck, int lane_in) {
    int lane = lane_in; asm volatile("" : "+v"(lane)); __builtin_assume(lane >= 0 && lane < 64);
    const int tok = lane & 15, g4 = lane >> 4, b = chain / 12, h = chain % 12;
    const size_t m0 = (size_t)b * T + (size_t)ck * 16;
#pragma unroll
    for (int i = 0; i < 7; ++i) { int p = lane + 64 * i; p = p < 408 ? p : 407; const int row = p / 24, q = p - row * 24;
        *(LAS v4u*)(area + FZ_R + row * FZ_RROW + q * 16) = stg[i]; }
    asm volatile("" ::: "memory");
    wkv_prep_issue(stg, PROJ, SHB, nchain, nck, lane);
    const float* mu = a.in[I_EMU];
    bf16x8 af[9];
#pragma unroll
    for (int ks = 0; ks < 9; ++ks) af[ks] = __builtin_bit_cast(bf16x8, AFG[((size_t)(b * 256 + ck) * 9 + ks) * 64 + lane]);
    const LAS unsigned char* curR = area + FZ_R + (tok + 1) * FZ_RROW;
#define FZ_XS4(which, cl_) ({ const v2u c4_ = *(const LAS v2u*)(curR + 128 * (which) + 2 * (cl_)), p4_ = *(const LAS v2u*)(curR - FZ_RROW + 128 * (which) + 2 * (cl_)); \
        const f32x4 cv_ = (f32x4){bflo(c4_.x), bfhi(c4_.x), bflo(c4_.y), bfhi(c4_.y)}, pv_ = (f32x4){bflo(p4_.x), bfhi(p4_.x), bflo(p4_.y), bfhi(p4_.y)}; \
        cv_ + (pv_ - cv_) * *(const f32x4*)(mu + (which) * BW + h * 64 + (cl_)); })
    const float* k_k = a.in[I_EKK];
    f32x4 kr[4];
    float ssq = 0.f;
#pragma unroll
    for (int nt = 0; nt < 4; ++nt) {
        const int cl = 16 * nt + 4 * g4;
        kr[nt] = FZ_XS4(1, cl);
        const f32x4 kkr = kr[nt] * *(const f32x4*)(k_k + h * 64 + cl);
        ssq += (kkr.x * kkr.x + kkr.y * kkr.y) + (kkr.z * kkr.z + kkr.w * kkr.w);
    }
    ssq += __shfl_xor(ssq, 16); ssq += __shfl_xor(ssq, 32);
    const float kinv = rcpf_(fmaxf(__builtin_amdgcn_sqrtf(ssq), 1e-12f));
    v2u pk_kk[4], pk_b[4], pk_ew[4];
    LAS unsigned char* tbw = area + tok * 128 + 8 * g4;
#pragma unroll
    for (int nt = 0; nt < 4; ++nt) {
        const bf16* lwp = LW + (size_t)(h * 64 + 16 * nt + tok) * LORA + 8 * g4;
        f32x4 aw = (f32x4){0.f, 0.f, 0.f, 0.f}, aa = aw, ag = aw;
        if (!(NOCORE & 2)) {
#pragma unroll
        for (int ks = 0; ks < 9; ++ks) { const bf16x8 bw = *(const bf16x8*)(lwp + 32 * ks);
            if (ks < 2) aw = mfma16(bw, af[ks], aw); else if (ks < 4) aa = mfma16(bw, af[ks], aa); else ag = mfma16(bw, af[ks], ag); }
        } else { aw = __builtin_bit_cast(f32x4, af[nt]); aa = __builtin_bit_cast(f32x4, af[nt + 4]); ag = aw; }
        const int cl = 16 * nt + 4 * g4, c4 = h * 64 + cl;
        const f32x4 w0 = *(const f32x4*)(a.in[I_EW0] + c4), a0 = *(const f32x4*)(a.in[I_EA0] + c4), kkc = *(const f32x4*)(k_k + c4), kac = *(const f32x4*)(a.in[I_EKA] + c4);
        f32x4 ew, av, kk, kp, bb;
#pragma unroll
        for (int i = 0; i < 4; ++i) {
            const float z = -(w0[i] + aw[i]);
            if (!(NOCORE & 4)) {
            const float sp = fmaxf(z, 0.f) + __logf(1.0f + __expf(-fabsf(z)));
            ew[i] = __expf(-sp - 0.5f);
            av[i] = sigmoidf_(a0[i] + aa[i]);
            } else { ew[i] = z; av[i] = a0[i] + aa[i]; }
            kk[i] = kr[nt][i] * kkc[i] * kinv;
            kp[i] = kr[nt][i] * (1.0f + (av[i] - 1.0f) * kac[i]);
            bb[i] = kk[i] * av[i];
        }
        const f32x4 rr4 = FZ_XS4(0, cl), vr4 = FZ_XS4(2, cl);
        *(LAS v2u*)(tbw + 0 * 2048 + 32 * nt) = (v2u){pk2(rr4.x, rr4.y), pk2(rr4.z, rr4.w)};
        *(LAS v2u*)(tbw + 1 * 2048 + 32 * nt) = (v2u){pk2(kp.x, kp.y), pk2(kp.z, kp.w)};
        *(LAS v2u*)(tbw + 2 * 2048 + 32 * nt) = (v2u){pk2(vr4.x, vr4.y), pk2(vr4.z, vr4.w)};
        *(LAS v2u*)(tbw + 3 * 2048 + 32 * nt) = (v2u){pk2(ag.x, ag.y), pk2(ag.z, ag.w)};
        pk_kk[nt] = (v2u){pk2(kk.x, kk.y), pk2(kk.z, kk.w)};
        pk_b[nt] = (v2u){pk2(bb.x, bb.y), pk2(bb.z, bb.w)};
        pk_ew[nt] = (v2u){pk2(ew.x, ew.y), pk2(ew.z, ew.w)};
        asm volatile("" ::: "memory");
    }
#undef FZ_XS4
    {
        LAS unsigned char* tbr = area + FZ_R + tok * 128 + 8 * g4;
#pragma unroll
        for (int nt = 0; nt < 4; ++nt) { *(LAS v2u*)(tbr + 0 * 2048 + 32 * nt) = pk_kk[nt]; *(LAS v2u*)(tbr + 1 * 2048 + 32 * nt) = pk_b[nt]; *(LAS v2u*)(tbr + 2 * 2048 + 32 * nt) = pk_ew[nt]; }
    }
#pragma unroll
    for (int sI = 0; sI < 4; ++sI) { const int tt = 4 * sI + (lane >> 4);
        unsigned char* Et = PREP + ((size_t)chain * T + (size_t)ck * 16 + tt) * 1024 + 8 * (lane & 15);
        const LAS unsigned char* tbs = area + tt * 128 + 8 * (lane & 15);
        if (!(NOCORE & 16)) { *(v2u*)(Et + 0) = *(const LAS v2u*)(tbs + 0 * 2048); *(v2u*)(Et + 128) = *(const LAS v2u*)(tbs + 1 * 2048);
        *(v2u*)(Et + 256) = *(const LAS v2u*)(tbs + 2 * 2048); *(v2u*)(Et + 640) = *(const LAS v2u*)(tbs + 3 * 2048); } }
    const int c = lane;
    float eLCv = 1.f;
    if (!(NOCORE & 8)) {
        unsigned short s_r[16], s_kp[16], s_kk[16], s_b[16], s_ew[16];
        const LAS unsigned short* t_r = (const LAS unsigned short*)(area + 0 * 2048) + c; const LAS unsigned short* t_kp = (const LAS unsigned short*)(area + 1 * 2048) + c;
        const LAS unsigned short* t_kk = (const LAS unsigned short*)(area + FZ_R + 0 * 2048) + c; const LAS unsigned short* t_b = (const LAS unsigned short*)(area + FZ_R + 1 * 2048) + c;
        const LAS unsigned short* t_ew = (const LAS unsigned short*)(area + FZ_R + 2 * 2048) + c;
#pragma unroll
        for (int t = 0; t < 16; ++t) { s_r[t] = t_r[t * 64]; s_kp[t] = t_kp[t * 64]; s_kk[t] = t_kk[t * 64]; s_b[t] = t_b[t * 64]; s_ew[t] = t_ew[t * 64]; }
        asm volatile("" ::: "memory");
        LAS unsigned char* scr0 = area + FZ_TILES;
        float L = 0.f;
#pragma unroll
        for (int t = 0; t < 16; ++t) {
            const float eprev = __expf(L);
            L -= bf2f(s_ew[t]);
            const float e = __expf(L), einv = rcpf_(e);
            *(LAS unsigned short*)(scr0 + CP_X + 0 * 2304 + t * 144 + 2 * c) = (unsigned short)f2bf(-bf2f(s_kk[t]) * eprev);
            *(LAS unsigned short*)(scr0 + CP_X + 1 * 2304 + t * 144 + 2 * c) = (unsigned short)f2bf(bf2f(s_b[t]) * einv);
            *(LAS unsigned short*)(scr0 + CP_X + 2 * 2304 + t * 144 + 2 * c) = (unsigned short)f2bf(bf2f(s_kp[t]) * einv);
            *(LAS unsigned short*)(scr0 + CP_RT + t * 144 + 2 * c) = (unsigned short)f2bf(bf2f(s_r[t]) * e);
        }
        eLCv = __expf(L);
    }
    LAS unsigned char* scr = area + FZ_TILES;
    if (!(NOCORE & 1)) wkv_chunk_core(REC, scr, area + FZ_SMALL, lane, eLCv); else if (eLCv == 12345.678f) *(float*)REC = eLCv;
}

constexpr int SQ_D = 8, SQ_SLOT = 12288, SQ_YST = SQ_D * SQ_SLOT;
static_assert(SQ_YST + 4 * 4096 <= RING_BYTES, "sequential pass LDS");
__device__ __forceinline__ void wkv_seq_issue(LAS unsigned char* slot, const unsigned char* R, const unsigned char* E0, int lw, int lane) {
#pragma unroll
    for (int i = 0; i < 3; ++i) {
        int q = lw * 3 + i; q = q > 10 ? 9 : q;
        const unsigned char* src;
        if (q < 2 || q == 4 || q == 5) { const int row = 8 * (q & 1) + (lane >> 3), pc = (lane & 7) ^ (row & 7); src = R + (q < 2 ? REC_AB : REC_RB) + row * 128 + pc * 16; }
        else if (q < 4) src = R + REC_BT + (q - 2) * 1024 + lane * 16;
        else if (q < 8) src = R + REC_PST + (q - 6) * 1024 + lane * 16;
        else if (q == 8) src = R + REC_HT + (lane < 48 ? lane : 47) * 16;
        else src = E0 + (size_t)(8 * (q - 9) + (lane >> 3)) * 1024 + 256 + (lane & 7) * 16;
        __builtin_amdgcn_global_load_lds((const unsigned*)src, (LAS unsigned*)(slot + q * 1024), 16, 0, 0);
    }
}
typedef short bf16x4 __attribute__((ext_vector_type(4)));
__device__ __forceinline__ f32x4 mfma16k(v2u a, v2u b, f32x4 c) { return __builtin_amdgcn_mfma_f32_16x16x16bf16_1k(__builtin_bit_cast(bf16x4, a), __builtin_bit_cast(bf16x4, b), c, 0, 0, 0); }
__device__ __forceinline__ void wkv_seq_chunk(f32x4 (&S)[4], const LAS unsigned char* buf, LAS unsigned char* ystage, int w, int tl, int g4) {
    bf16x8 sf[2];
#pragma unroll
    for (int ks = 0; ks < 2; ++ks) sf[ks] = __builtin_bit_cast(bf16x8, (v4u){pk2(S[2 * ks].x, S[2 * ks].y), pk2(S[2 * ks].z, S[2 * ks].w), pk2(S[2 * ks + 1].x, S[2 * ks + 1].y), pk2(S[2 * ks + 1].z, S[2 * ks + 1].w)});
    const LAS unsigned short* vp = (const LAS unsigned short*)(buf + 9 * 1024) + (4 * g4) * 64 + 16 * w + tl;
    const v2u vf = (v2u){(unsigned)vp[0] | ((unsigned)vp[64] << 16), (unsigned)vp[128] | ((unsigned)vp[192] << 16)};
    const int swz = (tl >> 3) * 1024 + (tl & 7) * 128;
    f32x4 y = (f32x4){0.f, 0.f, 0.f, 0.f}, z = y;
#pragma unroll
    for (int ks = 0; ks < 2; ++ks) {
        const int po = ((4 * ks + g4) ^ (tl & 7)) << 4;
        y = mfma16(*(const LAS bf16x8*)(buf + 4096 + swz + po), sf[ks], y);
        z = mfma16(*(const LAS bf16x8*)(buf + swz + po), sf[ks], z);
    }
    { const v2u hw = *(const LAS v2u*)(buf + 8192 + tl * 32 + 8 * g4); y = mfma16k(hw, vf, y); }
#pragma unroll
    for (int i = 0; i < 4; ++i) *(LAS float*)(ystage + (4 * g4 + i) * 256 + 4 * (16 * w + tl)) = y[i];
    const v2u zf = (v2u){pk2(z.x, z.y), pk2(z.z, z.w)};
#pragma unroll
    for (int kt = 0; kt < 4; ++kt) {
        const int row = 16 * kt + tl;
        const f32x4 pc4 = *(const LAS f32x4*)(buf + 8192 + 512 + 4 * (16 * kt + 4 * g4));
        const v2u bw = *(const LAS v2u*)(buf + 2048 + row * 32 + 8 * g4);
        const v2u pw = *(const LAS v2u*)(buf + 6144 + row * 32 + 8 * g4);
        f32x4 sn = S[kt] * pc4;
        sn = mfma16k(bw, zf, sn);
        S[kt] = mfma16k(pw, vf, sn);
    }
}
template <int ONLYCHAINS>
__device__ __forceinline__ void wkv_phase2(const Args& a, Frame& F, unsigned char* PREP, float* YS) {
    if (F.bid < 48) {
        const int chain = F.bid;
        unsigned char* Eb = PREP + (size_t)chain * T * 1024;
        unsigned* prog = (unsigned*)(a.ws + WS_CTL) + CW_PROG + 16 * chain;
        if (F.wave >= 4) {
            const int lw = F.wave - 4;
#pragma unroll
            for (int j = 0; j < 6; ++j) if (!(ONLYCHAINS & 2)) wkv_seq_issue(F.lds + j * SQ_SLOT, rec_ptr(a.ws, a.out, chain, j), Eb + (size_t)j * 16 * 1024, lw, F.lane);
            asm volatile("s_waitcnt vmcnt(12)" ::: "memory");
            __builtin_amdgcn_s_barrier();
            for (int p = 0; p < 128; ++p) {
                if (p > 0) {
#pragma unroll
                    for (int e = 0; e < 2; ++e) { const int ck = 2 * (p - 1) + e;
                        const v4u yv = *(const LAS v4u*)(F.lds + SQ_YST + (((p - 1) & 1) * 2 + e) * 4096 + lw * 1024 + F.lane * 16);
                        *(v4u*)(Eb + ((size_t)ck * 16 + 4 * lw + (F.lane >> 4)) * 1024 + 384 + 16 * (F.lane & 15)) = yv; } }
                if (lw == 0 && F.lane == 0) __hip_atomic_store(prog, (unsigned)(2 * p), __ATOMIC_RELAXED, __HIP_MEMORY_SCOPE_AGENT);
#pragma unroll
                for (int e = 0; e < 2; ++e) { int cn = 2 * (p + 3) + e; cn = cn < 256 ? cn : 255;
                    if (!(ONLYCHAINS & 2)) wkv_seq_issue(F.lds + ((2 * (p + 3) + e) % SQ_D) * SQ_SLOT, rec_ptr(a.ws, a.out, chain, cn), Eb + (size_t)cn * 16 * 1024, lw, F.lane); }
                asm volatile("s_waitcnt vmcnt(12)" ::: "memory");
                __builtin_amdgcn_s_barrier();
            }
#pragma unroll
            for (int e = 0; e < 2; ++e) { const int ck = 254 + e;
                const v4u yv = *(const LAS v4u*)(F.lds + SQ_YST + ((127 & 1) * 2 + e) * 4096 + lw * 1024 + F.lane * 16);
                *(v4u*)(Eb + ((size_t)ck * 16 + 4 * lw + (F.lane >> 4)) * 1024 + 384 + 16 * (F.lane & 15)) = yv; }
            asm volatile("s_waitcnt vmcnt(0)" ::: "memory");
        } else {
            const int w = F.wave, tl = F.lane & 15, g4 = F.lane >> 4;
            f32x4 S[4];
#pragma unroll
            for (int i = 0; i < 4; ++i) S[i] = (f32x4){0.f, 0.f, 0.f, 0.f};
            __builtin_amdgcn_s_barrier();
            for (int p = 0; p < 128; ++p) {
                if (!(ONLYCHAINS & 4)) {
                wkv_seq_chunk(S, F.lds + ((2 * p) % SQ_D) * SQ_SLOT, F.lds + SQ_YST + ((p & 1) * 2 + 0) * 4096, w, tl, g4);
                wkv_seq_chunk(S, F.lds + ((2 * p + 1) % SQ_D) * SQ_SLOT, F.lds + SQ_YST + ((p & 1) * 2 + 1) * 4096, w, tl, g4); }
                asm volatile("s_waitcnt lgkmcnt(0)" ::: "memory");
                __builtin_amdgcn_s_barrier();
            }
#pragma unroll
            for (int kt = 0; kt < 4; ++kt) *(f32x4*)(a.out + O_PWKV + ((size_t)chain * 64 + 16 * w + tl) * 64 + 16 * kt + 4 * g4) = S[kt];
        }
    } else if (!(ONLYCHAINS & 1)) {
        if (F.bid < 192 && F.wave < 4) {
            const int chain = F.bid % 48, k = F.bid / 48 - 1, hw = F.wave;
            const unsigned* prog = (const unsigned*)(a.ws + WS_CTL) + CW_PROG + 16 * chain;
            const unsigned char* Eb = PREP + (size_t)chain * T * 1024;
            for (int g = k; g < 64; g += 3) {
                const int ck = 4 * g + hw;
                for (unsigned sp = 0; sp < 20000u; ++sp) {
                    const unsigned pr = (unsigned)__builtin_amdgcn_readfirstlane((int)__hip_atomic_load(prog, __ATOMIC_RELAXED, __HIP_MEMORY_SCOPE_AGENT));
                    if ((int)pr + 40 >= ck) break;
                    __builtin_amdgcn_s_sleep(8);
                }
                const unsigned char* R = rec_ptr(a.ws, a.out, chain, ck);
                v4u x[11];
#pragma unroll
                for (int i = 0; i < 9; ++i) { int pz = F.lane + 64 * i; pz = pz < 560 ? pz : 559; x[i] = *(const v4u*)(R + (size_t)pz * 16); }
#pragma unroll
                for (int i = 0; i < 2; ++i) x[9 + i] = *(const v4u*)(Eb + ((size_t)ck * 16 + 8 * i + (F.lane >> 3)) * 1024 + 256 + (F.lane & 7) * 16);
#pragma unroll
                for (int i = 0; i < 11; ++i) asm volatile("" :: "v"(x[i].x), "v"(x[i].y), "v"(x[i].z), "v"(x[i].w));
            }
        } else {
        const int w = (F.bid < 192) ? ((F.bid - 48) * 4 + (F.wave - 4)) : (144 * 4 + (F.bid - 192) * NWAVES + F.wave); const int k4 = F.lane & 15;
        constexpr int NW_OTHER = 144 * 4 + 64 * NWAVES;
        for (int st = w; st < 384 * 16; st += NW_OTHER) {
            const int sc = st >> 4, rg = st & 15, row = 4 * rg + (F.lane >> 4), bs = sc / 12, h = sc % 12;
            f32x4 S = *(const f32x4*)(a.in[I_SWKV] + ((size_t)sc * 64 + row) * 64 + 4 * k4);
#pragma unroll
            for (int t = 0; t < 4; ++t) {
                const unsigned char* E = PREP + ((size_t)48 * T + (size_t)sc * 4 + t) * 1024;
                f32x4 d = ld_bf4(E + 768 + 8 * k4); d.x = __expf(-d.x); d.y = __expf(-d.y); d.z = __expf(-d.z); d.w = __expf(-d.w);
                const f32x4 kk = ld_bf4(E + 384 + 8 * k4), bb = ld_bf4(E + 512 + 8 * k4), kp = ld_bf4(E + 128 + 8 * k4), r = ld_bf4(E + 8 * k4);
                const float v = bf2f(*(const bf16*)(E + 256 + 2 * row));
                const float y = wkv_step(S, d, kk, bb, kp, r, v);
                if (k4 == 0) YS[((size_t)bs * 4 + t) * BW + h * 64 + row] = y;
            }
            *(f32x4*)(a.out + O_SWKV + ((size_t)sc * 64 + row) * 64 + 4 * k4) = S;
        }
        p0_convert_items(a, (LAS float*)(F.lds + F.wave * 16384), F.lane, P0_I_IN, P0_NITEMS, w, NW_OTHER);
        }
    }
}

__device__ __forceinline__ void mix_phase(const Args& a, Frame& F, const unsigned char* PREP, const float* YS, const bf16* ATTO, const float* LSE, bf16* MIX) {
    const int u = F.lane >> 4, cq = F.lane & 15;
    for (int m = F.gw; m < M; m += NGW) {
        bf16* orow = MIX + (size_t)m * D;
        size_t e0; int es;
        if (m < MP) { e0 = (size_t)((m >> 12) * 12) * T + (m & (T - 1)); es = T; } else { const int s = m - MP; e0 = (size_t)48 * T + (size_t)((s >> 2) * 12) * 4 + (s & 3); es = 4; }
#pragma unroll
        for (int it = 0; it < 3; ++it) {
            const int h = 4 * it + u, c = h * 64 + 4 * cq;
            const unsigned char* E = PREP + (e0 + (size_t)h * es) * 1024 + 8 * cq;
            const f32x4 y = (m < MP) ? *(const f32x4*)(E - 8 * cq + 384 + 16 * cq) : *(const f32x4*)(YS + (size_t)(m - MP) * BW + c);
            const f32x4 r = ld_bf4(E), kp = ld_bf4(E + 128), v = ld_bf4(E + 256), g = ld_bf4(E + 640);
            const f32x4 lw = *(const f32x4*)(a.in[I_ELNW] + c), lb = *(const f32x4*)(a.in[I_ELNB] + c), rk = *(const f32x4*)(a.in[I_ERK] + c);
            const float mean = row16_sum((y.x + y.y) + (y.z + y.w)) * (1.0f / 64.0f);
            const f32x4 dy = y - mean;
            const float var = row16_sum((dy.x * dy.x + dy.y * dy.y) + (dy.z * dy.z + dy.w * dy.w)) * (1.0f / 64.0f);
            const float rs = __builtin_amdgcn_rsqf(var + LNX_EPS);
            const f32x4 rkk = r * kp * rk;
            const float bsum = row16_sum((rkk.x + rkk.y) + (rkk.z + rkk.w));
            const f32x4 o = (dy * rs * lw + lb + v * bsum) * g;
            *(v2u*)(orow + 256 + c) = (v2u){pk2(o.x, o.y), pk2(o.z, o.w)};
        }
        {
            const int hs = u, c = hs * 64 + 4 * cq;
            const float l0 = LSE[((size_t)0 * M + m) * 4 + hs], l1 = LSE[((size_t)1 * M + m) * 4 + hs], l2 = LSE[((size_t)2 * M + m) * 4 + hs];
            const f32x4 a0 = ld_bf4((const unsigned char*)(ATTO + ((size_t)0 * M + m) * 256 + c)), a1 = ld_bf4((const unsigned char*)(ATTO + ((size_t)1 * M + m) * 256 + c)), a2 = ld_bf4((const unsigned char*)(ATTO + ((size_t)2 * M + m) * 256 + c));
            const float mx = fmaxf(l0, fmaxf(l1, l2));
            const float w0 = __builtin_amdgcn_exp2f(l0 - mx), w1 = __builtin_amdgcn_exp2f(l1 - mx), w2 = __builtin_amdgcn_exp2f(l2 - mx);
            const float inv = rcpf_(w0 + w1 + w2);
            const f32x4 o = (a0 * w0 + a1 * w1 + a2 * w2) * inv;
            *(v2u*)(orow + c) = (v2u){pk2(o.x, o.y), pk2(o.z, o.w)};
        }
    }
}

constexpr int HG_QROW = 272, HG_TROW = 40;
constexpr int HG_QE = 0, HG_KE = 16 * HG_QROW, HG_KDT = 2 * 16 * HG_QROW, HG_VT = HG_KDT + 128 * HG_TROW, HG_EBL = HG_VT + 128 * HG_TROW, HG_GS = HG_EBL + 512, HG_BUF = HG_GS + 2048;
constexpr int HG_BASE = 16384;
constexpr size_t WS_O = WS_B;
constexpr size_t WS_XCH = WS_B + (size_t)80 * MiB;
constexpr size_t WS_XP = WS_XCH + (size_t)256 * 65536;
static_assert(WS_O + (size_t)M * D * 4 <= WS_XCH && WS_XP + 256 * 512 <= WS_END, "region B (layer 1)");

template <bool FULL>
__device__ __forceinline__ void hgrn_chunks(Frame& F, const bf16* __restrict__ PC, const float* __restrict__ LB, float* __restrict__ O, f32x4 (&S)[8], float& Lsum, int b, int h, int seg) {
    const int tid = F.tid, c = tid & 127, j = tid >> 7, w = F.wave, tl = F.lane & 15, g4 = F.lane >> 4;
    const int pos = (c & ~31) | (((c >> 2) & 3) << 3) | (((c >> 4) & 1) << 2) | (c & 3);
    const float lb = LB[h * 128 + c];
    const size_t mseg = (size_t)b * T + (size_t)seg * 512;
    const bf16* prow = PC + (mseg + 4 * j) * CC + h * 128 + c;
    unsigned short fw[4], iw[4], qw[4], fn[4], in_[4], qn[4];
#pragma unroll
    for (int i = 0; i < 4; ++i) { fn[i] = prow[(size_t)i * CC + 1024]; in_[i] = prow[(size_t)i * CC + 2048]; qn[i] = FULL ? prow[(size_t)i * CC] : (unsigned short)0; }
    for (int n = 0; n < 32; ++n) {
        LAS unsigned char* buf = F.lds + HG_BASE + (n & 1) * HG_BUF;
#pragma unroll
        for (int i = 0; i < 4; ++i) { fw[i] = fn[i]; iw[i] = in_[i]; qw[i] = qn[i]; }
        if (n + 1 < 32) { const bf16* pn = prow + (size_t)(n + 1) * 16 * CC;
#pragma unroll
            for (int i = 0; i < 4; ++i) { fn[i] = pn[(size_t)i * CC + 1024]; in_[i] = pn[(size_t)i * CC + 2048]; if (FULL) qn[i] = pn[(size_t)i * CC]; } }
        float fg[4], pre[4]; float loc = 0.f;
#pragma unroll
        for (int i = 0; i < 4; ++i) { fg[i] = lb + (1.0f - lb) * sigmoidf_(bf2f(fw[i])); loc += __logf(fg[i]); pre[i] = loc; }
        LAS float* GS = (LAS float*)(buf + HG_GS);
        GS[j * 128 + c] = loc;
        __syncthreads();
        const float g0 = GS[c], g1 = GS[128 + c], g2 = GS[256 + c], g3 = GS[384 + c];
        const float off = (j > 0 ? g0 : 0.f) + (j > 1 ? g1 : 0.f) + (j > 2 ? g2 : 0.f);
        const float tot = (g0 + g1) + (g2 + g3);
        const float ebl = __expf(tot);
        Lsum += tot;
        float kd[4];
#pragma unroll
        for (int i = 0; i < 4; ++i) {
            const float bt = off + pre[i];
            const float eb = __expf(bt), en = rcpf_(eb);
            const float ke = (1.0f - fg[i]) * en;
            kd[i] = ke * ebl;
            if (FULL) {
                const float qe = siluf_(bf2f(qw[i])) * eb;
                *(LAS unsigned short*)(buf + HG_QE + (4 * j + i) * HG_QROW + 2 * pos) = (unsigned short)f2bf(qe);
                *(LAS unsigned short*)(buf + HG_KE + (4 * j + i) * HG_QROW + 2 * pos) = (unsigned short)f2bf(ke);
            }
        }
        *(LAS v2u*)(buf + HG_KDT + c * HG_TROW + 8 * j) = (v2u){pk2(kd[0], kd[1]), pk2(kd[2], kd[3])};
        *(LAS v2u*)(buf + HG_VT + c * HG_TROW + 8 * j) = (v2u){(unsigned)iw[0] | ((unsigned)iw[1] << 16), (unsigned)iw[2] | ((unsigned)iw[3] << 16)};
        if (j == 0) *(LAS float*)(buf + HG_EBL + 4 * c) = ebl;
        __syncthreads();
        const v2u vv = *(const LAS v2u*)(buf + HG_VT + (16 * w + tl) * HG_TROW + 8 * g4);
        const bf16x8 vf = __builtin_bit_cast(bf16x8, (v4u){vv.x, vv.y, 0u, 0u});
        if (FULL) {
            bf16x8 qf[4];
#pragma unroll
            for (int ks = 0; ks < 4; ++ks) qf[ks] = *(const LAS bf16x8*)(buf + HG_QE + tl * HG_QROW + 64 * ks + 16 * g4);
            f32x4 att = (f32x4){0.f, 0.f, 0.f, 0.f};
#pragma unroll
            for (int ks = 0; ks < 4; ++ks) att = mfma16(*(const LAS bf16x8*)(buf + HG_KE + tl * HG_QROW + 64 * ks + 16 * g4), qf[ks], att);
            if (4 * g4 + 0 > tl) att.x = 0.f;
            if (4 * g4 + 1 > tl) att.y = 0.f;
            if (4 * g4 + 2 > tl) att.z = 0.f;
            if (4 * g4 + 3 > tl) att.w = 0.f;
            const bf16x8 pB = __builtin_bit_cast(bf16x8, (v4u){pk2(att.x, att.y), pk2(att.z, att.w), 0u, 0u});
            f32x4 o = (f32x4){0.f, 0.f, 0.f, 0.f};
#pragma unroll
            for (int ks = 0; ks < 4; ++ks) {
                const bf16x8 sf = __builtin_bit_cast(bf16x8, (v4u){pk2(S[2 * ks].x, S[2 * ks].y), pk2(S[2 * ks].z, S[2 * ks].w), pk2(S[2 * ks + 1].x, S[2 * ks + 1].y), pk2(S[2 * ks + 1].z, S[2 * ks + 1].w)});
                o = mfma16(sf, qf[ks], o);
            }
            o = mfma16(vf, pB, o);
            *(f32x4*)(O + (mseg + (size_t)n * 16 + tl) * D + h * 128 + 16 * w + 4 * g4) = o;
        }
#pragma unroll
        for (int kt = 0; kt < 8; ++kt) {
            const v2u kw = *(const LAS v2u*)(buf + HG_KDT + (16 * kt + tl) * HG_TROW + 8 * g4);
            const f32x4 e4 = *(const LAS f32x4*)(buf + HG_EBL + 4 * (16 * kt + 4 * g4));
            S[kt] = S[kt] * e4;
            S[kt] = mfma16(__builtin_bit_cast(bf16x8, (v4u){kw.x, kw.y, 0u, 0u}), vf, S[kt]);
        }
    }
}

template <class BarT>
__device__ __forceinline__ void hgrn_fused(const Args& a, Frame& F, const bf16* __restrict__ PC, unsigned char* ws, const BarT& bar) {
    const float* LB = (const float*)(ws + WS_TAB + 8192);
    float* O = (float*)(ws + WS_O);
    {
        const int bs = F.bid >> 3, h = F.bid & 7;
        LAS float* Lq = (LAS float*)F.lds; LAS float* Lf = Lq + 512; LAS float* Lv = Lf + 512; LAS float* Lr = Lv + 512;
        { const int t = F.tid >> 7, k = F.tid & 127; const bf16* pr = PC + ((size_t)MP + bs * 4 + t) * CC + h * 128 + k; const float lb = LB[h * 128 + k];
          Lq[F.tid] = siluf_(bf2f(pr[0])); Lf[F.tid] = lb + (1.0f - lb) * sigmoidf_(bf2f(pr[1024])); Lv[F.tid] = bf2f(pr[2048]); }
        __syncthreads();
        const int v = F.tid & 127, kq = F.tid >> 7;
        float o0 = 0.f, o1 = 0.f, o2 = 0.f, o3 = 0.f;
        const float v0 = Lv[v], v1 = Lv[128 + v], v2 = Lv[256 + v], v3 = Lv[384 + v];
        const size_t sbase = ((size_t)(bs * 8 + h) * 128) * 128;
        for (int kk = 0; kk < 32; ++kk) { const int k = 32 * kq + kk;
            float s = a.in[I_SC][sbase + (size_t)k * 128 + v];
            float fg;
            fg = Lf[k]; s = fg * s + (1.0f - fg) * v0; o0 += Lq[k] * s;
            fg = Lf[128 + k]; s = fg * s + (1.0f - fg) * v1; o1 += Lq[128 + k] * s;
            fg = Lf[256 + k]; s = fg * s + (1.0f - fg) * v2; o2 += Lq[256 + k] * s;
            fg = Lf[384 + k]; s = fg * s + (1.0f - fg) * v3; o3 += Lq[384 + k] * s;
            a.out[O_SC + sbase + (size_t)k * 128 + v] = s; }
        Lr[(kq * 4 + 0) * 128 + v] = o0; Lr[(kq * 4 + 1) * 128 + v] = o1; Lr[(kq * 4 + 2) * 128 + v] = o2; Lr[(kq * 4 + 3) * 128 + v] = o3;
        __syncthreads();
        { const int t = F.tid >> 7, vv = F.tid & 127; const float o = Lr[(0 * 4 + t) * 128 + vv] + Lr[(1 * 4 + t) * 128 + vv] + Lr[(2 * 4 + t) * 128 + vv] + Lr[(3 * 4 + t) * 128 + vv];
          O[((size_t)MP + bs * 4 + t) * D + h * 128 + vv] = o; }
    }
    const int b = F.bid >> 6, h = (F.bid >> 3) & 7, seg = F.bid & 7, w = F.wave, tl = F.lane & 15, g4 = F.lane >> 4;
    f32x4* XCH = (f32x4*)(ws + WS_XCH); float* XP = (float*)(ws + WS_XP);
    f32x4 S[8];
    {
#pragma unroll
        for (int i = 0; i < 8; ++i) S[i] = (f32x4){0.f, 0.f, 0.f, 0.f};
        float Lsum = 0.f;
        hgrn_chunks<false>(F, PC, LB, O, S, Lsum, b, h, seg);
#pragma unroll
        for (int kt = 0; kt < 8; ++kt) XCH[(((size_t)F.bid * 8 + w) * 8 + kt) * 64 + F.lane] = S[kt];
        if (F.tid < 128) XP[F.bid * 128 + F.tid] = __expf(Lsum);
    }
    xcd_barrier(bar);
#pragma unroll
    for (int i = 0; i < 8; ++i) S[i] = (f32x4){0.f, 0.f, 0.f, 0.f};
    for (int sj = 0; sj < seg; ++sj) { const int blk = (F.bid & ~7) + sj;
#pragma unroll
        for (int kt = 0; kt < 8; ++kt) { const f32x4 p4 = *(const f32x4*)(XP + blk * 128 + 16 * kt + 4 * g4); S[kt] = S[kt] * p4 + XCH[(((size_t)blk * 8 + w) * 8 + kt) * 64 + F.lane]; } }
    {
        float Lsum = 0.f;
        hgrn_chunks<true>(F, PC, LB, O, S, Lsum, b, h, seg);
    }
    if (seg == 7) {
#pragma unroll
        for (int kt = 0; kt < 8; ++kt)
#pragma unroll
            for (int i = 0; i < 4; ++i) a.out[O_PC + ((size_t)(b * 8 + h) * 128 + 16 * kt + 4 * g4 + i) * 128 + 16 * w + tl] = S[kt][i];
    }
}

__device__ __forceinline__ void hgrn_out(const Args& a, Frame& F, const bf16* PC, const float* OB, bf16* CO) {
    const float* cn = a.in[I_CNORM];
    for (int m = F.gw; m < M; m += NGW) {
        const float* O = OB + (size_t)m * D;
        const bf16* gate = PC + (size_t)m * CC + 3072;
        f32x4 v[4]; float s = 0.f;
#pragma unroll
        for (int j = 0; j < 4; ++j) { v[j] = *(const f32x4*)(O + 256 * j + 4 * F.lane); s += (v[j].x * v[j].x + v[j].y * v[j].y) + (v[j].z * v[j].z + v[j].w * v[j].w); }
        s = wave_sum(s);
        const float rs = __builtin_amdgcn_rsqf(s * (1.0f / 1024.0f) + EPS);
#pragma unroll
        for (int j = 0; j < 4; ++j) { const int c = 256 * j + 4 * F.lane; const f32x4 g = *(const f32x4*)(cn + c); const v2u gw = *(const v2u*)(gate + c);
            const float x0 = v[j].x * rs * g.x * siluf_(bflo(gw.x)), x1 = v[j].y * rs * g.y * siluf_(bfhi(gw.x)), x2 = v[j].z * rs * g.z * siluf_(bflo(gw.y)), x3 = v[j].w * rs * g.w * siluf_(bfhi(gw.y));
            v2u w; w.x = pk2(x0, x1); w.y = pk2(x2, x3); *(v2u*)(CO + (size_t)m * D + c) = w; }
    }
}

__device__ __forceinline__ void final_norm(const Args& a, Frame& F, const float* rsq) {
    const float* g = a.in[I_NFIN];
    for (int m = F.gw; m < M; m += NGW) {
        float* X = a.out + (size_t)m * D;
        const float rs = __builtin_amdgcn_rsqf(rsq[m] * (1.0f / 1024.0f) + EPS);
#pragma unroll
        for (int j = 0; j < 4; ++j) { const int c = 256 * j + 4 * F.lane; f32x4 v = *(const f32x4*)(X + c); const f32x4 gg = *(const f32x4*)(g + c); v = v * rs * gg; *(f32x4*)(X + c) = v; }
    }
}


constexpr int NPHASE = 16;
__global__ void __launch_bounds__(NTHR, 2) mk_fwd(Args args) {
    extern __shared__ __attribute__((aligned(16))) unsigned char lds[];
    Frame F;
    F.lds = (LAS unsigned char*)lds;
    F.tid = threadIdx.x; F.lane = F.tid & 63; F.wave = __builtin_amdgcn_readfirstlane(F.tid >> 6); F.bid = blockIdx.x; F.gw = F.bid * NWAVES + F.wave;
    unsigned char* ws = args.ws;
    gu32* ctl = (gu32*)(ws + WS_CTL);
    volatile LAS unsigned* MISC = (volatile LAS unsigned*)(F.lds + MISC_OFF);
    for (int u = F.tid; u < (BT_OFF - LDSCTL_OFF) / 4; u += NTHR) ((LAS unsigned*)(F.lds + LDSCTL_OFF))[u] = 0u;
    __syncthreads();
    XcdBarrier bar; bar.bar = (unsigned*)(ctl + CW_BAR); bar.x = 0; bar.st = nullptr;
#if !MK_PER_PHASE
    bar = xcd_barrier_post((unsigned*)(ctl + CW_BAR) + args.li * XCD_BAR_WORDS, MISC + 8);
#define GRID_BAR() xcd_barrier(bar)
#else
#define GRID_BAR() do {} while (0)
#endif
    const int lo = args.ph_lo, hi = args.ph_hi;
#define FRESH(G) Frame G = F; asm volatile("" : "+v"(G.tid)); __builtin_assume(G.tid >= 0 && G.tid < NTHR); G.lane = G.tid & 63
#ifndef PH_MASK
#define PH_MASK 0xFFFF
#endif
#define IN(k) ((((PH_MASK) >> (k)) & 1) && lo <= (k) && (k) < hi)
#define SEAM(k) do { if (IN(k) && IN((k) + 1)) GRID_BAR(); } while (0)

    float* rsq = (float*)(ws + WS_CTL + RSQ_OFF);
    bf16* BUF0 = (bf16*)(ws + WS_BUF0); bf16* BUF1 = (bf16*)(ws + WS_BUF1);
    bf16* RA = (bf16*)(ws + WS_A);
    unsigned char* PREP = ws + WS_B;
    bf16* ATTO = (bf16*)(ws + WS_ATTO); float* LSE = (float*)(ws + WS_LSE);
    const int G = (int)gridDim.x;

    if (IN(0)) { FRESH(G); p0_prologue(args, G); }
    SEAM(0);
    if (IN(1)) {
        pg8::Gemm g{BUF0, (const bf16*)(ws + WS_WIN0), MP, EC, D}; pg8::StaticOrder S; S.init(MP, EC, G, F.bid);
        pg8::EpiScale<0> E{RA, EC, rsq};
        pg8::gemm_phase<pg8::EpiScale<0>, pg8::StaticOrder, true, true>(F.lds, g, S, E);
        { FRESH(G); SEpiScale SE{RA, EC, rsq, 0}; sgemm_phase(G, BUF0, (const bf16*)(ws + WS_WIN0), EC, D, SE); }
    }
    SEAM(1);
    if (IN(2)) {
        FRESH(G);
        { const float* BT = (const float*)(ws + WS_TAB); LAS float* bt = (LAS float*)(F.lds + BT_OFF);
          for (int i = G.tid; i < 12 * BT_LD; i += NTHR) bt[i] = BT[i]; }
        __syncthreads();
        const LAS float* bt = (const LAS float*)(F.lds + BT_OFF);
#ifndef PSKIP
#define PSKIP 0
#endif
        const bool prb = (args.li == 1);
        if (!(prb && (PSKIP & 1)))
        for (int t = F.bid; t < NB * 3 * 4 * 16; t += 256) attn_block(G, RA, bt, ATTO, LSE, t);
        if (!(prb && (PSKIP & 2)))
        for (int t = F.gw; t < SB * 12 * 4; t += NGW) sattn_task(args, RA, bt, ATTO, LSE, (LAS float*)(F.lds + F.wave * 16384), t, G.lane);
        __syncthreads();
#ifndef PREPV
#define PREPV 0
#endif
        if (!prb || PREPV == 0) { if (!(prb && (PSKIP & 4)))
        for (int t = MP / 16 + F.bid; t < M / 16; t += 256) prep_block<0>(args, G, RA, (const bf16*)(ws + WS_TAB + 16384), (const bf16*)(ws + WS_SHB), PREP, t); }
        else { for (int t = F.bid; t < M / 16; t += 256) prep_block<(PREPV ? PREPV : 16)>(args, G, RA, (const bf16*)(ws + WS_TAB + 16384), (const bf16*)(ws + WS_SHB), (unsigned char*)args.out, t); }
        if (!(prb && (PSKIP & 8))) kv_copies(RA, args.out, F.bid * NTHR + G.tid);
        for (int t = F.gw; t < (MP / 16) * 9; t += NGW) wkv_afrag_task(args, RA, (const bf16*)(ws + WS_SHB), (v4u*)(ws + WS_AFG), t / 9, t % 9, G.lane);
    }
    SEAM(2);
    if (IN(3)) { FRESH(G);
#ifdef FRONT_TWICE
#ifndef FRONTV
#define FRONTV 1
#endif
        { LAS unsigned char* area = G.lds + G.wave * FZ_BYTES;
          v4u stg[7];
          wkv_prep_issue(stg, RA, (const bf16*)(ws + WS_SHB), G.gw >> 8, G.gw & 255, G.lane);
          for (int t = G.gw; t < 48 * 256; t += NGW) { const int tn = (t + NGW < 48 * 256) ? t + NGW : t;
              wkv_prep_chunk<FRONTV>(args, stg, (const v4u*)(ws + WS_AFG), RA, (const bf16*)(ws + WS_TAB + 16384), (const bf16*)(ws + WS_SHB), PREP, rec_ptr(ws, args.out, t >> 8, t & 255), area, t >> 8, t & 255, tn >> 8, tn & 255, G.lane); } }
#endif
#ifdef FUSED_TWICE
        { LAS unsigned char* area = G.lds + G.wave * FZ_BYTES;
          v4u stg[7];
          wkv_prep_issue(stg, RA, (const bf16*)(ws + WS_SHB), G.gw >> 8, G.gw & 255, G.lane);
          for (int t = G.gw; t < 48 * 256; t += NGW) { const int tn = (t + NGW < 48 * 256) ? t + NGW : t;
              wkv_prep_chunk<0>(args, stg, (const v4u*)(ws + WS_AFG), RA, (const bf16*)(ws + WS_TAB + 16384), (const bf16*)(ws + WS_SHB), PREP, rec_ptr(ws, args.out, t >> 8, t & 255), area, t >> 8, t & 255, tn >> 8, tn & 255, G.lane); } }
#endif
        { LAS unsigned char* area = G.lds + G.wave * FZ_BYTES;
          v4u stg[7];
          wkv_prep_issue(stg, RA, (const bf16*)(ws + WS_SHB), G.gw >> 8, G.gw & 255, G.lane);
          for (int t = G.gw; t < 48 * 256; t += NGW) { const int tn = (t + NGW < 48 * 256) ? t + NGW : t;
              wkv_prep_chunk<0>(args, stg, (const v4u*)(ws + WS_AFG), RA, (const bf16*)(ws + WS_TAB + 16384), (const bf16*)(ws + WS_SHB), PREP, rec_ptr(ws, args.out, t >> 8, t & 255), area, t >> 8, t & 255, tn >> 8, tn & 255, G.lane); } }
        GRID_BAR();
#ifdef SEQ_PRE
        wkv_phase2<SEQ_PRE>(args, G, PREP, (float*)(ws + WS_YS)); __syncthreads();
#endif
        wkv_phase2<0>(args, G, PREP, (float*)(ws + WS_YS));
#ifdef SEQ_TWICE
        __syncthreads(); wkv_phase2<SEQ_TWICE - 1>(args, G, PREP, (float*)(ws + WS_YS));
#endif
        }
    SEAM(3);
    if (IN(4)) { FRESH(G); mix_phase(args, G, PREP, (const float*)(ws + WS_YS), ATTO, LSE, BUF1); }
    SEAM(4);
    if (IN(5)) {
        pg8::Gemm g{BUF1, (const bf16*)(ws + WS_WOUT0), MP, D, D}; pg8::StaticOrder S; S.init(MP, D, G, F.bid);
        pg8::EpiResid E{args.in[I_XP], args.in[I_XS], args.out, BUF0, rsq + 1 * MPAD, M};
        pg8::gemm_phase<pg8::EpiResid, pg8::StaticOrder, true, true>(F.lds, g, S, E);
        { FRESH(G); SEpiResid SE{args.in[I_XS], args.out + (size_t)MP * D, BUF0, rsq + 1 * MPAD}; sgemm_phase(G, BUF1, (const bf16*)(ws + WS_WOUT0), D, D, SE); }
    }
    SEAM(5);
    if (IN(6)) {
        pg8::Gemm g{BUF0, (const bf16*)(ws + WS_WUP0), MP, FF, D}; pg8::StaticOrder S; S.init(MP, FF, G, F.bid);
        pg8::EpiScale<1> E{RA, FF, rsq + 1 * MPAD};
        pg8::gemm_phase<pg8::EpiScale<1>, pg8::StaticOrder, true, true>(F.lds, g, S, E);
        { FRESH(G); SEpiScale SE{RA, FF, rsq + 1 * MPAD, 1}; sgemm_phase(G, BUF0, (const bf16*)(ws + WS_WUP0), FF, D, SE); }
#ifdef SGEMM_TWICE
        { FRESH(G); SEpiScale SE{RA, FF, rsq + 1 * MPAD, 1}; sgemm_phase(G, BUF0, (const bf16*)(ws + WS_WUP0), FF, D, SE); }
        { FRESH(G); SEpiScale SE{RA, FF, rsq + 1 * MPAD, 1}; sgemm_phase(G, BUF0, (const bf16*)(ws + WS_WUP0), FF, D, SE); }
#endif
    }
    SEAM(6);
    if (IN(7)) {
        pg8::Gemm g{RA, (const bf16*)(ws + WS_WDN0), MP, D, FF}; pg8::StaticOrder S; S.init(MP, D, G, F.bid);
        pg8::EpiResid E{args.out, args.out + (size_t)MP * D, args.out, BUF1, rsq + 2 * MPAD, M};
        pg8::gemm_phase<pg8::EpiResid, pg8::StaticOrder, true, true>(F.lds, g, S, E);
        { FRESH(G); SEpiResid SE{args.out + (size_t)MP * D, args.out + (size_t)MP * D, BUF1, rsq + 2 * MPAD}; sgemm_phase(G, RA, (const bf16*)(ws + WS_WDN0), D, FF, SE); }
    }
    SEAM(7);
    if (IN(8)) {
        pg8::Gemm g{BUF1, (const bf16*)(ws + WS_WCIN), MP, CC, D}; pg8::StaticOrder S; S.init(MP, CC, G, F.bid);
        pg8::EpiScale<0> E{RA, CC, rsq + 2 * MPAD};
        pg8::gemm_phase<pg8::EpiScale<0>, pg8::StaticOrder, true, true>(F.lds, g, S, E);
        { FRESH(G); SEpiScale SE{RA, CC, rsq + 2 * MPAD, 0}; sgemm_phase(G, BUF1, (const bf16*)(ws + WS_WCIN), CC, D, SE); }
    }
    SEAM(8);
    if (IN(9)) { }
    if (IN(10)) { FRESH(G); hgrn_fused(args, G, RA, ws, bar); }
    SEAM(10);
    if (IN(11)) { FRESH(G); hgrn_out(args, G, RA, (const float*)(ws + WS_O), BUF0); }
    SEAM(11);
    if (IN(12)) {
        pg8::Gemm g{BUF0, (const bf16*)(ws + WS_WCOUT), MP, D, D}; pg8::StaticOrder S; S.init(MP, D, G, F.bid);
        pg8::EpiResid E{args.out, args.out + (size_t)MP * D, args.out, BUF1, rsq + 3 * MPAD, M};
        pg8::gemm_phase<pg8::EpiResid, pg8::StaticOrder, true, true>(F.lds, g, S, E);
        { FRESH(G); SEpiResid SE{args.out + (size_t)MP * D, args.out + (size_t)MP * D, BUF1, rsq + 3 * MPAD}; sgemm_phase(G, BUF0, (const bf16*)(ws + WS_WCOUT), D, D, SE); }
    }
    SEAM(12);
    if (IN(13)) {
        pg8::Gemm g{BUF1, (const bf16*)(ws + WS_WUP1), MP, FF, D}; pg8::StaticOrder S; S.init(MP, FF, G, F.bid);
        pg8::EpiScale<1> E{RA, FF, rsq + 3 * MPAD};
        pg8::gemm_phase<pg8::EpiScale<1>, pg8::StaticOrder, true, true>(F.lds, g, S, E);
        { FRESH(G); SEpiScale SE{RA, FF, rsq + 3 * MPAD, 1}; sgemm_phase(G, BUF1, (const bf16*)(ws + WS_WUP1), FF, D, SE); }
    }
    SEAM(13);
    if (IN(14)) {
        pg8::Gemm g{RA, (const bf16*)(ws + WS_WDN1), MP, D, FF}; pg8::StaticOrder S; S.init(MP, D, G, F.bid);
        pg8::EpiResid E{args.out, args.out + (size_t)MP * D, args.out, BUF0, rsq + 4 * MPAD, M};
        pg8::gemm_phase<pg8::EpiResid, pg8::StaticOrder, true, true>(F.lds, g, S, E);
        { FRESH(G); SEpiResid SE{args.out + (size_t)MP * D, args.out + (size_t)MP * D, BUF0, rsq + 4 * MPAD}; sgemm_phase(G, RA, (const bf16*)(ws + WS_WDN1), D, FF, SE); }
    }
    SEAM(14);
    if (IN(15)) { FRESH(G); final_norm(args, G, rsq + 4 * MPAD); }
#undef IN
#undef SEAM
}

extern "C" void kernel_launch(void* const* d_in, const int* in_sizes, int n_in, void* d_out, int out_size, void* d_ws, size_t ws_size, hipStream_t stream) {
    static int grid = 0;
    if (grid == 0) {
        if (n_in != 31 || in_sizes[0] != MP * D || out_size != (int)O_END || ws_size < WS_REQUIRED) {
            fprintf(stderr, "kernel_launch: shape/workspace mismatch: n_in %d in0 %d out %d ws %zu (need %zu); nothing launched\n", n_in, n_in > 0 ? in_sizes[0] : -1, out_size, ws_size, (size_t)WS_REQUIRED); grid = -1; return; }
        if (hipFuncSetAttribute((const void*)mk_fwd, hipFuncAttributeMaxDynamicSharedMemorySize, LDS_BYTES) != hipSuccess) { fprintf(stderr, "kernel_launch: hipFuncSetAttribute failed\n"); grid = -1; return; }
        int per_cu = 0;
        if (hipOccupancyMaxActiveBlocksPerMultiprocessor(&per_cu, (const void*)mk_fwd, NTHR, LDS_BYTES) != hipSuccess || per_cu < 1)
            fprintf(stderr, "kernel_launch: note: occupancy query reports %d workgroups per CU\n", per_cu);
        (void)hipGetLastError();
        grid = 256;
    }
    if (grid < 0) return;
    if (hipMemsetAsync((char*)d_ws + WS_CTL, 0, CTL_ZERO_BYTES, stream) != hipSuccess) { fprintf(stderr, "kernel_launch: hipMemsetAsync failed\n"); return; }
    Args a{};
    for (int i = 0; i < 31; ++i) a.in[i] = (const float*)d_in[i];
    a.out = (float*)d_out; a.ws = (unsigned char*)d_ws;
#if MK_PER_PHASE
    for (int p = 0; p < NPHASE; ++p) { a.ph_lo = p; a.ph_hi = p + 1; hipLaunchKernelGGL(mk_fwd, dim3(grid), dim3(NTHR), LDS_BYTES, stream, a); }
#else
#if defined(PROBE_PHASE)
    a.ph_lo = 0; a.ph_hi = PROBE_PHASE + 1; a.li = 0; hipLaunchKernelGGL(mk_fwd, dim3(grid), dim3(NTHR), LDS_BYTES, stream, a);
    a.ph_lo = PROBE_PHASE; a.ph_hi = PROBE_PHASE + 1; a.li = 1; hipLaunchKernelGGL(mk_fwd, dim3(grid), dim3(NTHR), LDS_BYTES, stream, a);
    a.ph_lo = PROBE_PHASE + 1; a.ph_hi = NPHASE; a.li = 2; hipLaunchKernelGGL(mk_fwd, dim3(grid), dim3(NTHR), LDS_BYTES, stream, a);
#else
    a.ph_lo = 0; a.ph_hi = NPHASE;
    hipLaunchKernelGGL(mk_fwd, dim3(grid), dim3(NTHR), LDS_BYTES, stream, a);
#endif
#endif
    const hipError_t le = hipPeekAtLastError();
    if (le != hipSuccess) fprintf(stderr, "kernel_launch: launch failed: %s\n", hipGetErrorName(le));
}
```

```cpp
#include <hip/hip_runtime.h>
#include <cstdio>
#include <cstdint>

#ifndef MK_PER_PHASE
#define MK_PER_PHASE 0
#endif

namespace pg8 {
#define PG8_LAS __attribute__((address_space(3)))
typedef unsigned short bf16_t;
typedef short bf16x8 __attribute__((ext_vector_type(8)));
typedef float f32x4 __attribute__((ext_vector_type(4)));
typedef unsigned u32x4 __attribute__((ext_vector_type(4)));
constexpr int BM = 256, BK = 64, HALF = 128, HTB = HALF * BK * 2  , STAGE_BYTES = 8 * HTB, NXCD = 8, WGM = 8;

__host__ __device__ __forceinline__ int lds_byte(int r, int c) { const int st = (r >> 4) * 2 + (c >> 5), rr = r & 15, cc = c & 31, ob = rr * 64 + cc * 2; return st * 1024 + (ob ^ (((ob >> 9) & 1) << 5)); }
__host__ __device__ __forceinline__ void stage_rc(int b, int& R, int& C) { const int st = b / 1024, sb = b % 1024, swz = sb ^ (((sb >> 9) & 1) << 5); R = (st >> 1) * 16 + swz / 64; C = (st & 1) * 32 + (swz % 64) / 2; }
__host__ __device__ __forceinline__ int perm32(int rho) { const int n = rho >> 4, i = rho & 15; return 8 * (i >> 2) + 4 * n + (i & 3); }

struct Unit { int pm, pn; };
struct Gemm { const bf16_t* A; const bf16_t* Bt; int M, N, K; };

struct StaticOrder {
    int nM, nN, nwg, G, c;
    __host__ __device__ void init(int M, int N, int G_, int c_) { nM = M / BM; nN = N / BM; nwg = nM * nN; G = G_; c = c_; }
    __host__ __device__ bool next(int i, Unit& u) const {
        const long L = (long)i * G + c; if (L >= nwg) return false;
        int wgid = (int)L; { const int q = nwg / NXCD, r = nwg % NXCD, xcd = wgid % NXCD, off = wgid / NXCD; wgid = (xcd < r ? xcd * (q + 1) : r * (q + 1) + (xcd - r) * q) + off; }
        const int nig = WGM * nN, gid = wgid / nig, fm = gid * WGM, gsz = (nM - fm) < WGM ? (nM - fm) : WGM;
        u.pm = fm + ((wgid % nig) % gsz); u.pn = (wgid % nig) / gsz; return true;
    }
    __device__ __forceinline__ void a_ready(const Unit&) const {}
    __device__ __forceinline__ void done(const Unit&) const {}
};


__device__ __forceinline__ unsigned cvt_pk_bf16(float lo, float hi) { unsigned r; asm volatile("v_cvt_pk_bf16_f32 %0, %1, %2" : "=v"(r) : "v"(lo), "v"(hi)); return r; }
typedef unsigned u32x2 __attribute__((ext_vector_type(2)));

template <int RELU2> struct EpiScale {
    static constexpr bool PERM = true, AFTER_DRAIN = false;
    bf16_t* O; int ldc; const float* rsq;
    __device__ __forceinline__ void operator()(const f32x4 (&acc)[2][2][4][2], const Unit& u, int wr, int wc, int fr, int fq) const {
        const int col0 = u.pn * BM + wc * 32 + 8 * fq;
#pragma unroll
        for (int ai = 0; ai < 2; ++ai)
#pragma unroll
            for (int m = 0; m < 4; ++m) {
                const int row = u.pm * BM + ai * HALF + wr * 64 + m * 16 + fr;
                const float s = __builtin_amdgcn_rsqf(rsq[row] * (1.0f / 1024.0f) + 1e-6f);
                bf16_t* rowp = O + (size_t)row * ldc + col0;
#pragma unroll
                for (int bj = 0; bj < 2; ++bj) {
                    f32x4 v0 = acc[ai][bj][m][0] * s, v1 = acc[ai][bj][m][1] * s;
                    if (RELU2) { v0.x = fmaxf(v0.x, 0.f); v0.y = fmaxf(v0.y, 0.f); v0.z = fmaxf(v0.z, 0.f); v0.w = fmaxf(v0.w, 0.f); v0 = v0 * v0;
                                 v1.x = fmaxf(v1.x, 0.f); v1.y = fmaxf(v1.y, 0.f); v1.z = fmaxf(v1.z, 0.f); v1.w = fmaxf(v1.w, 0.f); v1 = v1 * v1; }
                    u32x4 w; w.x = cvt_pk_bf16(v0.x, v0.y); w.y = cvt_pk_bf16(v0.z, v0.w); w.z = cvt_pk_bf16(v1.x, v1.y); w.w = cvt_pk_bf16(v1.z, v1.w);
                    *(u32x4*)(rowp + bj * HALF) = w;
                }
            }
    }
};

struct EpiResid {
    static constexpr bool PERM = true, AFTER_DRAIN = false;
    const float* Rp; const float* Rs;
    float* X; bf16_t* XB; float* rsq; int Mv;
    __device__ __forceinline__ void operator()(const f32x4 (&acc)[2][2][4][2], const Unit& u, int wr, int wc, int fr, int fq) const {
        const int col0 = u.pn * BM + wc * 32 + 8 * fq;
#pragma unroll
        for (int ai = 0; ai < 2; ++ai)
#pragma unroll
            for (int m = 0; m < 4; ++m) {
                const int row = u.pm * BM + ai * HALF + wr * 64 + m * 16 + fr;
                const bool valid = row < Mv;
                const float* rrow = (row < 16384) ? (Rp + (size_t)row * 1024) : (Rs + (size_t)(row - 16384) * 1024);
                float ss = 0.f;
#pragma unroll
                for (int bj = 0; bj < 2; ++bj) {
                    const int col = col0 + bj * HALF;
                    f32x4 x0 = (f32x4){0.f, 0.f, 0.f, 0.f}, x1 = x0;
                    if (valid) {
                        x0 = *(const f32x4*)(rrow + col) + acc[ai][bj][m][0]; x1 = *(const f32x4*)(rrow + col + 4) + acc[ai][bj][m][1];
                        *(f32x4*)(X + (size_t)row * 1024 + col) = x0; *(f32x4*)(X + (size_t)row * 1024 + col + 4) = x1;
                        ss += ((x0.x * x0.x + x0.y * x0.y) + (x0.z * x0.z + x0.w * x0.w)) + ((x1.x * x1.x + x1.y * x1.y) + (x1.z * x1.z + x1.w * x1.w));
                    }
                    u32x4 w; w.x = cvt_pk_bf16(x0.x, x0.y); w.y = cvt_pk_bf16(x0.z, x0.w); w.z = cvt_pk_bf16(x1.x, x1.y); w.w = cvt_pk_bf16(x1.z, x1.w);
                    *(u32x4*)(XB + (size_t)row * 1024 + col) = w;
                }
                ss += __shfl_xor(ss, 16); ss += __shfl_xor(ss, 32);
                if (fq == 0 && valid) unsafeAtomicAdd(rsq + row, ss);
            }
    }
};

template <class Epi, class Sched, bool ALIGN_EPI = false, bool SP2 = false>
__device__ __forceinline__ void gemm_phase(PG8_LAS unsigned char* lds, const Gemm g, const Sched& S, const Epi& E) {
    int tid_ = threadIdx.x; asm volatile("" : "+v"(tid_)); __builtin_assume(tid_ >= 0 && tid_ < 512);
    const int tid = tid_, wid = __builtin_amdgcn_readfirstlane(tid >> 6), lane = tid & 63, wr = wid >> 2, wc = wid & 3, fr = lane & 15, fq = lane >> 4;
    const int K = g.K, nt = K / BK;
    unsigned voffA[2], voffB[2];
#pragma unroll
    for (int i = 0; i < 2; ++i) { int R, C; stage_rc(tid * 16 + i * 8192, R, C); const int Rb = Epi::PERM ? ((R & ~31) + perm32(R & 31)) : R;
        voffA[i] = (unsigned)(R * K + C) * 2u; voffB[i] = (unsigned)(Rb * K + C) * 2u; }
    const size_t kstep = (size_t)(BK * 2);
    const size_t hstep = (size_t)HALF * K * 2;
    const size_t tstep = 2 * hstep;
    const unsigned ldsw = (unsigned)wid * 1024u;
    const int aoff = lds_byte(wr * 64 + fr, fq * 8), boff = lds_byte(wc * 32 + fr, fq * 8);
#define PG8_SA(b, h) (((b) * 2 + (h)) * HTB)
#define PG8_SB(b, h) ((4 + (b) * 2 + (h)) * HTB)
#define PG8_STAGE(bufoff, gbase, voff) do { _Pragma("unroll") for (int _i = 0; _i < 2; ++_i) \
        __builtin_amdgcn_global_load_lds((const unsigned*)((const char*)(gbase) + (voff)[_i]), (PG8_LAS unsigned*)(lds + (bufoff) + ldsw + _i * 8192), 16, 0, 0); } while (0)
#define PG8_LDA(dst, b, h) do { _Pragma("unroll") for (int m = 0; m < 4; ++m) _Pragma("unroll") for (int k = 0; k < 2; ++k) dst[m][k] = *(const PG8_LAS bf16x8*)(lds + PG8_SA(b, h) + aoff + m * 2048 + k * 1024); } while (0)
#define PG8_LDB(dst, b, h) do { _Pragma("unroll") for (int n = 0; n < 2; ++n) _Pragma("unroll") for (int k = 0; k < 2; ++k) dst[n][k] = *(const PG8_LAS bf16x8*)(lds + PG8_SB(b, h) + boff + n * 2048 + k * 1024); } while (0)
#define PG8_MMA(ai, bj, At, Bt) do { __builtin_amdgcn_s_setprio(1); _Pragma("unroll") for (int m = 0; m < 4; ++m) _Pragma("unroll") for (int n = 0; n < 2; ++n) _Pragma("unroll") for (int k = 0; k < 2; ++k) \
        acc[ai][bj][m][n] = __builtin_amdgcn_mfma_f32_16x16x32_bf16(Bt[n][k], At[m][k], acc[ai][bj][m][n], 0, 0, 0); __builtin_amdgcn_s_setprio(0); } while (0)
#define PG8_WAIT_V(n) asm volatile("s_waitcnt vmcnt(" #n ")" ::: "memory")
#define PG8_WAIT_L(n) asm volatile("s_waitcnt lgkmcnt(" #n ")" ::: "memory")
#define PG8_BAR __builtin_amdgcn_s_barrier()
#define PG8_SCHED __builtin_amdgcn_sched_barrier(0)
    Unit cur, nxt; int ui = 0;
    if (!S.next(0, cur)) return;
    f32x4 acc[2][2][4][2];
#pragma unroll
    for (int a = 0; a < 2; ++a)
#pragma unroll
        for (int b = 0; b < 2; ++b)
#pragma unroll
            for (int m = 0; m < 4; ++m)
#pragma unroll
                for (int n = 0; n < 2; ++n) acc[a][b][m][n] = (f32x4){0.f, 0.f, 0.f, 0.f};
    bf16x8 At[4][2], B0[2][2], B1[2][2];
    const char* cA = (const char*)g.A + (size_t)cur.pm * tstep; const char* cB = (const char*)g.Bt + (size_t)cur.pn * tstep;
    S.a_ready(cur);
    if constexpr (SP2) {
        PG8_STAGE(PG8_SB(0, 0), cB, voffB); PG8_STAGE(PG8_SB(0, 1), cB + hstep, voffB); PG8_STAGE(PG8_SA(0, 0), cA, voffA); PG8_STAGE(PG8_SA(0, 1), cA + hstep, voffA);
        if (wr == 1) PG8_BAR;
        PG8_WAIT_V(2); PG8_BAR;
        PG8_STAGE(PG8_SB(1, 0), cB + kstep, voffB); PG8_STAGE(PG8_SA(1, 0), cA + kstep, voffA); PG8_STAGE(PG8_SB(1, 1), cB + hstep + kstep, voffB);
        PG8_WAIT_V(6); PG8_BAR;
    } else {
        PG8_STAGE(PG8_SB(0, 0), cB, voffB); PG8_STAGE(PG8_SA(0, 0), cA, voffA); PG8_STAGE(PG8_SB(0, 1), cB + hstep, voffB); PG8_STAGE(PG8_SA(0, 1), cA + hstep, voffA);
        if (wr == 1) PG8_BAR;
        PG8_WAIT_V(4); PG8_BAR;
        PG8_STAGE(PG8_SB(1, 0), cB + kstep, voffB); PG8_STAGE(PG8_SA(1, 0), cA + kstep, voffA); PG8_STAGE(PG8_SB(1, 1), cB + hstep + kstep, voffB);
        PG8_WAIT_V(6); PG8_BAR;
    }
    for (;;) {
        const bool has_next = S.next(ui + 1, nxt);
        const char* nA = has_next ? (const char*)g.A + (size_t)nxt.pm * tstep : cA; const char* nB = has_next ? (const char*)g.Bt + (size_t)nxt.pn * tstep : cB;
        for (int t = 0; t < nt; t += 2) {
            const bool last = (t == nt - 2);
            const char* a1 = cA + (size_t)(t + 1) * kstep;
            const char* a2 = last ? nA : cA + (size_t)(t + 2) * kstep; const char* b2 = last ? nB : cB + (size_t)(t + 2) * kstep;
            const char* a3 = a2 + kstep; const char* b3 = b2 + kstep;
            if (last && has_next) S.a_ready(nxt);
            if constexpr (SP2) {
            PG8_LDB(B0, 0, 0); PG8_LDB(B1, 0, 1); PG8_SCHED; PG8_LDA(At, 0, 0); PG8_STAGE(PG8_SA(1, 1), a1 + hstep, voffA);
            PG8_WAIT_V(8); PG8_WAIT_L(0); PG8_BAR; PG8_MMA(0, 0, At, B0); PG8_MMA(0, 1, At, B1); PG8_BAR; PG8_SCHED;
            PG8_LDA(At, 0, 1); PG8_STAGE(PG8_SB(0, 0), b2, voffB); PG8_STAGE(PG8_SB(0, 1), b2 + hstep, voffB); PG8_STAGE(PG8_SA(0, 0), a2, voffA);
            PG8_WAIT_V(8); PG8_WAIT_L(0); PG8_BAR; PG8_MMA(1, 0, At, B0); PG8_MMA(1, 1, At, B1); PG8_BAR; PG8_SCHED;
            PG8_LDB(B0, 1, 0); PG8_LDB(B1, 1, 1); PG8_SCHED; PG8_LDA(At, 1, 0); PG8_STAGE(PG8_SA(0, 1), a2 + hstep, voffA);
            PG8_WAIT_V(8); PG8_WAIT_L(0); PG8_BAR; PG8_MMA(0, 0, At, B0); PG8_MMA(0, 1, At, B1); PG8_BAR; PG8_SCHED;
            PG8_LDA(At, 1, 1); PG8_STAGE(PG8_SB(1, 0), b3, voffB); PG8_STAGE(PG8_SB(1, 1), b3 + hstep, voffB); PG8_STAGE(PG8_SA(1, 0), a3, voffA);
            PG8_WAIT_V(8); PG8_WAIT_L(0); PG8_BAR; PG8_MMA(1, 0, At, B0); PG8_MMA(1, 1, At, B1); PG8_BAR; PG8_SCHED;
            } else {
            PG8_LDB(B0, 0, 0); PG8_SCHED; PG8_LDA(At, 0, 0); PG8_STAGE(PG8_SA(1, 1), a1 + hstep, voffA);
            PG8_WAIT_L(8); PG8_BAR; PG8_WAIT_L(0); PG8_MMA(0, 0, At, B0); PG8_BAR; PG8_SCHED;
            PG8_LDB(B1, 0, 1); PG8_STAGE(PG8_SB(0, 0), b2, voffB);
            PG8_BAR; PG8_WAIT_L(0); PG8_MMA(0, 1, At, B1); PG8_BAR;
            PG8_LDA(At, 0, 1); PG8_STAGE(PG8_SA(0, 0), a2, voffA);
            PG8_BAR; PG8_WAIT_L(0); PG8_MMA(1, 0, At, B0); PG8_BAR; PG8_SCHED;
            PG8_STAGE(PG8_SB(0, 1), b2 + hstep, voffB);
            PG8_WAIT_V(6); PG8_BAR; PG8_MMA(1, 1, At, B1); PG8_BAR;
            PG8_LDB(B0, 1, 0); PG8_SCHED; PG8_LDA(At, 1, 0); PG8_STAGE(PG8_SA(0, 1), a2 + hstep, voffA);
            PG8_WAIT_L(8); PG8_BAR; PG8_WAIT_L(0); PG8_MMA(0, 0, At, B0); PG8_BAR; PG8_SCHED;
            PG8_LDB(B1, 1, 1); PG8_STAGE(PG8_SB(1, 0), b3, voffB);
            PG8_BAR; PG8_WAIT_L(0); PG8_MMA(0, 1, At, B1); PG8_BAR;
            PG8_LDA(At, 1, 1); PG8_STAGE(PG8_SA(1, 0), a3, voffA);
            PG8_BAR; PG8_WAIT_L(0); PG8_MMA(1, 0, At, B0); PG8_BAR; PG8_SCHED;
            PG8_STAGE(PG8_SB(1, 1), b3 + hstep, voffB);
            PG8_WAIT_V(6); PG8_BAR; PG8_MMA(1, 1, At, B1); PG8_BAR;
            }
        }
        if constexpr (ALIGN_EPI) { if (wr == 0) PG8_BAR; }
        if constexpr (!Epi::AFTER_DRAIN) { E(acc, cur, wr, wc, fr, fq); S.done(cur); }
        if (!has_next) break;
#pragma unroll
        for (int a = 0; a < 2; ++a)
#pragma unroll
            for (int b = 0; b < 2; ++b)
#pragma unroll
                for (int m = 0; m < 4; ++m)
#pragma unroll
                    for (int n = 0; n < 2; ++n) acc[a][b][m][n] = (f32x4){0.f, 0.f, 0.f, 0.f};
        cur = nxt; cA = nA; cB = nB; ++ui;
        if constexpr (ALIGN_EPI) { if (wr == 1) PG8_BAR; }
    }
    PG8_WAIT_V(0);
    if constexpr (!ALIGN_EPI) { if (wr == 0) PG8_BAR; }
    PG8_BAR;
    if constexpr (Epi::AFTER_DRAIN) { E.fused(acc, cur, wr, wc, fr, fq, lds, wid, lane); S.done(cur); }
#undef PG8_SA
#undef PG8_SB
#undef PG8_STAGE
#undef PG8_LDA
#undef PG8_LDB
#undef PG8_MMA
#undef PG8_WAIT_V
#undef PG8_WAIT_L
#undef PG8_BAR
#undef PG8_SCHED
}
}

#define GAS __attribute__((address_space(1)))
#define LAS __attribute__((address_space(3)))
typedef unsigned short bf16;
typedef unsigned v4u __attribute__((ext_vector_type(4)));
typedef unsigned v2u __attribute__((ext_vector_type(2)));
typedef float f32x4 __attribute__((ext_vector_type(4)));
typedef float f32x2 __attribute__((ext_vector_type(2)));
typedef float f32x16 __attribute__((ext_vector_type(16)));
typedef short bf16x8 __attribute__((ext_vector_type(8)));
typedef GAS unsigned gu32;

constexpr int NWAVES = 8, NTHR = 512;
constexpr int D = 1024, T = 4096, NB = 4, MP = NB * T, SB = 32, ST = 4, MS = SB * ST, M = MP + MS, MPAD = 16640;
constexpr int EC = 5120, ECR = 4896, AQKV = 2304, BCOLS = 2592, CC = 4096, FF = 4096, BW = 768;
constexpr int LORA = 288;
constexpr float EPS = 1e-6f, LNX_EPS = 64e-5f, LOG2E = 1.4426950408889634f;
constexpr float QSCALE2 = 0.125f * LOG2E;
constexpr int BT_LD = 132;

constexpr size_t O_YP = 0, O_YS = (size_t)MP * D, O_PA0 = (size_t)M * D;
constexpr size_t O_PA1 = O_PA0 + (size_t)4 * 128 * 512, O_PA2 = O_PA1 + (size_t)4 * 512 * 512, O_PSH = O_PA2 + (size_t)4 * 2048 * 512;
constexpr size_t O_PWKV = O_PSH + (size_t)4 * BCOLS, O_PC = O_PWKV + (size_t)4 * 12 * 64 * 64, O_SA0 = O_PC + (size_t)4 * 8 * 128 * 128;
constexpr size_t O_SA1 = O_SA0 + (size_t)32 * 4 * 512, O_SA2 = O_SA1 + (size_t)32 * 4 * 512, O_SSH = O_SA2 + (size_t)32 * 4 * 512;
constexpr size_t O_SWKV = O_SSH + (size_t)32 * BCOLS, O_SC = O_SWKV + (size_t)32 * 12 * 64 * 64, O_END = O_SC + (size_t)32 * 8 * 128 * 128;
static_assert(O_END == 29191296, "output size");

constexpr size_t MiB = 1u << 20;
constexpr size_t WS_CTL = 0, CTL_ZERO_BYTES = 1 * MiB;
constexpr int CW_BAR = 4096;
constexpr int CW_PROG = 15360;
constexpr size_t RSQ_OFF = 65536;
constexpr size_t WS_TAB = 1 * MiB;
constexpr size_t WS_SHB = 1 * MiB + 512 * 1024;
constexpr size_t WS_WIN0 = 2 * MiB;
constexpr size_t WS_WOUT0 = WS_WIN0 + (size_t)EC * D * 2;
constexpr size_t WS_WUP0 = WS_WOUT0 + (size_t)D * D * 2;
constexpr size_t WS_WDN0 = WS_WUP0 + (size_t)FF * D * 2;
constexpr size_t WS_WCIN = WS_WDN0 + (size_t)FF * D * 2;
constexpr size_t WS_WCOUT = WS_WCIN + (size_t)CC * D * 2;
constexpr size_t WS_WUP1 = WS_WCOUT + (size_t)D * D * 2;
constexpr size_t WS_WDN1 = WS_WUP1 + (size_t)FF * D * 2;
constexpr size_t WS_BUF0 = WS_WDN1 + (size_t)FF * D * 2;
constexpr size_t WS_BUF1 = WS_BUF0 + (size_t)MPAD * D * 2;
constexpr size_t WS_ATTO = WS_BUF1 + (size_t)MPAD * D * 2;
constexpr size_t WS_LSE = WS_ATTO + (size_t)3 * M * 256 * 2;
constexpr size_t WS_SQ = WS_LSE + (size_t)3 * M * 4 * 4;
constexpr size_t WS_A = ((WS_SQ + (size_t)MS * 3 * 1024 * 4 + 255) / 256) * 256;
constexpr size_t WS_B = WS_A + (size_t)MPAD * EC * 2;
constexpr int NPREP = 48 * T + 384 * ST;
constexpr size_t WS_END = WS_B + (size_t)NPREP * 1024;
constexpr size_t WS_QE = WS_B, WS_KE = WS_QE + (size_t)MP * D * 2, WS_KET = WS_KE + (size_t)MP * D * 2, WS_VT = WS_KET + (size_t)MP * D * 2, WS_EBL = WS_VT + (size_t)MP * D * 2;
static_assert(WS_EBL + (size_t)(MP / 16) * D * 4 <= WS_END, "region B");

constexpr int RING_BYTES = 131072, LDSCTL_OFF = RING_BYTES, MISC_OFF = LDSCTL_OFF + 320, BT_OFF = 135168, LDS_BYTES = 147456;
static_assert(BT_OFF + 12 * BT_LD * 4 <= LDS_BYTES && MISC_OFF + 128 <= BT_OFF, "LDS map");

#define RLX_AGENT __ATOMIC_RELAXED, __HIP_MEMORY_SCOPE_AGENT
#define LDS_WAIT() asm volatile("s_waitcnt lgkmcnt(0)" ::: "memory")
#define VM_WAIT() asm volatile("s_waitcnt vmcnt(0)" ::: "memory")
typedef __bf16 bf16x2_t __attribute__((ext_vector_type(2)));
__device__ __forceinline__ unsigned pk2(float lo, float hi) { const f32x2 v = {lo, hi}; const bf16x2_t b = __builtin_convertvector(v, bf16x2_t); return __builtin_bit_cast(unsigned, b); }
__device__ __forceinline__ unsigned f2bf(float f) { return pk2(f, 0.f) & 0xffffu; }
__device__ __forceinline__ float bf2f(unsigned short b) { return __uint_as_float((unsigned)b << 16); }
__device__ __forceinline__ float bflo(unsigned w) { return __uint_as_float(w << 16); }
__device__ __forceinline__ float bfhi(unsigned w) { return __uint_as_float(w & 0xffff0000u); }
__device__ __forceinline__ float wave_sum(float v) {
#pragma unroll
    for (int o = 1; o < 64; o <<= 1) v += __shfl_xor(v, o);
    return v;
}
__device__ __forceinline__ float wave_max(float v) {
#pragma unroll
    for (int o = 1; o < 64; o <<= 1) v = fmaxf(v, __shfl_xor(v, o));
    return v;
}
__device__ __forceinline__ float rcpf_(float x) { return __builtin_amdgcn_rcpf(x); }
__device__ __forceinline__ float sigmoidf_(float x) { return rcpf_(1.0f + __expf(-x)); }
__device__ __forceinline__ float siluf_(float x) { return x * rcpf_(1.0f + __expf(-x)); }

#define XB_TMO      128
#define XB_XCNT(j)  (256  + 64 * (j))
#define XB_XSUB(j)  (1280 + 64 * (j))
#define XB_XGEN(j)  (2304 + 64 * (j))
#define XB_TOP      3328
#define XB_TOPGEN   3392
#define XCD_BAR_WORDS 3456
#define XB_SPIN_CAP (1u << 18)

__device__ __forceinline__ unsigned xb_ld(unsigned* p)              { return __hip_atomic_load(p, __ATOMIC_RELAXED, __HIP_MEMORY_SCOPE_AGENT); }
__device__ __forceinline__ unsigned xb_add(unsigned* p, unsigned v) { return __hip_atomic_fetch_add(p, v, __ATOMIC_RELAXED, __HIP_MEMORY_SCOPE_AGENT); }
__device__ __forceinline__ unsigned xb_xcc_id() { return (unsigned)__builtin_amdgcn_s_getreg((3 << 11) | 20) & 0xFu; }
#define XB_SPIN(cond, bar) do { unsigned _sp = 0; while (cond) { __builtin_amdgcn_s_sleep(1); \
    if ((++_sp & 255u) == 0u) { if (xb_ld(&(bar)[XB_TMO])) break; if (_sp > XB_SPIN_CAP) { atomicAdd(&(bar)[XB_TMO], 1u); break; } } } } while (0)

struct XcdBarrier {
    unsigned* bar; unsigned x;
    volatile LAS unsigned* st;
};

__device__ __forceinline__ XcdBarrier xcd_barrier_post(unsigned* bar, volatile LAS unsigned* st) {
    XcdBarrier b; b.bar = bar; b.x = xb_xcc_id(); b.st = st;
    if (threadIdx.x == 0) (void)xb_add(&bar[XB_XCNT(b.x)], 1u);
    return b;
}
__device__ __forceinline__ void xcd_barrier_complete(unsigned* bar, unsigned x, unsigned& nloc, unsigned& nx) {
    const unsigned G = gridDim.x * gridDim.y * gridDim.z;
    unsigned sum, cnt, mine, sp = 0u;
    for (;;) {
        sum = 0u; cnt = 0u; mine = 0u;
#pragma unroll
        for (unsigned j = 0; j < 16; ++j) { const unsigned c = xb_ld(&bar[XB_XCNT(j)]); sum += c; cnt += (c > 0u) ? 1u : 0u; mine = (j == x) ? c : mine; }
        if (sum == G) break;
        __builtin_amdgcn_s_sleep(1);
        if ((++sp & 255u) == 0u) { if (xb_ld(&bar[XB_TMO])) break; if (sp > XB_SPIN_CAP) { atomicAdd(&bar[XB_TMO], 1u); break; } }
    }
    nloc = mine > 0u ? mine : 1u; nx = cnt > 0u ? cnt : 1u;
}

__device__ __forceinline__ void xcd_barrier(const XcdBarrier& b) {
    asm volatile("s_waitcnt vmcnt(0)" ::: "memory");
    __syncthreads();
    if (threadIdx.x == 0) {
        unsigned* bar = b.bar;
        __builtin_amdgcn_s_waitcnt(0);
        unsigned nloc = b.st[0], nx = b.st[1];
        if (nloc == 0u) { xcd_barrier_complete(bar, b.x, nloc, nx); b.st[0] = nloc; b.st[1] = nx; }
        const unsigned old = xb_add(&bar[XB_XSUB(b.x)], 1u);
        const unsigned gen = old / nloc;
        if (old + 1u == (gen + 1u) * nloc) {
            __builtin_amdgcn_fence(__ATOMIC_RELEASE, "agent");
            asm volatile("s_waitcnt vmcnt(0)" ::: "memory");
            const unsigned og = xb_add(&bar[XB_TOP], 1u);
            const unsigned tg = og / nx;
            if (og + 1u == (tg + 1u) * nx) xb_add(&bar[XB_TOPGEN], 1u);
            else XB_SPIN(xb_ld(&bar[XB_TOPGEN]) == tg, bar);
            __builtin_amdgcn_fence(__ATOMIC_ACQUIRE, "agent");
            xb_add(&bar[XB_XGEN(b.x)], 1u);
            asm volatile("s_waitcnt vmcnt(0)" ::: "memory");
        } else {
            XB_SPIN(xb_ld(&bar[XB_XGEN(b.x)]) == gen, bar);
            __builtin_amdgcn_fence(__ATOMIC_ACQUIRE, "agent");
            asm volatile("s_waitcnt vmcnt(0)" ::: "memory");
        }
    }
    __syncthreads();
}

struct Args { const float* in[31]; float* out; unsigned char* ws; int ph_lo, ph_hi, li, pad; };
enum { I_XP = 0, I_XS, I_CA0, I_CA1, I_CA2, I_SSH, I_SWKV, I_SC, I_RELB, I_NMIX, I_NMLP, I_NFIN, I_EWIN, I_EMU, I_EW0, I_EW2, I_EA0, I_EA2, I_EG2,
       I_EKK, I_EKA, I_ERK, I_ELNW, I_ELNB, I_EWOUT, I_CWIN, I_CLB, I_CNORM, I_CWOUT, I_MUP, I_MDN };

struct Frame {
    LAS unsigned char* lds;
    int tid, lane, wave, bid, gw;
};
constexpr int NGW = 256 * NWAVES, NGT = 256 * NTHR;

__device__ __forceinline__ void p0_transpose_item(const float* W, int K, int N, bf16* WT, const float* gain, LAS float* scr, int item, int lane) {
    const int nblk = N / 32, kb = item / nblk, nb = item % nblk, k0 = 64 * kb, n0 = 32 * nb;
    f32x4 x[8];
#pragma unroll
    for (int i = 0; i < 8; ++i) x[i] = *(const f32x4*)(W + (size_t)(k0 + 8 * i + (lane >> 3)) * N + n0 + 4 * (lane & 7));
    if (gain) {
#pragma unroll
        for (int i = 0; i < 8; ++i) x[i] = x[i] * gain[k0 + 8 * i + (lane >> 3)];
    }
#pragma unroll
    for (int i = 0; i < 8; ++i) { LAS float* d = scr + (8 * i + (lane >> 3)) * 33 + 4 * (lane & 7); d[0] = x[i].x; d[1] = x[i].y; d[2] = x[i].z; d[3] = x[i].w; }
    LDS_WAIT(); asm volatile("" ::: "memory");
    const int c = lane & 7;
#pragma unroll
    for (int j = 0; j < 4; ++j) { const int n = (lane >> 3) + 8 * j; const LAS float* s = scr + (8 * c) * 33 + n;
        v4u o; o.x = pk2(s[0 * 33], s[1 * 33]); o.y = pk2(s[2 * 33], s[3 * 33]); o.z = pk2(s[4 * 33], s[5 * 33]); o.w = pk2(s[6 * 33], s[7 * 33]);
        *(GAS v4u*)(WT + (size_t)(n0 + n) * K + k0 + 8 * c) = o; }
    LDS_WAIT(); asm volatile("" ::: "memory");
}

__device__ __forceinline__ int t5_bucket(int dist) {
    if (dist < 16) return dist;
    const float d = (float)dist;
    int large = 16 + (int)(logf(d * (1.0f / 16.0f)) / 4.852030263919617f * 16.0f);
    return large < 31 ? large : 31;
}

constexpr int P0_I_IN = 16 * (ECR / 32), P0_I_SQ = 16 * 32, P0_I_UP = 16 * 128, P0_I_DN = 64 * 32;
constexpr int P0_NITEMS = P0_I_IN + P0_I_SQ + P0_I_UP + P0_I_DN + P0_I_UP + P0_I_SQ + P0_I_UP + P0_I_DN;
__device__ __forceinline__ void p0_convert_items(const Args& a, LAS float* scr, int lane, int first, int last, int wid, int nw) {
    unsigned char* ws = a.ws;
    for (int it = first + wid; it < last; it += nw) {
        int r = it;
        if (r < P0_I_IN) { p0_transpose_item(a.in[I_EWIN], D, ECR, (bf16*)(ws + WS_WIN0), a.in[I_NMIX], scr, r, lane); continue; } r -= P0_I_IN;
        if (r < P0_I_SQ) { p0_transpose_item(a.in[I_EWOUT], D, D, (bf16*)(ws + WS_WOUT0), nullptr, scr, r, lane); continue; } r -= P0_I_SQ;
        if (r < P0_I_UP) { p0_transpose_item(a.in[I_MUP], D, FF, (bf16*)(ws + WS_WUP0), a.in[I_NMLP], scr, r, lane); continue; } r -= P0_I_UP;
        if (r < P0_I_DN) { p0_transpose_item(a.in[I_MDN], FF, D, (bf16*)(ws + WS_WDN0), nullptr, scr, r, lane); continue; } r -= P0_I_DN;
        if (r < P0_I_UP) { p0_transpose_item(a.in[I_CWIN], D, CC, (bf16*)(ws + WS_WCIN), a.in[I_NMIX] + D, scr, r, lane); continue; } r -= P0_I_UP;
        if (r < P0_I_SQ) { p0_transpose_item(a.in[I_CWOUT], D, D, (bf16*)(ws + WS_WCOUT), nullptr, scr, r, lane); continue; } r -= P0_I_SQ;
        if (r < P0_I_UP) { p0_transpose_item(a.in[I_MUP] + (size_t)D * FF, D, FF, (bf16*)(ws + WS_WUP1), a.in[I_NMLP] + D, scr, r, lane); continue; } r -= P0_I_UP;
        p0_transpose_item(a.in[I_MDN] + (size_t)FF * D, FF, D, (bf16*)(ws + WS_WDN1), nullptr, scr, r, lane);
    }
}

__device__ __forceinline__ void p0_prologue(const Args& a, Frame& F) {
    unsigned char* ws = a.ws;
    LAS float* scr = (LAS float*)(F.lds + F.wave * 16384);
    p0_convert_items(a, scr, F.lane, 0, P0_I_IN, F.gw, NGW);
    const int gt = F.bid * NTHR + F.tid;
    { v4u* z = (v4u*)(ws + WS_WIN0 + (size_t)ECR * D * 2); const int n = (EC - ECR) * D * 2 / 16;
      for (int i = gt; i < n; i += NGT) z[i] = (v4u){0u, 0u, 0u, 0u}; }
    { float* BT = (float*)(ws + WS_TAB); const float* rb = a.in[I_RELB];
      for (int i = gt; i < 12 * 129; i += NGT) { const int hd = i / 129, j = i % 129, g = hd >> 2; const int dist = j << (2 * g);
          BT[hd * BT_LD + j] = rb[t5_bucket(dist) * 12 + hd] * LOG2E; }
      float* LB = (float*)(ws + WS_TAB + 8192); const float* lr = a.in[I_CLB];
      for (int i = gt; i < 1024; i += NGT) LB[i] = 1.0f / (1.0f + expf(lr[i] - lr[1024 + i]));
      bf16* LW = (bf16*)(ws + WS_TAB + 16384); const float* w2 = a.in[I_EW2]; const float* a2 = a.in[I_EA2]; const float* g2 = a.in[I_EG2];
      for (int i = gt; i < BW * LORA; i += NGT) { const int ch = i / LORA, j = i % LORA;
          const float v = j < 64 ? w2[j * BW + ch] : (j < 128 ? a2[(j - 64) * BW + ch] : g2[(j - 128) * BW + ch]);
          LW[i] = (bf16)f2bf(v); } }
    { bf16* SHB = (bf16*)(ws + WS_SHB); const float* ss = a.in[I_SSH];
      for (int i = gt; i < 33 * BCOLS; i += NGT) SHB[i] = (i < 32 * BCOLS) ? (bf16)f2bf(ss[i]) : (bf16)0; }
    { bf16* B0 = (bf16*)(ws + WS_BUF0); bf16* B1 = (bf16*)(ws + WS_BUF1); float* rsq0 = (float*)(ws + WS_CTL + RSQ_OFF);
      for (int m = F.gw; m < MPAD; m += NGW) {
          unsigned long long* o8 = (unsigned long long*)(B0 + (size_t)m * D) + F.lane;
          if (m < M) {
              const float* xr = (m < MP) ? (a.in[I_XP] + (size_t)m * D) : (a.in[I_XS] + (size_t)(m - MP) * D);
              const f32x4* x4 = (const f32x4*)xr + F.lane; f32x4 v[4]; float s = 0.f;
#pragma unroll
              for (int j = 0; j < 4; ++j) { v[j] = x4[64 * j]; s += (v[j].x * v[j].x + v[j].y * v[j].y) + (v[j].z * v[j].z + v[j].w * v[j].w); }
              s = wave_sum(s);
#pragma unroll
              for (int j = 0; j < 4; ++j) o8[64 * j] = (unsigned long long)pk2(v[j].x, v[j].y) | ((unsigned long long)pk2(v[j].z, v[j].w) << 32);
              if (F.lane == 0) rsq0[m] = s;
          } else {
              unsigned long long* p8 = (unsigned long long*)(B1 + (size_t)m * D) + F.lane;
#pragma unroll
              for (int j = 0; j < 4; ++j) { o8[64 * j] = 0ull; p8[64 * j] = 0ull; }
          }
      } }
}

__device__ __forceinline__ f32x16 mfma32(bf16x8 a, bf16x8 b, f32x16 c) { return __builtin_amdgcn_mfma_f32_32x32x16_bf16(a, b, c, 0, 0, 0); }
__device__ __forceinline__ f32x4 mfma16(bf16x8 a, bf16x8 b, f32x4 c) { return __builtin_amdgcn_mfma_f32_16x16x32_bf16(a, b, c, 0, 0, 0); }

struct SEpiScale {
    bf16* O; int ldc; const float* rsq; int relu2;
    __device__ __forceinline__ void operator()(int row, int col, f32x4 v, int fq) const {
        const float s = __builtin_amdgcn_rsqf(rsq[row] * (1.0f / 1024.0f) + EPS);
        v = v * s;
        if (relu2) { v.x = fmaxf(v.x, 0.f); v.y = fmaxf(v.y, 0.f); v.z = fmaxf(v.z, 0.f); v.w = fmaxf(v.w, 0.f); v = v * v; }
        v2u w; w.x = pk2(v.x, v.y); w.y = pk2(v.z, v.w);
        *(v2u*)(O + (size_t)row * ldc + col) = w;
    }
};
struct SEpiResid {
    const float* R; float* X; bf16* XB; float* rsq;
    __device__ __forceinline__ void operator()(int row, int col, f32x4 v, int fq) const {
        const size_t o = (size_t)(row - MP) * 1024 + col;
        const f32x4 x = *(const f32x4*)(R + o) + v;
        *(f32x4*)(X + o) = x;
        v2u w; w.x = pk2(x.x, x.y); w.y = pk2(x.z, x.w);
        *(v2u*)(XB + (size_t)row * 1024 + col) = w;
        float ss = (x.x * x.x + x.y * x.y) + (x.z * x.z + x.w * x.w);
        ss += __shfl_xor(ss, 16); ss += __shfl_xor(ss, 32);
        if (fq == 0) unsafeAtomicAdd(rsq + row, ss);
    }
};
template <class Epi>
__device__ __forceinline__ void sgemm_phase(Frame& F, const bf16* __restrict__ A, const bf16* __restrict__ Bt, int N, int K, const Epi& E) {
    const int fr = F.lane & 15, fq = F.lane >> 4, w = F.wave;
    const int kw = K >> 3;
    LAS f32x4* red = (LAS f32x4*)F.lds;
    for (int u = F.bid; u < (N >> 4); u += 256) {
        const int n0 = u << 4;
        f32x4 acc[8];
#pragma unroll
        for (int mt = 0; mt < 8; ++mt) acc[mt] = (f32x4){0.f, 0.f, 0.f, 0.f};
        const bf16* ap = A + (size_t)(MP + fr) * K + w * kw + 8 * fq;
        const bf16* bp = Bt + (size_t)(n0 + fr) * K + w * kw + 8 * fq;
        for (int k0 = 0; k0 < kw; k0 += 128) {
            bf16x8 bfr[4], afr[4][8];
#pragma unroll
            for (int kk = 0; kk < 4; ++kk) { const int k = k0 + 32 * kk;
                bfr[kk] = *(const bf16x8*)(bp + k);
#pragma unroll
                for (int mt = 0; mt < 8; ++mt) afr[kk][mt] = *(const bf16x8*)(ap + (size_t)(16 * mt) * K + k); }
#pragma unroll
            for (int kk = 0; kk < 4; ++kk)
#pragma unroll
                for (int mt = 0; mt < 8; ++mt) acc[mt] = mfma16(bfr[kk], afr[kk][mt], acc[mt]);
        }
#pragma unroll
        for (int mt = 0; mt < 8; ++mt) red[(w * 8 + mt) * 64 + F.lane] = acc[mt];
        __syncthreads();
        f32x4 sum = red[(0 * 8 + w) * 64 + F.lane];
#pragma unroll
        for (int j = 1; j < 8; ++j) sum = sum + red[(j * 8 + w) * 64 + F.lane];
        E(MP + 16 * w + fr, n0 + 4 * fq, sum, fq);
        __syncthreads();
    }
}


constexpr int AT_ROW = 144, AT_K = 0, AT_V = 384 * AT_ROW;
static_assert(2 * 384 * AT_ROW <= RING_BYTES && 8 * 32 * AT_ROW <= AT_V, "attention LDS");
__device__ __forceinline__ void attn_block(Frame& F, const bf16* __restrict__ PROJ, const LAS float* bt, bf16* ATTO, float* LSE, int btask) {
    const int lane = F.lane, w = F.wave;
    const int ti8 = btask & 15; int rest = btask >> 4; const int hs = rest & 3; rest >>= 2; const int g = rest % 3; const int b = rest / 3;
    const int dsh = 2 * g, dil = 1 << dsh, tpr = (T >> dsh) >> 5;
    const int r = (ti8 * 8) / tpr, s0blk = ((ti8 * 8) % tpr) * 32, hd = 4 * g + hs;
    const int q = lane & 31, hh = lane >> 5;
    const size_t rowbase = (size_t)b * T + r;
    const int s0 = s0blk + 32 * w;
    const bf16* Qp = PROJ + (rowbase + (size_t)dil * (s0 + q)) * EC + hd * 64 + 8 * hh;
    bf16x8 qf[4];
#pragma unroll
    for (int ks = 0; ks < 4; ++ks) qf[ks] = *(const bf16x8*)(Qp + 16 * ks);
    {
        v4u stg[12];
#pragma unroll
        for (int i = 0; i < 12; ++i) { const int idx = F.tid + NTHR * i, kv = idx / 3072, rem = idx - kv * 3072, row = rem >> 3, piece = rem & 7;
            int sk = s0blk - 128 + row; sk = sk < 0 ? 0 : sk;
            stg[i] = *(const v4u*)(PROJ + (rowbase + (size_t)dil * sk) * EC + (1 + kv) * BW + hd * 64 + piece * 8); }
#pragma unroll
        for (int i = 0; i < 12; ++i) { const int idx = F.tid + NTHR * i, kv = idx / 3072, rem = idx - kv * 3072, row = rem >> 3, piece = rem & 7;
            *(LAS v4u*)(F.lds + (kv ? AT_V : AT_K) + row * AT_ROW + piece * 16) = stg[i]; }
    }
    __syncthreads();
    f32x16 o0, o1;
#pragma unroll
    for (int i = 0; i < 16; ++i) { o0[i] = 0.f; o1[i] = 0.f; }
    float mrun = -1e30f, lrun = 0.f;
    const LAS float* btp = bt + hd * BT_LD;
    for (int kt = 4; kt >= 0; --kt) {
        const int kbase = s0 - 128 + 32 * kt;
        if (kbase + 31 < 0) break;
        const int kb = 32 * w + 32 * kt;
        const LAS unsigned char* kp = F.lds + AT_K + (kb + q) * AT_ROW + 16 * hh;
        bf16x8 kf[4];
#pragma unroll
        for (int ks = 0; ks < 4; ++ks) kf[ks] = *(const LAS bf16x8*)(kp + 32 * ks);
        bf16x8 vf[2][2];
#pragma unroll
        for (int s = 0; s < 2; ++s)
#pragma unroll
            for (int j = 0; j < 8; ++j) {
                const int key = 16 * s + 8 * (j >> 2) + 4 * hh + (j & 3);
                const LAS unsigned short* vp = (const LAS unsigned short*)(F.lds + AT_V + (kb + key) * AT_ROW) + q;
                vf[s][0][j] = (short)vp[0]; vf[s][1][j] = (short)vp[32];
            }
        f32x16 sacc;
#pragma unroll
        for (int i = 0; i < 16; ++i) sacc[i] = 0.f;
#pragma unroll
        for (int ks = 0; ks < 4; ++ks) sacc = mfma32(kf[ks], qf[ks], sacc);
        float x[16]; float tmax = -1e30f;
#pragma unroll
        for (int reg = 0; reg < 16; ++reg) {
            const int i = (reg & 3) + 8 * (reg >> 2) + 4 * hh;
            const int jj = q - i + 128 - 32 * kt;
            const bool valid = (jj >= 0) && (jj <= 128) && (kbase + i >= 0);
            const int jc = jj < 0 ? 0 : (jj > 128 ? 128 : jj);
            const float bv = btp[jc];
            x[reg] = valid ? (sacc[reg] * QSCALE2 + bv) : -1e30f;
            tmax = fmaxf(tmax, x[reg]);
        }
        tmax = fmaxf(tmax, __shfl_xor(tmax, 32));
        const float mnew = fmaxf(mrun, tmax);
        const float alpha = __builtin_amdgcn_exp2f(mrun - mnew);
        float psum = 0.f; float p[16];
#pragma unroll
        for (int reg = 0; reg < 16; ++reg) { p[reg] = __builtin_amdgcn_exp2f(x[reg] - mnew); psum += p[reg]; }
        psum += __shfl_xor(psum, 32);
        lrun = lrun * alpha + psum; mrun = mnew;
#pragma unroll
        for (int i = 0; i < 16; ++i) { o0[i] *= alpha; o1[i] *= alpha; }
        v4u pw0, pw1;
        pw0.x = pk2(p[0], p[1]); pw0.y = pk2(p[2], p[3]); pw0.z = pk2(p[4], p[5]); pw0.w = pk2(p[6], p[7]);
        pw1.x = pk2(p[8], p[9]); pw1.y = pk2(p[10], p[11]); pw1.z = pk2(p[12], p[13]); pw1.w = pk2(p[14], p[15]);
        const bf16x8 pf0 = __builtin_bit_cast(bf16x8, pw0), pf1 = __builtin_bit_cast(bf16x8, pw1);
        o0 = mfma32(vf[0][0], pf0, o0); o0 = mfma32(vf[1][0], pf1, o0);
        o1 = mfma32(vf[0][1], pf0, o1); o1 = mfma32(vf[1][1], pf1, o1);
    }
    const float inv = rcpf_(lrun);
    __syncthreads();
    {
        LAS unsigned char* ob = F.lds + w * (32 * AT_ROW);
        LAS unsigned char* op = ob + q * AT_ROW + 8 * hh;
#pragma unroll
        for (int rg = 0; rg < 4; ++rg) {
            *(LAS v2u*)(op + 16 * rg) = (v2u){pk2(o0[4 * rg] * inv, o0[4 * rg + 1] * inv), pk2(o0[4 * rg + 2] * inv, o0[4 * rg + 3] * inv)};
            *(LAS v2u*)(op + 64 + 16 * rg) = (v2u){pk2(o1[4 * rg] * inv, o1[4 * rg + 1] * inv), pk2(o1[4 * rg + 2] * inv, o1[4 * rg + 3] * inv)};
        }
#pragma unroll
        for (int ps = 0; ps < 4; ++ps) { const int row = 8 * ps + (lane >> 3), piece = lane & 7;
            const v4u v = *(const LAS v4u*)(ob + row * AT_ROW + piece * 16);
            *(v4u*)(ATTO + ((size_t)g * M + rowbase + (size_t)dil * (s0 + row)) * 256 + hs * 64 + piece * 8) = v; }
    }
    if (hh == 0) LSE[((size_t)g * M + rowbase + (size_t)dil * (s0 + q)) * 4 + hs] = mrun + __log2f(lrun);
    __syncthreads();
}

__device__ __forceinline__ void sattn_task(const Args& a, const bf16* __restrict__ PROJ, const LAS float* bt, bf16* ATTO, float* LSE, LAS float* scr, int task, int lane) {
    const int t = task & 3, hd = (task >> 2) % 12, bs = task / 48, g = hd >> 2, hs = hd & 3, dsh = 2 * g, dil = 1 << dsh, W = 128 << dsh;
    const float* cache = a.in[I_CA0 + g];
    const LAS float* btp = bt + hd * BT_LD;
    LAS float* qs = scr; LAS float* ps = scr + 64;
    const size_t m0 = (size_t)MP + bs * 4;
    qs[lane] = bf2f(PROJ[(m0 + t) * EC + hd * 64 + lane]) * QSCALE2;
    LDS_WAIT(); asm volatile("" ::: "memory");
    float xv[3]; float mx = -1e30f;
#pragma unroll
    for (int ksl = 0; ksl < 3; ++ksl) {
        const int j = lane + 64 * ksl; float x = -1e30f;
        if (j <= 128) {
            const int rho = W + t - j * dil; float dot = 0.f;
            if (rho >= W) {
                const bf16* kp = PROJ + (m0 + (rho - W)) * EC + BW + hd * 64;
#pragma unroll 8
                for (int d = 0; d < 64; ++d) dot += bf2f(kp[d]) * qs[d];
            } else {
                const float* kp = cache + (((size_t)bs * W + rho) * 2 + 0) * 256 + hs * 64;
                f32x4 kv[16];
#pragma unroll
                for (int d4 = 0; d4 < 16; ++d4) kv[d4] = *(const f32x4*)(kp + 4 * d4);
#pragma unroll
                for (int d4 = 0; d4 < 16; ++d4) { const LAS float* qq = qs + 4 * d4; dot += kv[d4].x * qq[0] + kv[d4].y * qq[1] + kv[d4].z * qq[2] + kv[d4].w * qq[3]; }
            }
            x = dot + btp[j];
        }
        xv[ksl] = x; mx = fmaxf(mx, x);
    }
    mx = wave_max(mx);
    float psum = 0.f;
#pragma unroll
    for (int ksl = 0; ksl < 3; ++ksl) { const int j = lane + 64 * ksl; const float p = (j <= 128) ? __builtin_amdgcn_exp2f(xv[ksl] - mx) : 0.f; psum += p; if (j <= 128) ps[j] = p; }
    psum = wave_sum(psum);
    LDS_WAIT(); asm volatile("" ::: "memory");
    float acc = 0.f;
    for (int j = 0; j <= 128; ++j) { const int rho = W + t - j * dil; if (rho < W) break; acc += ps[j] * bf2f(PROJ[(m0 + (rho - W)) * EC + 2 * BW + hd * 64 + lane]); }
    const int jc0 = t / dil + 1;
    const float* vb = cache + (((size_t)bs * W + (W + t)) * 2 + 1) * 256 + hs * 64 + lane;
    int j = jc0;
    for (; j + 16 <= 129; j += 16) {
        float vv[16];
#pragma unroll
        for (int u = 0; u < 16; ++u) vv[u] = vb[-(long)(j + u) * dil * 512];
#pragma unroll
        for (int u = 0; u < 16; ++u) acc += ps[j + u] * vv[u];
    }
    for (; j <= 128; ++j) acc += ps[j] * vb[-(long)j * dil * 512];
    ATTO[((size_t)g * M + m0 + t) * 256 + hs * 64 + lane] = (bf16)f2bf(acc * rcpf_(psum));
    if (lane == 0) LSE[((size_t)g * M + m0 + t) * 4 + hs] = mx + __log2f(psum);
    LDS_WAIT(); asm volatile("" ::: "memory");
}

__device__ __forceinline__ f32x4 ld4bf(const bf16* p) { const v2u w = *(const v2u*)p; return (f32x4){bflo(w.x), bfhi(w.x), bflo(w.y), bfhi(w.y)}; }
__device__ __forceinline__ void kv_copies(const bf16* __restrict__ PROJ, float* out, int gt) {
#pragma unroll
    for (int g = 0; g < 3; ++g) {
        const int Wp = 128 << (2 * g); const size_t off = g == 0 ? O_PA0 : (g == 1 ? O_PA1 : O_PA2);
        const int n4 = NB * Wp * 128;
        for (int i4 = gt; i4 < n4; i4 += NGT) { const int i = i4 * 4; const int d = i & 63, hs = (i >> 6) & 3, kv = (i >> 8) & 1, rr = i >> 9, ii = rr % Wp, b = rr / Wp;
            *(f32x4*)(out + off + i) = ld4bf(PROJ + ((size_t)b * T + (T - Wp) + ii) * EC + (1 + kv) * BW + (4 * g + hs) * 64 + d); }
        const size_t soff = g == 0 ? O_SA0 : (g == 1 ? O_SA1 : O_SA2);
        for (int i4 = gt; i4 < SB * ST * 128; i4 += NGT) { const int i = i4 * 4; const int d = i & 63, hs = (i >> 6) & 3, kv = (i >> 8) & 1, rr = i >> 9;
            *(f32x4*)(out + soff + i) = ld4bf(PROJ + ((size_t)MP + rr) * EC + (1 + kv) * BW + (4 * g + hs) * 64 + d); }
    }
    for (int i4 = gt; i4 < NB * BCOLS / 4; i4 += NGT) { const int i = i4 * 4; const int b = i / BCOLS, c = i % BCOLS; *(f32x4*)(out + O_PSH + i) = ld4bf(PROJ + ((size_t)b * T + T - 1) * EC + AQKV + c); }
    for (int i4 = gt; i4 < SB * BCOLS / 4; i4 += NGT) { const int i = i4 * 4; const int b = i / BCOLS, c = i % BCOLS; *(f32x4*)(out + O_SSH + i) = ld4bf(PROJ + ((size_t)MP + b * 4 + 3) * EC + AQKV + c); }
}

__device__ __forceinline__ void xs8(const bf16* cur, const bf16* prv, const float* mu, int col, float* o) {
    const v4u c8 = *(const v4u*)(cur + col), p8 = *(const v4u*)(prv + col);
    const f32x4 m0 = *(const f32x4*)(mu + col), m1 = *(const f32x4*)(mu + col + 4);
    const float c[8] = {bflo(c8.x), bfhi(c8.x), bflo(c8.y), bfhi(c8.y), bflo(c8.z), bfhi(c8.z), bflo(c8.w), bfhi(c8.w)};
    const float p[8] = {bflo(p8.x), bfhi(p8.x), bflo(p8.y), bfhi(p8.y), bflo(p8.z), bfhi(p8.z), bflo(p8.w), bfhi(p8.w)};
    const float mm[8] = {m0.x, m0.y, m0.z, m0.w, m1.x, m1.y, m1.z, m1.w};
#pragma unroll
    for (int i = 0; i < 8; ++i) o[i] = c[i] + (p[i] - c[i]) * mm[i];
}
__device__ __forceinline__ f32x4 xs4(const bf16* cur, const bf16* prv, const float* mu, int col) {
    const v2u c4 = *(const v2u*)(cur + col), p4 = *(const v2u*)(prv + col);
    const f32x4 c = (f32x4){bflo(c4.x), bfhi(c4.x), bflo(c4.y), bfhi(c4.y)}, p = (f32x4){bflo(p4.x), bfhi(p4.x), bflo(p4.y), bfhi(p4.y)};
    const f32x4 m = *(const f32x4*)(mu + col);
    return c + (p - c) * m;
}

constexpr int PB_ROW = BCOLS * 2, PB_PIECES = PB_ROW / 16, PB_AF_OFF = 20 * PB_ROW, PB_SCR_OFF = PB_AF_OFF + 9 * 64 * 16, PB_SCR_W = 2048;
static_assert(PB_SCR_OFF + 8 * PB_SCR_W <= BT_OFF, "prep LDS");
__device__ __forceinline__ f32x4 lxs4(const LAS unsigned char* cur, const float* mu, int col) {
    const v2u c4 = *(const LAS v2u*)(cur + 2 * col), p4 = *(const LAS v2u*)(cur - PB_ROW + 2 * col);
    const f32x4 c = (f32x4){bflo(c4.x), bfhi(c4.x), bflo(c4.y), bfhi(c4.y)}, p = (f32x4){bflo(p4.x), bfhi(p4.x), bflo(p4.y), bfhi(p4.y)};
    const f32x4 m = *(const f32x4*)(mu + col);
    return c + (p - c) * m;
}
template <int PV>
__device__ __forceinline__ void prep_block(const Args& a, Frame& F, const bf16* __restrict__ PROJ, const bf16* __restrict__ LW, const bf16* __restrict__ SHB, unsigned char* PREP, int task) {
    const int lane = F.lane, tok = lane & 15, g4 = lane >> 4, w = F.wave;
    const bool samp = task >= MP / 16;
    const int nrows = samp ? 20 : 17;
    if (!(PV & 8)) {
        v4u stg[13];
#pragma unroll
        for (int i = 0; i < 13; ++i) { const int idx = F.tid + NTHR * i;
            if (idx < nrows * PB_PIECES) {
                const int row = idx / PB_PIECES, piece = idx - row * PB_PIECES;
                const bf16* src;
                if (!samp) { const int m = task * 16 - 1 + row; src = (row == 0 && ((task * 16) & (T - 1)) == 0) ? (SHB + 32 * BCOLS) : (PROJ + (size_t)m * EC + AQKV); }
                else { const int q = row / 5, rr = row - 5 * q, seq = (task - MP / 16) * 4 + q; src = (rr == 0) ? (SHB + seq * BCOLS) : (PROJ + (size_t)(MP + seq * 4 + rr - 1) * EC + AQKV); }
                stg[i] = *(const v4u*)(src + piece * 8); }
            else stg[i] = (v4u){0u, 0u, 0u, 0u}; }
#pragma unroll
        for (int i = 0; i < 13; ++i) { const int idx = F.tid + NTHR * i;
            if (idx < nrows * PB_PIECES) { const int row = idx / PB_PIECES, piece = idx - row * PB_PIECES; *(LAS v4u*)(F.lds + row * PB_ROW + piece * 16) = stg[i]; } }
    }
    __syncthreads();
    const int crow = samp ? (5 * (tok >> 2) + 1 + (tok & 3)) : (tok + 1);
    const LAS unsigned char* cur = F.lds + crow * PB_ROW;
    const float* mu = a.in[I_EMU];
    for (int ks = w; ks < 9; ks += 8) {
        const int col = 3 * BW + 32 * ks + 8 * g4;
        const v4u c8 = *(const LAS v4u*)(cur + 2 * col), p8 = *(const LAS v4u*)(cur - PB_ROW + 2 * col);
        const f32x4 m0 = *(const f32x4*)(mu + col), m1 = *(const f32x4*)(mu + col + 4);
        const float c[8] = {bflo(c8.x), bfhi(c8.x), bflo(c8.y), bfhi(c8.y), bflo(c8.z), bfhi(c8.z), bflo(c8.w), bfhi(c8.w)};
        const float p[8] = {bflo(p8.x), bfhi(p8.x), bflo(p8.y), bfhi(p8.y), bflo(p8.z), bfhi(p8.z), bflo(p8.w), bfhi(p8.w)};
        const float mm[8] = {m0.x, m0.y, m0.z, m0.w, m1.x, m1.y, m1.z, m1.w};
        float v[8];
#pragma unroll
        for (int i = 0; i < 8; ++i) {
            v[i] = c[i] + (p[i] - c[i]) * mm[i];
            if (ks < 2) { const float e = __expf(2.0f * v[i]); v[i] = 1.0f - 2.0f * rcpf_(e + 1.0f); }
            else if (ks >= 4) v[i] = sigmoidf_(v[i]);
        }
        *(LAS v4u*)(F.lds + PB_AF_OFF + (ks * 64 + lane) * 16) = (v4u){pk2(v[0], v[1]), pk2(v[2], v[3]), pk2(v[4], v[5]), pk2(v[6], v[7])};
    }
    __syncthreads();
    bf16x8 af[9];
#pragma unroll
    for (int ks = 0; ks < 9; ++ks) af[ks] = *(const LAS bf16x8*)(F.lds + PB_AF_OFF + (ks * 64 + lane) * 16);
    size_t ebase0; int estride;
    if (!samp) { const int m0 = task * 16, t0 = m0 & (T - 1), b = m0 >> 12; ebase0 = (size_t)(b * 12) * T + t0; estride = T; }
    else { const int sb0 = (task - MP / 16) * 4; ebase0 = (size_t)48 * T + (size_t)(sb0 * 12) * 4; estride = 4; }
    LAS unsigned char* scr = F.lds + PB_SCR_OFF + w * PB_SCR_W;
    const float* k_k = a.in[I_EKK];
#pragma unroll 1
    for (int h = w; h < 12; h += 8) {
        f32x4 kr[4];
        float ssq = 0.f;
#pragma unroll
        for (int nt = 0; nt < 4; ++nt) {
            const int c4 = h * 64 + 16 * nt + 4 * g4;
            kr[nt] = lxs4(cur, mu, BW + c4);
            const f32x4 kkr = kr[nt] * *(const f32x4*)(k_k + c4);
            ssq += (kkr.x * kkr.x + kkr.y * kkr.y) + (kkr.z * kkr.z + kkr.w * kkr.w);
        }
        ssq += __shfl_xor(ssq, 16); ssq += __shfl_xor(ssq, 32);
        const float kinv = rcpf_(fmaxf(__builtin_amdgcn_sqrtf(ssq), 1e-12f));
        v2u pkv[7][4];
#pragma unroll
        for (int nt = 0; nt < 4; ++nt) {
            const bf16* lwp = LW + (size_t)(h * 64 + 16 * nt + tok) * LORA + 8 * g4;
            f32x4 aw = (f32x4){0.f, 0.f, 0.f, 0.f}, aa = aw, ag = aw;
            if (!(PV & 1)) {
#pragma unroll
            for (int ks = 0; ks < 9; ++ks) { const bf16x8 bw = *(const bf16x8*)(lwp + 32 * ks);
                if (ks < 2) aw = mfma16(bw, af[ks], aw); else if (ks < 4) aa = mfma16(bw, af[ks], aa); else ag = mfma16(bw, af[ks], ag); }
            } else { aw = __builtin_bit_cast(f32x4, af[nt]); aa = __builtin_bit_cast(f32x4, af[nt + 4]); ag = aw; }
            const int c4 = h * 64 + 16 * nt + 4 * g4, cl = 16 * nt + 4 * g4;
            const f32x4 w0 = *(const f32x4*)(a.in[I_EW0] + c4), a0 = *(const f32x4*)(a.in[I_EA0] + c4), kkc = *(const f32x4*)(k_k + c4), kac = *(const f32x4*)(a.in[I_EKA] + c4);
            f32x4 dec, av, kk, kp, bb;
#pragma unroll
            for (int i = 0; i < 4; ++i) {
                const float z = -(w0[i] + aw[i]);
                if (!(PV & 2)) {
                const float sp = fmaxf(z, 0.f) + __logf(1.0f + __expf(-fabsf(z)));
                const float ww = -sp - 0.5f;
                dec[i] = __expf(ww);
                av[i] = sigmoidf_(a0[i] + aa[i]);
                } else { dec[i] = z; av[i] = a0[i] + aa[i]; }
                kk[i] = kr[nt][i] * kkc[i] * kinv;
                kp[i] = kr[nt][i] * (1.0f + (av[i] - 1.0f) * kac[i]);
                bb[i] = kk[i] * av[i];
            }
            const f32x4 rr4 = lxs4(cur, mu, c4), vr4 = lxs4(cur, mu, 2 * BW + c4);
            const f32x4 ew = dec;
            pkv[0][nt] = (v2u){pk2(rr4.x, rr4.y), pk2(rr4.z, rr4.w)};
            pkv[1][nt] = (v2u){pk2(kp.x, kp.y), pk2(kp.z, kp.w)};
            pkv[2][nt] = (v2u){pk2(vr4.x, vr4.y), pk2(vr4.z, vr4.w)};
            pkv[3][nt] = (v2u){pk2(kk.x, kk.y), pk2(kk.z, kk.w)};
            pkv[4][nt] = (v2u){pk2(bb.x, bb.y), pk2(bb.z, bb.w)};
            pkv[5][nt] = (v2u){pk2(ag.x, ag.y), pk2(ag.z, ag.w)};
            pkv[6][nt] = (v2u){pk2(ew.x, ew.y), pk2(ew.z, ew.w)};
        }
        unsigned char* Et[4];
#pragma unroll
        for (int sI = 0; sI < 4; ++sI) { const int tt = 4 * sI + (lane >> 4);
            size_t eidx = ebase0 + (size_t)h * estride + (samp ? (size_t)((tt >> 2) * 48 + (tt & 3)) : (size_t)tt);
            if (PV) eidx &= 65535;
            Et[sI] = PREP + eidx * 1024 + 8 * (lane & 15); }
#pragma unroll
        for (int vI = 0; vI < 7; ++vI) {
#pragma unroll
            for (int nt = 0; nt < 4; ++nt) *(LAS v2u*)(scr + tok * 128 + 2 * (16 * nt + 4 * g4)) = pkv[vI][nt];
#pragma unroll
            for (int sI = 0; sI < 4; ++sI) { const v2u ov = *(const LAS v2u*)(scr + (4 * sI + (lane >> 4)) * 128 + 8 * (lane & 15)); if (!(PV & 4)) *(v2u*)(Et[sI] + 128 * vI) = ov; else asm volatile("" :: "v"(ov.x), "v"(ov.y)); }
        }
    }
    __syncthreads();
}

__device__ __forceinline__ float row16_sum(float x) {
    x += __int_as_float(__builtin_amdgcn_mov_dpp(__float_as_int(x), 0x128, 0xf, 0xf, false));
    x += __int_as_float(__builtin_amdgcn_mov_dpp(__float_as_int(x), 0x124, 0xf, 0xf, false));
    x += __int_as_float(__builtin_amdgcn_mov_dpp(__float_as_int(x), 0x122, 0xf, 0xf, false));
    x += __int_as_float(__builtin_amdgcn_mov_dpp(__float_as_int(x), 0x121, 0xf, 0xf, false));
    return x;
}
__device__ __forceinline__ void row16_sum2(float& a, float& b) {
    asm("s_nop 1\n\t"
        "v_add_f32_dpp %0, %0, %0 row_ror:8 row_mask:0xf bank_mask:0xf\n\t"
        "v_add_f32_dpp %1, %1, %1 row_ror:8 row_mask:0xf bank_mask:0xf\n\t"
        "s_nop 0\n\t"
        "v_add_f32_dpp %0, %0, %0 row_ror:4 row_mask:0xf bank_mask:0xf\n\t"
        "v_add_f32_dpp %1, %1, %1 row_ror:4 row_mask:0xf bank_mask:0xf\n\t"
        "s_nop 0\n\t"
        "v_add_f32_dpp %0, %0, %0 row_ror:2 row_mask:0xf bank_mask:0xf\n\t"
        "v_add_f32_dpp %1, %1, %1 row_ror:2 row_mask:0xf bank_mask:0xf\n\t"
        "s_nop 0\n\t"
        "v_add_f32_dpp %0, %0, %0 row_ror:1 row_mask:0xf bank_mask:0xf\n\t"
        "v_add_f32_dpp %1, %1, %1 row_ror:1 row_mask:0xf bank_mask:0xf\n\t"
        "s_nop 1"
        : "+v"(a), "+v"(b));
}
__device__ __forceinline__ float wkv_step(f32x4& S, const f32x4 d, const f32x4 kk, const f32x4 bb, const f32x4 kp, const f32x4 r, const float v) {
    float p = S.x * kk.x; p = fmaf(S.y, kk.y, p); p = fmaf(S.z, kk.z, p); p = fmaf(S.w, kk.w, p);
    const float sa = -row16_sum(p);
    S.x = fmaf(sa, bb.x, fmaf(S.x, d.x, v * kp.x));
    S.y = fmaf(sa, bb.y, fmaf(S.y, d.y, v * kp.y));
    S.z = fmaf(sa, bb.z, fmaf(S.z, d.z, v * kp.z));
    S.w = fmaf(sa, bb.w, fmaf(S.w, d.w, v * kp.w));
    float y = S.x * r.x; y = fmaf(S.y, r.y, y); y = fmaf(S.z, r.z, y); y = fmaf(S.w, r.w, y);
    return row16_sum(y);
}
__device__ __forceinline__ float wkv_step_p(f32x4& S, float& ypart, const f32x4 d, const f32x4 kk, const f32x4 bb, const f32x4 kp, const f32x4 r, const float v) {
    float s0 = S.x, s1 = S.y, s2 = S.z, s3 = S.w, y = ypart, p, t;
    asm("v_mul_f32 %5, %0, %7\n\t"
        "v_fmac_f32 %5, %1, %8\n\t"
        "v_fmac_f32 %5, %2, %9\n\t"
        "v_fmac_f32 %5, %3, %10\n\t"
        "v_mul_f32 %6, %27, %19\n\t"
        "v_add_f32_dpp %4, %4, %4 row_ror:8 row_mask:0xf bank_mask:0xf\n\t"
        "v_add_f32_dpp %5, %5, %5 row_ror:8 row_mask:0xf bank_mask:0xf\n\t"
        "v_fma_f32 %0, %0, %11, %6\n\t"
        "v_add_f32_dpp %4, %4, %4 row_ror:4 row_mask:0xf bank_mask:0xf\n\t"
        "v_add_f32_dpp %5, %5, %5 row_ror:4 row_mask:0xf bank_mask:0xf\n\t"
        "v_mul_f32 %6, %27, %20\n\t"
        "v_add_f32_dpp %4, %4, %4 row_ror:2 row_mask:0xf bank_mask:0xf\n\t"
        "v_add_f32_dpp %5, %5, %5 row_ror:2 row_mask:0xf bank_mask:0xf\n\t"
        "v_fma_f32 %1, %1, %12, %6\n\t"
        "v_add_f32_dpp %4, %4, %4 row_ror:1 row_mask:0xf bank_mask:0xf\n\t"
        "v_add_f32_dpp %5, %5, %5 row_ror:1 row_mask:0xf bank_mask:0xf\n\t"
        "v_mul_f32 %6, %27, %21\n\t"
        "v_fma_f32 %2, %2, %13, %6\n\t"
        "v_mul_f32 %6, %27, %22\n\t"
        "v_fma_f32 %3, %3, %14, %6\n\t"
        "v_fma_f32 %0, -%5, %15, %0\n\t"
        "v_fma_f32 %1, -%5, %16, %1\n\t"
        "v_fma_f32 %2, -%5, %17, %2\n\t"
        "v_fma_f32 %3, -%5, %18, %3\n\t"
        "v_mul_f32 %6, %0, %23\n\t"
        "v_fmac_f32 %6, %1, %24\n\t"
        "v_fmac_f32 %6, %2, %25\n\t"
        "v_fmac_f32 %6, %3, %26"
        : "+v"(s0), "+v"(s1), "+v"(s2), "+v"(s3), "+v"(y), "=&v"(p), "=&v"(t)
        : "v"(kk.x), "v"(kk.y), "v"(kk.z), "v"(kk.w), "v"(d.x), "v"(d.y), "v"(d.z), "v"(d.w), "v"(bb.x), "v"(bb.y), "v"(bb.z), "v"(bb.w),
          "v"(kp.x), "v"(kp.y), "v"(kp.z), "v"(kp.w), "v"(r.x), "v"(r.y), "v"(r.z), "v"(r.w), "v"(v));
    S.x = s0; S.y = s1; S.z = s2; S.w = s3;
    ypart = t;
    return y;
}
__device__ __forceinline__ f32x4 ld_bf4(const unsigned char* p) { const v2u w = *(const v2u*)p; return (f32x4){bflo(w.x), bfhi(w.x), bflo(w.y), bfhi(w.y)}; }

constexpr int WK_TCH = 32, WK_STEP_F = 336, WK_BUF_F = WK_TCH * WK_STEP_F;
constexpr int WK_NG = WK_TCH * 84;
__device__ __forceinline__ void wkv_fetch(v2u (&raw)[11], const unsigned char* Eb, int c, int li, int rowq) {
    const unsigned char* Ec = Eb + (size_t)c * WK_TCH * 1024;
#pragma unroll
    for (int i = 0; i < 11; ++i) { const int gi = li + 256 * i;
        if (gi < WK_NG) { const int st = gi / 84, gg = gi % 84; int off;
            if (gg < 16) off = 768 + 8 * gg; else if (gg < 32) off = 384 + 8 * (gg - 16); else if (gg < 48) off = 512 + 8 * (gg - 32);
            else if (gg < 64) off = 128 + 8 * (gg - 48); else if (gg < 80) off = 8 * (gg - 64); else off = 256 + 2 * (16 * rowq + 4 * (gg - 80));
            raw[i] = *(const v2u*)(Ec + (size_t)st * 1024 + off); }
        else raw[i] = (v2u){0u, 0u}; }
}
__device__ __forceinline__ void wkv_put(const v2u (&raw)[11], LAS float* L, int c, int li) {
    LAS float* buf = L + (c & 1) * WK_BUF_F;
#pragma unroll
    for (int i = 0; i < 11; ++i) { const int gi = li + 256 * i;
        if (gi < WK_NG) { const int st = gi / 84, gg = gi % 84; LAS float* sp = buf + st * WK_STEP_F;
            f32x4 v = (f32x4){bflo(raw[i].x), bfhi(raw[i].x), bflo(raw[i].y), bfhi(raw[i].y)};
            if (gg < 16) { v.x = __expf(-v.x); v.y = __expf(-v.y); v.z = __expf(-v.z); v.w = __expf(-v.w); }
            *(LAS f32x4*)(sp + 4 * gg) = v; } }
}
__device__ __forceinline__ void wkv_phase(const Args& a, Frame& F, unsigned char* PREP, bf16* PROJ) {
    if (F.bid < 192) {
        const int chain = F.bid >> 2, rowq = F.bid & 3, b = chain / 12, h = chain % 12;
        LAS float* L = (LAS float*)F.lds;
        const unsigned char* Eb = PREP + (size_t)chain * T * 1024;
        const bool loader = F.wave >= 4; const int li = F.tid - 256;
        f32x4 S = (f32x4){0.f, 0.f, 0.f, 0.f};
        const int k4 = F.lane & 15, rloc = 4 * (F.wave & 3) + (F.lane >> 4);
        constexpr int NCH = T / WK_TCH;
        float ypart = 0.f, yreg = 0.f;
        float* ybase = (float*)(PROJ + ((size_t)b * T + k4) * EC) + 1152 + h * 64 + 16 * rowq + rloc;
        v2u raw[11];
        if (loader) { wkv_fetch(raw, Eb, 0, li, rowq); wkv_put(raw, L, 0, li); wkv_fetch(raw, Eb, 1, li, rowq); }
        __syncthreads();
        for (int c = 0; c < NCH; ++c) {
            if (loader) { if (c + 1 < NCH) wkv_put(raw, L, c + 1, li); if (c + 2 < NCH) wkv_fetch(raw, Eb, c + 2, li, rowq); }
            else {
                const LAS float* buf = L + (c & 1) * WK_BUF_F;
                f32x4 od[2], okk[2], obb[2], okp[2], orr[2]; float ov[2];
                od[0] = *(const LAS f32x4*)(buf + 4 * k4); okk[0] = *(const LAS f32x4*)(buf + 64 + 4 * k4); obb[0] = *(const LAS f32x4*)(buf + 128 + 4 * k4);
                okp[0] = *(const LAS f32x4*)(buf + 192 + 4 * k4); orr[0] = *(const LAS f32x4*)(buf + 256 + 4 * k4); ov[0] = buf[320 + rloc];
#pragma unroll
                for (int s = 0; s < WK_TCH; ++s) {
                    if (s + 1 < WK_TCH) { const LAS float* sp = buf + (s + 1) * WK_STEP_F; const int nb = (s + 1) & 1;
                        od[nb] = *(const LAS f32x4*)(sp + 4 * k4); okk[nb] = *(const LAS f32x4*)(sp + 64 + 4 * k4); obb[nb] = *(const LAS f32x4*)(sp + 128 + 4 * k4);
                        okp[nb] = *(const LAS f32x4*)(sp + 192 + 4 * k4); orr[nb] = *(const LAS f32x4*)(sp + 256 + 4 * k4); ov[nb] = sp[320 + rloc]; }
                    const int cb = s & 1;
                    const float yprev = wkv_step_p(S, ypart, od[cb], okk[cb], obb[cb], okp[cb], orr[cb], ov[cb]);
                    yreg = (k4 == ((s + 15) & 15)) ? yprev : yreg;
                    if ((s & 15) == 0 && (c > 0 || s > 0)) ybase[(size_t)(32 * c + s - 16) * (EC / 2)] = yreg;
                }
            }
            __syncthreads();
        }
        if (!loader) {
            float dummy = 0.f; row16_sum2(ypart, dummy);
            yreg = (k4 == 15) ? ypart : yreg;
            ybase[(size_t)(T - 16) * (EC / 2)] = yreg;
            *(f32x4*)(a.out + O_PWKV + ((size_t)chain * 64 + 16 * rowq + rloc) * 64 + 4 * k4) = S;
        }
    } else {
        const int w = (F.bid - 192) * NWAVES + F.wave; const int k4 = F.lane & 15;
        for (int st = w; st < 384 * 16; st += 64 * NWAVES) {
            const int sc = st >> 4, rg = st & 15, row = 4 * rg + (F.lane >> 4), bs = sc / 12, h = sc % 12;
            f32x4 S = *(const f32x4*)(a.in[I_SWKV] + ((size_t)sc * 64 + row) * 64 + 4 * k4);
#pragma unroll
            for (int t = 0; t < 4; ++t) {
                const unsigned char* E = PREP + ((size_t)48 * T + (size_t)sc * 4 + t) * 1024;
                f32x4 d = ld_bf4(E + 768 + 8 * k4); d.x = __expf(-d.x); d.y = __expf(-d.y); d.z = __expf(-d.z); d.w = __expf(-d.w);
                const f32x4 kk = ld_bf4(E + 384 + 8 * k4), bb = ld_bf4(E + 512 + 8 * k4), kp = ld_bf4(E + 128 + 8 * k4), r = ld_bf4(E + 8 * k4);
                const float v = bf2f(*(const bf16*)(E + 256 + 2 * row));
                const float y = wkv_step(S, d, kk, bb, kp, r, v);
                if (k4 == 0) ((float*)(PROJ + ((size_t)MP + bs * 4 + t) * EC))[1152 + h * 64 + row] = y;
            }
            *(f32x4*)(a.out + O_SWKV + ((size_t)sc * 64 + row) * 64 + 4 * k4) = S;
        }
        p0_convert_items(a, (LAS float*)(F.lds + F.wave * 16384), F.lane, P0_I_IN, P0_NITEMS, w, 64 * NWAVES);
    }
}

constexpr int REC_BYTES = 8960, REC_AB = 0, REC_BT = 2048, REC_RB = 4096, REC_PST = 6144, REC_HT = 8192, REC_PC = 8704;
constexpr size_t REC_CHAIN = (size_t)256 * REC_BYTES;
constexpr size_t WS_REQUIRED = WS_END;
static_assert(14 * REC_CHAIN <= (size_t)MPAD * D * 2 && 20 * REC_CHAIN <= (size_t)M * D * 4, "record placement");
__device__ __forceinline__ unsigned char* rec_ptr(unsigned char* ws, float* out, int chain, int ck) {
    const size_t o = (size_t)ck * REC_BYTES;
    if (chain < 14) return ws + WS_BUF0 + (size_t)chain * REC_CHAIN + o;
    if (chain < 28) return ws + WS_BUF1 + (size_t)(chain - 14) * REC_CHAIN + o;
    return (unsigned char*)out + (size_t)(chain - 28) * REC_CHAIN + o;
}
constexpr size_t WS_YS = WS_SQ;
static_assert((size_t)MS * BW * 4 <= (size_t)MS * 3 * 1024 * 4, "YS region");
constexpr int CP_RT = 0, CP_X = 2304, CP_MAB = CP_X + 9216, CP_TT = CP_MAB + 1024, CP_PC = CP_TT + 1024, CP_BYTES = CP_PC + 256;
static_assert(8 * CP_BYTES <= RING_BYTES, "chunk precompute LDS");
typedef short bf16x4 __attribute__((ext_vector_type(4)));
__device__ __forceinline__ f32x4 mfma16k(v2u a, v2u b, f32x4 c) { return __builtin_amdgcn_mfma_f32_16x16x16bf16_1k(__builtin_bit_cast(bf16x4, a), __builtin_bit_cast(bf16x4, b), c, 0, 0, 0); }
__device__ __forceinline__ v2u frag4(f32x4 v) { return (v2u){pk2(v.x, v.y), pk2(v.z, v.w)}; }
__device__ __forceinline__ bf16x8 frag_lo(float x, float y, float z, float w) { return __builtin_bit_cast(bf16x8, (v4u){pk2(x, y), pk2(z, w), 0u, 0u}); }
__device__ __forceinline__ bf16x8 frag_lo4(f32x4 v) { return frag_lo(v.x, v.y, v.z, v.w); }
__device__ __forceinline__ int kpos(int k) { return (k & ~31) | (((k >> 2) & 3) << 3) | (((k >> 4) & 1) << 2) | (k & 3); }

__device__ __forceinline__ void wkv_chunk_core(unsigned char* __restrict__ REC, LAS unsigned char* scr, LAS unsigned char* scm, int lane, const float eLC) {
    const int tl = lane & 15, g4 = lane >> 4, c = lane;
    f32x4 Mab = (f32x4){0.f, 0.f, 0.f, 0.f}, MakT = Mab, Nrb = Mab, Nrk = Mab;
#pragma unroll
    for (int ks = 0; ks < 2; ++ks) {
        const int fo = tl * 144 + 64 * ks + 16 * g4;
        const bf16x8 fA = *(const LAS bf16x8*)(scr + CP_X + 0 * 2304 + fo), fB = *(const LAS bf16x8*)(scr + CP_X + 1 * 2304 + fo), fK = *(const LAS bf16x8*)(scr + CP_X + 2 * 2304 + fo), fR = *(const LAS bf16x8*)(scr + CP_RT + fo);
        Mab = mfma16(fB, fA, Mab);
        MakT = mfma16(fA, fK, MakT);
        Nrb = mfma16(fB, fR, Nrb);
        Nrk = mfma16(fK, fR, Nrk);
    }
#pragma unroll
    for (int i = 0; i < 4; ++i) { const int row = 4 * g4 + i;
        if (!(row < tl)) Mab[i] = 0.f;
        if (!(tl < row)) MakT[i] = 0.f;
        if (!(row <= tl)) { Nrb[i] = 0.f; Nrk[i] = 0.f; } }
    *(LAS f32x4*)(scm + 0 + (tl * 16 + 4 * g4) * 4) = Mab;
    float Trow[16];
#pragma unroll
    for (int t = 0; t < 16; ++t) {
        float acc = (t == tl) ? 1.0f : 0.0f;
        if (t > 0) {
            const LAS float* col = (const LAS float*)(scm + 0 + t * 64);
#pragma unroll
            for (int tp = 0; tp < t; ++tp) acc = fmaf(Trow[tp], col[tp], acc);
        }
        Trow[t] = acc;
    }
#pragma unroll
    for (int t = 0; t < 16; ++t) *(LAS float*)(scm + 1024 + (t * 16 + tl) * 4) = Trow[t];
    const v2u Tf = frag4(*(const LAS f32x4*)(scm + 1024 + (tl * 16 + 4 * g4) * 4));
    {
        unsigned short ra_[16], rb_[16], rk_[16];
#pragma unroll
        for (int t = 0; t < 16; ++t) { ra_[t] = *(const LAS unsigned short*)(scr + CP_X + 0 * 2304 + t * 144 + 2 * c); rb_[t] = *(const LAS unsigned short*)(scr + CP_X + 1 * 2304 + t * 144 + 2 * c);
            rk_[t] = *(const LAS unsigned short*)(scr + CP_X + 2 * 2304 + t * 144 + 2 * c); }
        unsigned wa[8], wb[8], wk[8];
#pragma unroll
        for (int i = 0; i < 8; ++i) { wa[i] = (unsigned)ra_[2 * i] | ((unsigned)ra_[2 * i + 1] << 16);
            wb[i] = pk2(bf2f(rb_[2 * i]) * eLC, bf2f(rb_[2 * i + 1]) * eLC); wk[i] = pk2(bf2f(rk_[2 * i]) * eLC, bf2f(rk_[2 * i + 1]) * eLC); }
        asm volatile("" ::: "memory");
        LAS unsigned char* ra = scr + CP_X + c * 48;
        *(LAS v4u*)(ra) = (v4u){wa[0], wa[1], wa[2], wa[3]}; *(LAS v4u*)(ra + 16) = (v4u){wa[4], wa[5], wa[6], wa[7]};
        *(LAS v4u*)(ra + 3072) = (v4u){wb[0], wb[1], wb[2], wb[3]}; *(LAS v4u*)(ra + 3072 + 16) = (v4u){wb[4], wb[5], wb[6], wb[7]};
        *(LAS v4u*)(ra + 6144) = (v4u){wk[0], wk[1], wk[2], wk[3]}; *(LAS v4u*)(ra + 6144 + 16) = (v4u){wk[4], wk[5], wk[6], wk[7]};
        *(LAS float*)(scm + 2048 + 4 * c) = eLC;
    }
    f32x4 Abar[4];
#pragma unroll
    for (int nt = 0; nt < 4; ++nt) { const v2u w = *(const LAS v2u*)(scr + CP_X + (16 * nt + tl) * 48 + 8 * g4);
        Abar[nt] = mfma16k(Tf, w, (f32x4){0.f, 0.f, 0.f, 0.f}); }
    const v2u fMakT = frag4(MakT), fNrb = frag4(Nrb);
    const f32x4 GT = mfma16k(Tf, fMakT, (f32x4){0.f, 0.f, 0.f, 0.f});
    const v2u fGT = frag4(GT);
    unsigned char* R = REC;
    LAS unsigned char* SB = scm + 2304;
    v2u fAb[4];
#pragma unroll
    for (int kt = 0; kt < 4; ++kt) fAb[kt] = frag4(Abar[kt]);
    {
        const f32x4 Hm = mfma16k(fGT, fNrb, Nrk);
        v2u rbw[4];
#pragma unroll
        for (int kt = 0; kt < 4; ++kt) {
            f32x4 rb = mfma16k(fAb[kt], fNrb, (f32x4){0.f, 0.f, 0.f, 0.f});
            const v2u rw = *(const LAS v2u*)(scr + CP_RT + tl * 144 + 2 * (16 * kt + 4 * g4));
            rb.x += bflo(rw.x); rb.y += bfhi(rw.x); rb.z += bflo(rw.y); rb.w += bfhi(rw.y);
            rbw[kt] = (v2u){pk2(rb.x, rb.y), pk2(rb.z, rb.w)};
        }
        asm volatile("" ::: "memory");
#pragma unroll
        for (int kt = 0; kt < 4; ++kt) *(LAS v2u*)(SB + tl * 128 + 2 * kpos(16 * kt + 4 * g4)) = rbw[kt];
        *(LAS v2u*)(SB + 2048 + tl * 32 + 8 * g4) = (v2u){pk2(Hm.x, Hm.y), pk2(Hm.z, Hm.w)};
        *(v4u*)(R + REC_RB + lane * 16) = *(const LAS v4u*)(SB + lane * 16);
        *(v4u*)(R + REC_RB + 1024 + lane * 16) = *(const LAS v4u*)(SB + 1024 + lane * 16);
        if (lane < 32) *(v4u*)(R + REC_HT + lane * 16) = *(const LAS v4u*)(SB + 2048 + lane * 16);
    }
#pragma unroll
    for (int nt = 0; nt < 4; ++nt) {
        const int pk_ = 2 * kpos(16 * nt + tl);
        const unsigned w01 = pk2(Abar[nt].x, Abar[nt].y), w23 = pk2(Abar[nt].z, Abar[nt].w);
        *(LAS unsigned short*)(SB + (4 * g4 + 0) * 128 + pk_) = (unsigned short)(w01 & 0xffffu); *(LAS unsigned short*)(SB + (4 * g4 + 1) * 128 + pk_) = (unsigned short)(w01 >> 16);
        *(LAS unsigned short*)(SB + (4 * g4 + 2) * 128 + pk_) = (unsigned short)(w23 & 0xffffu); *(LAS unsigned short*)(SB + (4 * g4 + 3) * 128 + pk_) = (unsigned short)(w23 >> 16);
    }
    *(v4u*)(R + REC_AB + lane * 16) = *(const LAS v4u*)(SB + lane * 16);
    *(v4u*)(R + REC_AB + 1024 + lane * 16) = *(const LAS v4u*)(SB + 1024 + lane * 16);
#pragma unroll
    for (int i = 0; i < 2; ++i) { const int p = lane + 64 * i;
        *(v4u*)(R + REC_BT + p * 16) = *(const LAS v4u*)(scr + CP_X + 3072 + (p >> 1) * 48 + (p & 1) * 16); }
    if (lane < 16) *(v4u*)(R + REC_PC + lane * 16) = *(const LAS v4u*)(scm + 2048 + lane * 16);
#pragma unroll
    for (int nt = 0; nt < 4; ++nt) {
        const v2u bw = *(const LAS v2u*)(scr + CP_X + 3072 + (16 * nt + tl) * 48 + 8 * g4);
        f32x4 ps = mfma16k(fGT, bw, (f32x4){0.f, 0.f, 0.f, 0.f});
        const v2u kw = *(const LAS v2u*)(scr + CP_X + 6144 + (16 * nt + tl) * 48 + 8 * g4);
        ps.x += bflo(kw.x); ps.y += bfhi(kw.x); ps.z += bflo(kw.y); ps.w += bfhi(kw.y);
        *(LAS v2u*)(SB + 2048 + nt * 512 + tl * 32 + 8 * g4) = (v2u){pk2(ps.x, ps.y), pk2(ps.z, ps.w)};
    }
    *(v4u*)(R + REC_PST + lane * 16) = *(const LAS v4u*)(SB + 2048 + lane * 16);
    *(v4u*)(R + REC_PST + 1024 + lane * 16) = *(const LAS v4u*)(SB + 2048 + 1024 + lane * 16);
}

constexpr int FZ_L = 0, FZ_LROW = 576, FZ_R = 17 * 576, FZ_RROW = 384, FZ_BYTES = 17 * 960;
constexpr int FZ_TILES = 4096, FZ_SMALL = 0;
static_assert(8 * FZ_BYTES <= RING_BYTES && FZ_TILES + 2304 + 9216 <= FZ_BYTES && FZ_R + 3 * 2048 <= FZ_BYTES, "fused prep LDS");
constexpr size_t WS_AFG = WS_WUP1;
static_assert((size_t)(MP / 16) * 9 * 1024 <= 2 * (size_t)FF * D * 2, "A-fragment cache");
__device__ __forceinline__ void wkv_afrag_task(const Args& a, const bf16* __restrict__ PROJ, const bf16* __restrict__ SHB, v4u* __restrict__ AFG, int grp, int ks, int lane) {
    const int tok = lane & 15, g4 = lane >> 4, ck = grp & 255;
    const size_t m = (size_t)grp * 16 + tok;
    const bf16* cur = PROJ + m * EC + AQKV;
    const bf16* prv = (tok == 0 && ck == 0) ? (SHB + 32 * BCOLS) : (cur - EC);
    const float* mu = a.in[I_EMU];
    const int col = 3 * BW + 32 * ks + 8 * g4;
    const v4u c8 = *(const v4u*)(cur + col), p8 = *(const v4u*)(prv + col);
    const f32x4 m0v = *(const f32x4*)(mu + col), m1v = *(const f32x4*)(mu + col + 4);
    const float cc[8] = {bflo(c8.x), bfhi(c8.x), bflo(c8.y), bfhi(c8.y), bflo(c8.z), bfhi(c8.z), bflo(c8.w), bfhi(c8.w)};
    const float pp[8] = {bflo(p8.x), bfhi(p8.x), bflo(p8.y), bfhi(p8.y), bflo(p8.z), bfhi(p8.z), bflo(p8.w), bfhi(p8.w)};
    const float mm[8] = {m0v.x, m0v.y, m0v.z, m0v.w, m1v.x, m1v.y, m1v.z, m1v.w};
    float v[8];
#pragma unroll
    for (int i = 0; i < 8; ++i) {
        v[i] = cc[i] + (pp[i] - cc[i]) * mm[i];
        const float e = __expf(ks < 2 ? 2.0f * v[i] : -v[i]);
        const float rc = rcpf_(e + 1.0f);
        v[i] = ks < 2 ? (1.0f - 2.0f * rc) : (ks >= 4 ? rc : v[i]);
    }
    AFG[((size_t)grp * 9 + ks) * 64 + lane] = (v4u){pk2(v[0], v[1]), pk2(v[2], v[3]), pk2(v[4], v[5]), pk2(v[6], v[7])};
}
__device__ __forceinline__ void wkv_prep_issue(v4u (&stg)[7], const bf16* __restrict__ PROJ, const bf16* __restrict__ SHB, int chain, int ck, int lane) {
    const int b = chain / 12, h = chain % 12; const size_t m0 = (size_t)b * T + (size_t)ck * 16;
#pragma unroll
    for (int i = 0; i < 7; ++i) { int p = lane + 64 * i; p = p < 408 ? p : 407;
        const int row = p / 24, q = p - row * 24;
        const int col = (q >> 3) * BW + h * 64 + 8 * (q & 7);
        const bf16* src = (row == 0 && ck == 0) ? (SHB + 32 * BCOLS) : (PROJ + (m0 - 1 + row) * EC + AQKV);
        stg[i] = *(const v4u*)(src + col); }
}
template <int NOCORE>
__device__ __forceinline__ void wkv_prep_chunk(const Args& a, v4u (&stg)[7], const v4u* __restrict__ AFG, const bf16* __restrict__ PROJ, const bf16* __restrict__ LW, const bf16* __restrict__ SHB, unsigned char* PREP, unsigned char* REC,
                                               LAS unsigned char* area, int chain, int ck, int nchain, int nck, int lane_in) {
    int lane = lane_in; asm volatile("" : "+v"(lane)); __builtin_assume(lane >= 0 && lane < 64);
    const int tok = lane & 15, g4 = lane >> 4, b = chain / 12, h = chain % 12;
    const size_t m0 = (size_t)b * T + (size_t)ck * 16;
#pragma unroll
    for (int i = 0; i < 7; ++i) { int p = lane + 64 * i; p = p < 408 ? p : 407; const int row = p / 24, q = p - row * 24;
        *(LAS v4u*)(area + FZ_R + row * FZ_RROW + q * 16) = stg[i]; }
    asm volatile("" ::: "memory");
    wkv_prep_issue(stg, PROJ, SHB, nchain, nck, lane);
    const float* mu = a.in[I_EMU];
    bf16x8 af[9];
#pragma unroll
    for (int ks = 0; ks < 9; ++ks) af[ks] = __builtin_bit_cast(bf16x8, AFG[((size_t)(b * 256 + ck) * 9 + ks) * 64 + lane]);
    const LAS unsigned char* curR = area + FZ_R + (tok + 1) * FZ_RROW;
#define FZ_XS4(which, cl_) ({ const v2u c4_ = *(const LAS v2u*)(curR + 128 * (which) + 2 * (cl_)), p4_ = *(const LAS v2u*)(curR - FZ_RROW + 128 * (which) + 2 * (cl_)); \
        const f32x4 cv_ = (f32x4){bflo(c4_.x), bfhi(c4_.x), bflo(c4_.y), bfhi(c4_.y)}, pv_ = (f32x4){bflo(p4_.x), bfhi(p4_.x), bflo(p4_.y), bfhi(p4_.y)}; \
        cv_ + (pv_ - cv_) * *(const f32x4*)(mu + (which) * BW + h * 64 + (cl_)); })
    const float* k_k = a.in[I_EKK];
    f32x4 kr[4];
    float ssq = 0.f;
#pragma unroll
    for (int nt = 0; nt < 4; ++nt) {
        const int cl = 16 * nt + 4 * g4;
        kr[nt] = FZ_XS4(1, cl);
        const f32x4 kkr = kr[nt] * *(const f32x4*)(k_k + h * 64 + cl);
        ssq += (kkr.x * kkr.x + kkr.y * kkr.y) + (kkr.z * kkr.z + kkr.w * kkr.w);
    }
    ssq += __shfl_xor(ssq, 16); ssq += __shfl_xor(ssq, 32);
    const float kinv = rcpf_(fmaxf(__builtin_amdgcn_sqrtf(ssq), 1e-12f));
    v2u pk_kk[4], pk_b[4], pk_ew[4];
    LAS unsigned char* tbw = area + tok * 128 + 8 * g4;
#pragma unroll
    for (int nt = 0; nt < 4; ++nt) {
        const bf16* lwp = LW + (size_t)(h * 64 + 16 * nt + tok) * LORA + 8 * g4;
        f32x4 aw = (f32x4){0.f, 0.f, 0.f, 0.f}, aa = aw, ag = aw;
        if (!(NOCORE & 2)) {
#pragma unroll
        for (int ks = 0; ks < 9; ++ks) { const bf16x8 bw = *(const bf16x8*)(lwp + 32 * ks);
            if (ks < 2) aw = mfma16(bw, af[ks], aw); else if (ks < 4) aa = mfma16(bw, af[ks], aa); else ag = mfma16(bw, af[ks], ag); }
        } else { aw = __builtin_bit_cast(f32x4, af[nt]); aa = __builtin_bit_cast(f32x4, af[nt + 4]); ag = aw; }
        const int cl = 16 * nt + 4 * g4, c4 = h * 64 + cl;
        const f32x4 w0 = *(const f32x4*)(a.in[I_EW0] + c4), a0 = *(const f32x4*)(a.in[I_EA0] + c4), kkc = *(const f32x4*)(k_k + c4), kac = *(const f32x4*)(a.in[I_EKA] + c4);
        f32x4 ew, av, kk, kp, bb;
#pragma unroll
        for (int i = 0; i < 4; ++i) {
            const float z = -(w0[i] + aw[i]);
            if (!(NOCORE & 4)) {
            const float sp = fmaxf(z, 0.f) + __logf(1.0f + __expf(-fabsf(z)));
            ew[i] = __expf(-sp - 0.5f);
            av[i] = sigmoidf_(a0[i] + aa[i]);
            } else { ew[i] = z; av[i] = a0[i] + aa[i]; }
            kk[i] = kr[nt][i] * kkc[i] * kinv;
            kp[i] = kr[nt][i] * (1.0f + (av[i] - 1.0f) * kac[i]);
            bb[i] = kk[i] * av[i];
        }
        const f32x4 rr4 = FZ_XS4(0, cl), vr4 = FZ_XS4(2, cl);
        *(LAS v2u*)(tbw + 0 * 2048 + 32 * nt) = (v2u){pk2(rr4.x, rr4.y), pk2(rr4.z, rr4.w)};
        *(LAS v2u*)(tbw + 1 * 2048 + 32 * nt) = (v2u){pk2(kp.x, kp.y), pk2(kp.z, kp.w)};
        *(LAS v2u*)(tbw + 2 * 2048 + 32 * nt) = (v2u){pk2(vr4.x, vr4.y), pk2(vr4.z, vr4.w)};
        *(LAS v2u*)(tbw + 3 * 2048 + 32 * nt) = (v2u){pk2(ag.x, ag.y), pk2(ag.z, ag.w)};
        pk_kk[nt] = (v2u){pk2(kk.x, kk.y), pk2(kk.z, kk.w)};
        pk_b[nt] = (v2u){pk2(bb.x, bb.y), pk2(bb.z, bb.w)};
        pk_ew[nt] = (v2u){pk2(ew.x, ew.y), pk2(ew.z, ew.w)};
        asm volatile("" ::: "memory");
    }
#undef FZ_XS4
    {
        LAS unsigned char* tbr = area + FZ_R + tok * 128 + 8 * g4;
#pragma unroll
        for (int nt = 0; nt < 4; ++nt) { *(LAS v2u*)(tbr + 0 * 2048 + 32 * nt) = pk_kk[nt]; *(LAS v2u*)(tbr + 1 * 2048 + 32 * nt) = pk_b[nt]; *(LAS v2u*)(tbr + 2 * 2048 + 32 * nt) = pk_ew[nt]; }
    }
#pragma unroll
    for (int sI = 0; sI < 4; ++sI) { const int tt = 4 * sI + (lane >> 4);
        unsigned char* Et = PREP + ((size_t)chain * T + (size_t)ck * 16 + tt) * 1024 + 8 * (lane & 15);
        const LAS unsigned char* tbs = area + tt * 128 + 8 * (lane & 15);
        if (!(NOCORE & 16)) { *(v2u*)(Et + 0) = *(const LAS v2u*)(tbs + 0 * 2048); *(v2u*)(Et + 128) = *(const LAS v2u*)(tbs + 1 * 2048);
        *(v2u*)(Et + 256) = *(const LAS v2u*)(tbs + 2 * 2048); *(v2u*)(Et + 640) = *(const LAS v2u*)(tbs + 3 * 2048); } }
    const int c = lane;
    float eLCv = 1.f;
    if (!(NOCORE & 8)) {
        unsigned short s_r[16], s_kp[16], s_kk[16], s_b[16], s_ew[16];
        const LAS unsigned short* t_r = (const LAS unsigned short*)(area + 0 * 2048) + c; const LAS unsigned short* t_kp = (const LAS unsigned short*)(area + 1 * 2048) + c;
        const LAS unsigned short* t_kk = (const LAS unsigned short*)(area + FZ_R + 0 * 2048) + c; const LAS unsigned short* t_b = (const LAS unsigned short*)(area + FZ_R + 1 * 2048) + c;
        const LAS unsigned short* t_ew = (const LAS unsigned short*)(area + FZ_R + 2 * 2048) + c;
#pragma unroll
        for (int t = 0; t < 16; ++t) { s_r[t] = t_r[t * 64]; s_kp[t] = t_kp[t * 64]; s_kk[t] = t_kk[t * 64]; s_b[t] = t_b[t * 64]; s_ew[t] = t_ew[t * 64]; }
        asm volatile("" ::: "memory");
        LAS unsigned char* scr0 = area + FZ_TILES;
        float L = 0.f;
#pragma unroll
        for (int t = 0; t < 16; ++t) {
            const float eprev = __expf(L);
            L -= bf2f(s_ew[t]);
            const float e = __expf(L), einv = rcpf_(e);
            *(LAS unsigned short*)(scr0 + CP_X + 0 * 2304 + t * 144 + 2 * c) = (unsigned short)f2bf(-bf2f(s_kk[t]) * eprev);
            *(LAS unsigned short*)(scr0 + CP_X + 1 * 2304 + t * 144 + 2 * c) = (unsigned short)f2bf(bf2f(s_b[t]) * einv);
            *(LAS unsigned short*)(scr0 + CP_X + 2 * 2304 + t * 144 + 2 * c) = (unsigned short)f2bf(bf2f(s_kp[t]) * einv);
            *(LAS unsigned short*)(scr0 + CP_RT + t * 144 + 2 * c) = (unsigned short)f2bf(bf2f(s_r[t]) * e);
        }
        eLCv = __expf(L);
    }
    LAS unsigned char* scr = area + FZ_TILES;
    if (!(NOCORE & 1)) wkv_chunk_core(REC, scr, area + FZ_SMALL, lane, eLCv); else if (eLCv == 12345.678f) *(float*)REC = eLCv;
}

constexpr int SQ_D = 10, SQ_SLOT = 11264, SQ_YST = SQ_D * SQ_SLOT, SQ_LOOK = SQ_D / 2 - 1;
static_assert(SQ_YST + 4 * 4096 <= RING_BYTES, "sequential pass LDS");
__device__ __forceinline__ void wkv_seq_issue(LAS unsigned char* slot, const unsigned char* R, const unsigned char* E0, int lw, int lane) {
#pragma unroll
    for (int i = 0; i < 3; ++i) {
        int q = lw * 3 + i; q = q > 10 ? 9 : q;
        const unsigned char* src;
        if (q < 2 || q == 4 || q == 5) { const int row = 8 * (q & 1) + (lane >> 3), pc = (lane & 7) ^ (row & 7); src = R + (q < 2 ? REC_AB : REC_RB) + row * 128 + pc * 16; }
        else if (q < 4) src = R + REC_BT + (q - 2) * 1024 + lane * 16;
        else if (q < 8) src = R + REC_PST + (q - 6) * 1024 + lane * 16;
        else if (q == 8) src = R + REC_HT + (lane < 48 ? lane : 47) * 16;
        else src = E0 + (size_t)(8 * (q - 9) + (lane >> 3)) * 1024 + 256 + (lane & 7) * 16;
        __builtin_amdgcn_global_load_lds((const unsigned*)src, (LAS unsigned*)(slot + q * 1024), 16, 0, 0);
    }
}
struct SeqOps { bf16x8 rb0, rb1, ab0, ab1; v2u hw; unsigned v0, v1, v2, v3; f32x4 pc0, pc1, pc2, pc3; v2u bw0, bw1, bw2, bw3, pw0, pw1, pw2, pw3; };
__device__ __forceinline__ void wkv_seq_load(SeqOps& o, const LAS unsigned char* buf, int w, int tl, int g4) {
    const LAS unsigned short* vp = (const LAS unsigned short*)(buf + 9 * 1024) + (4 * g4) * 64 + 16 * w + tl;
    const int swz = (tl >> 3) * 1024 + (tl & 7) * 128, po0 = ((g4) ^ (tl & 7)) << 4, po1 = ((4 + g4) ^ (tl & 7)) << 4;
    o.ab0 = *(const LAS bf16x8*)(buf + swz + po0); o.ab1 = *(const LAS bf16x8*)(buf + swz + po1);
    o.rb0 = *(const LAS bf16x8*)(buf + 4096 + swz + po0); o.rb1 = *(const LAS bf16x8*)(buf + 4096 + swz + po1);
    o.hw = *(const LAS v2u*)(buf + 8192 + tl * 32 + 8 * g4);
    o.v0 = vp[0]; o.v1 = vp[64]; o.v2 = vp[128]; o.v3 = vp[192];
    o.pc0 = *(const LAS f32x4*)(buf + 8192 + 512 + 4 * (0 + 4 * g4)); o.pc1 = *(const LAS f32x4*)(buf + 8192 + 512 + 4 * (16 + 4 * g4));
    o.pc2 = *(const LAS f32x4*)(buf + 8192 + 512 + 4 * (32 + 4 * g4)); o.pc3 = *(const LAS f32x4*)(buf + 8192 + 512 + 4 * (48 + 4 * g4));
    o.bw0 = *(const LAS v2u*)(buf + 2048 + (0 + tl) * 32 + 8 * g4); o.bw1 = *(const LAS v2u*)(buf + 2048 + (16 + tl) * 32 + 8 * g4);
    o.bw2 = *(const LAS v2u*)(buf + 2048 + (32 + tl) * 32 + 8 * g4); o.bw3 = *(const LAS v2u*)(buf + 2048 + (48 + tl) * 32 + 8 * g4);
    o.pw0 = *(const LAS v2u*)(buf + 6144 + (0 + tl) * 32 + 8 * g4); o.pw1 = *(const LAS v2u*)(buf + 6144 + (16 + tl) * 32 + 8 * g4);
    o.pw2 = *(const LAS v2u*)(buf + 6144 + (32 + tl) * 32 + 8 * g4); o.pw3 = *(const LAS v2u*)(buf + 6144 + (48 + tl) * 32 + 8 * g4);
}
__device__ __forceinline__ void wkv_seq_math(f32x4 (&S)[4], const SeqOps& o, LAS unsigned char* ystage, int w, int tl, int g4) {
    const bf16x8 sf0 = __builtin_bit_cast(bf16x8, (v4u){pk2(S[0].x, S[0].y), pk2(S[0].z, S[0].w), pk2(S[1].x, S[1].y), pk2(S[1].z, S[1].w)});
    const bf16x8 sf1 = __builtin_bit_cast(bf16x8, (v4u){pk2(S[2].x, S[2].y), pk2(S[2].z, S[2].w), pk2(S[3].x, S[3].y), pk2(S[3].z, S[3].w)});
    const v2u vf = (v2u){o.v0 | (o.v1 << 16), o.v2 | (o.v3 << 16)};
    f32x4 z = mfma16(o.ab0, sf0, (f32x4){0.f, 0.f, 0.f, 0.f});
    f32x4 y = mfma16(o.rb0, sf0, (f32x4){0.f, 0.f, 0.f, 0.f});
    z = mfma16(o.ab1, sf1, z);
    y = mfma16(o.rb1, sf1, y);
    f32x4 s0 = S[0] * o.pc0, s1 = S[1] * o.pc1, s2 = S[2] * o.pc2, s3 = S[3] * o.pc3;
    s0 = mfma16k(o.pw0, vf, s0); s1 = mfma16k(o.pw1, vf, s1); s2 = mfma16k(o.pw2, vf, s2); s3 = mfma16k(o.pw3, vf, s3);
    y = mfma16k(o.hw, vf, y);
    const v2u zf = (v2u){pk2(z.x, z.y), pk2(z.z, z.w)};
    S[0] = mfma16k(o.bw0, zf, s0); S[1] = mfma16k(o.bw1, zf, s1); S[2] = mfma16k(o.bw2, zf, s2); S[3] = mfma16k(o.bw3, zf, s3);
    const unsigned y01 = pk2(y.x, y.y), y23 = pk2(y.z, y.w);
    LAS unsigned short* yp = (LAS unsigned short*)(ystage + (4 * g4) * 128 + 2 * (16 * w + tl));
    yp[0] = (unsigned short)y01; yp[64] = (unsigned short)(y01 >> 16); yp[128] = (unsigned short)y23; yp[192] = (unsigned short)(y23 >> 16);
}
template <int ONLYCHAINS>
__device__ __forceinline__ void wkv_phase2(const Args& a, Frame& F, unsigned char* PREP, float* YS) {
    if (F.bid < 48) {
        const int chain = F.bid;
        unsigned char* Eb = PREP + (size_t)chain * T * 1024;
        unsigned* prog = (unsigned*)(a.ws + WS_CTL) + CW_PROG + 16 * chain;
        if (F.wave >= 4) {
            const int lw = F.wave - 4;
#pragma unroll
            for (int j = 0; j < 2 * SQ_LOOK; ++j) if (!(ONLYCHAINS & 2)) wkv_seq_issue(F.lds + j * SQ_SLOT, rec_ptr(a.ws, a.out, chain, j), Eb + (size_t)j * 16 * 1024, lw, F.lane);
            asm volatile("s_waitcnt vmcnt(%0)" :: "n"(6 * (SQ_LOOK - 2)) : "memory");
            __builtin_amdgcn_s_barrier();
            for (int p = 0; p < 128; ++p) {
                if (p > 0 && !(ONLYCHAINS & 8)) {
                    const int e = lw >> 1, hf = lw & 1, ck = 2 * (p - 1) + e;
                    const v4u yv = *(const LAS v4u*)(F.lds + SQ_YST + (((p - 1) & 1) * 2 + e) * 4096 + hf * 1024 + F.lane * 16);
                    *(v4u*)(Eb + ((size_t)ck * 16 + 8 * hf + (F.lane >> 3)) * 1024 + 384 + 16 * (F.lane & 7)) = yv; }
                if (lw == 0 && F.lane == 0) __hip_atomic_store(prog, (unsigned)(2 * p), __ATOMIC_RELAXED, __HIP_MEMORY_SCOPE_AGENT);
#pragma unroll
                for (int e = 0; e < 2; ++e) { int cn = 2 * (p + SQ_LOOK) + e; cn = cn < 256 ? cn : 255;
                    if (!(ONLYCHAINS & 2)) wkv_seq_issue(F.lds + ((2 * (p + SQ_LOOK) + e) % SQ_D) * SQ_SLOT, rec_ptr(a.ws, a.out, chain, cn), Eb + (size_t)cn * 16 * 1024, lw, F.lane); }
                asm volatile("s_waitcnt vmcnt(%0)" :: "n"(6 * (SQ_LOOK - 2)) : "memory");
                __builtin_amdgcn_s_barrier();
            }
            { const int e = lw >> 1, hf = lw & 1, ck = 254 + e;
                const v4u yv = *(const LAS v4u*)(F.lds + SQ_YST + ((127 & 1) * 2 + e) * 4096 + hf * 1024 + F.lane * 16);
                *(v4u*)(Eb + ((size_t)ck * 16 + 8 * hf + (F.lane >> 3)) * 1024 + 384 + 16 * (F.lane & 7)) = yv; }
            asm volatile("s_waitcnt vmcnt(0)" ::: "memory");
        } else {
            const int w = F.wave, tl = F.lane & 15, g4 = F.lane >> 4;
            f32x4 S[4];
#pragma unroll
            for (int i = 0; i < 4; ++i) S[i] = (f32x4){0.f, 0.f, 0.f, 0.f};
            __builtin_amdgcn_s_barrier();
            SeqOps oa, ob;
            wkv_seq_load(oa, F.lds, w, tl, g4);
            for (int p = 0; p < 128; ++p) {
                if (!(ONLYCHAINS & 4)) {
                asm volatile("s_waitcnt lgkmcnt(0)" ::: "memory");
                wkv_seq_load(ob, F.lds + ((2 * p + 1) % SQ_D) * SQ_SLOT, w, tl, g4);
                __builtin_amdgcn_sched_barrier(0);
                wkv_seq_math(S, oa, F.lds + SQ_YST + ((p & 1) * 2 + 0) * 4096, w, tl, g4);
                __builtin_amdgcn_sched_barrier(0);
                asm volatile("s_waitcnt lgkmcnt(0)" ::: "memory");
                wkv_seq_load(oa, F.lds + ((2 * p + 2) % SQ_D) * SQ_SLOT, w, tl, g4);
                __builtin_amdgcn_sched_barrier(0);
                wkv_seq_math(S, ob, F.lds + SQ_YST + ((p & 1) * 2 + 1) * 4096, w, tl, g4);
                __builtin_amdgcn_sched_barrier(0); }
                asm volatile("s_waitcnt lgkmcnt(0)" ::: "memory");
                __builtin_amdgcn_s_barrier();
            }
#pragma unroll
            for (int kt = 0; kt < 4; ++kt) *(f32x4*)(a.out + O_PWKV + ((size_t)chain * 64 + 16 * w + tl) * 64 + 16 * kt + 4 * g4) = S[kt];
        }
    } else if (!(ONLYCHAINS & 1) || (ONLYCHAINS & 16)) {
        if (F.bid < 192 && F.wave < 4) {
            const int chain = F.bid % 48, k = F.bid / 48 - 1, hw = F.wave;
            const unsigned* prog = (const unsigned*)(a.ws + WS_CTL) + CW_PROG + 16 * chain;
            const unsigned char* Eb = PREP + (size_t)chain * T * 1024;
            for (int g = k; g < 64; g += 3) {
                const int ck = 4 * g + hw;
                for (unsigned sp = 0; sp < 20000u; ++sp) {
                    const unsigned pr = (unsigned)__builtin_amdgcn_readfirstlane((int)__hip_atomic_load(prog, __ATOMIC_RELAXED, __HIP_MEMORY_SCOPE_AGENT));
                    if ((int)pr + 24 >= ck) break;
                    __builtin_amdgcn_s_sleep(8);
                }
                const unsigned char* R = rec_ptr(a.ws, a.out, chain, ck);
                v4u x[11];
#pragma unroll
                for (int i = 0; i < 9; ++i) { int pz = F.lane + 64 * i; pz = pz < 560 ? pz : 559; x[i] = *(const v4u*)(R + (size_t)pz * 16); }
#pragma unroll
                for (int i = 0; i < 2; ++i) x[9 + i] = *(const v4u*)(Eb + ((size_t)ck * 16 + 8 * i + (F.lane >> 3)) * 1024 + 256 + (F.lane & 7) * 16);
#pragma unroll
                for (int i = 0; i < 11; ++i) asm volatile("" :: "v"(x[i].x), "v"(x[i].y), "v"(x[i].z), "v"(x[i].w));
            }
        } else if (!(ONLYCHAINS & 16)) {
        const int w = (F.bid < 192) ? ((F.bid - 48) * 4 + (F.wave - 4)) : (144 * 4 + (F.bid - 192) * NWAVES + F.wave); const int k4 = F.lane & 15;
        constexpr int NW_OTHER = 144 * 4 + 64 * NWAVES;
        for (int st = w; st < 384 * 16; st += NW_OTHER) {
            const int sc = st >> 4, rg = st & 15, row = 4 * rg + (F.lane >> 4), bs = sc / 12, h = sc % 12;
            f32x4 S = *(const f32x4*)(a.in[I_SWKV] + ((size_t)sc * 64 + row) * 64 + 4 * k4);
#pragma unroll
            for (int t = 0; t < 4; ++t) {
                const unsigned char* E = PREP + ((size_t)48 * T + (size_t)sc * 4 + t) * 1024;
                f32x4 d = ld_bf4(E + 768 + 8 * k4); d.x = __expf(-d.x); d.y = __expf(-d.y); d.z = __expf(-d.z); d.w = __expf(-d.w);
                const f32x4 kk = ld_bf4(E + 384 + 8 * k4), bb = ld_bf4(E + 512 + 8 * k4), kp = ld_bf4(E + 128 + 8 * k4), r = ld_bf4(E + 8 * k4);
                const float v = bf2f(*(const bf16*)(E + 256 + 2 * row));
                const float y = wkv_step(S, d, kk, bb, kp, r, v);
                if (k4 == 0) YS[((size_t)bs * 4 + t) * BW + h * 64 + row] = y;
            }
            *(f32x4*)(a.out + O_SWKV + ((size_t)sc * 64 + row) * 64 + 4 * k4) = S;
        }
        p0_convert_items(a, (LAS float*)(F.lds + F.wave * 16384), F.lane, P0_I_IN, P0_NITEMS, w, NW_OTHER);
        }
    }
}

__device__ __forceinline__ void mix_phase(const Args& a, Frame& F, const unsigned char* PREP, const float* YS, const bf16* ATTO, const float* LSE, bf16* MIX) {
    const int u = F.lane >> 4, cq = F.lane & 15;
    for (int m = F.gw; m < M; m += NGW) {
        bf16* orow = MIX + (size_t)m * D;
        size_t e0; int es;
        if (m < MP) { e0 = (size_t)((m >> 12) * 12) * T + (m & (T - 1)); es = T; } else { const int s = m - MP; e0 = (size_t)48 * T + (size_t)((s >> 2) * 12) * 4 + (s & 3); es = 4; }
#pragma unroll
        for (int it = 0; it < 3; ++it) {
            const int h = 4 * it + u, c = h * 64 + 4 * cq;
            const unsigned char* E = PREP + (e0 + (size_t)h * es) * 1024 + 8 * cq;
            const f32x4 y = (m < MP) ? ld_bf4(E + 384) : *(const f32x4*)(YS + (size_t)(m - MP) * BW + c);
            const f32x4 r = ld_bf4(E), kp = ld_bf4(E + 128), v = ld_bf4(E + 256), g = ld_bf4(E + 640);
            const f32x4 lw = *(const f32x4*)(a.in[I_ELNW] + c), lb = *(const f32x4*)(a.in[I_ELNB] + c), rk = *(const f32x4*)(a.in[I_ERK] + c);
            const float mean = row16_sum((y.x + y.y) + (y.z + y.w)) * (1.0f / 64.0f);
            const f32x4 dy = y - mean;
            const float var = row16_sum((dy.x * dy.x + dy.y * dy.y) + (dy.z * dy.z + dy.w * dy.w)) * (1.0f / 64.0f);
            const float rs = __builtin_amdgcn_rsqf(var + LNX_EPS);
            const f32x4 rkk = r * kp * rk;
            const float bsum = row16_sum((rkk.x + rkk.y) + (rkk.z + rkk.w));
            const f32x4 o = (dy * rs * lw + lb + v * bsum) * g;
            *(v2u*)(orow + 256 + c) = (v2u){pk2(o.x, o.y), pk2(o.z, o.w)};
        }
        {
            const int hs = u, c = hs * 64 + 4 * cq;
            const float l0 = LSE[((size_t)0 * M + m) * 4 + hs], l1 = LSE[((size_t)1 * M + m) * 4 + hs], l2 = LSE[((size_t)2 * M + m) * 4 + hs];
            const f32x4 a0 = ld_bf4((const unsigned char*)(ATTO + ((size_t)0 * M + m) * 256 + c)), a1 = ld_bf4((const unsigned char*)(ATTO + ((size_t)1 * M + m) * 256 + c)), a2 = ld_bf4((const unsigned char*)(ATTO + ((size_t)2 * M + m) * 256 + c));
            const float mx = fmaxf(l0, fmaxf(l1, l2));
            const float w0 = __builtin_amdgcn_exp2f(l0 - mx), w1 = __builtin_amdgcn_exp2f(l1 - mx), w2 = __builtin_amdgcn_exp2f(l2 - mx);
            const float inv = rcpf_(w0 + w1 + w2);
            const f32x4 o = (a0 * w0 + a1 * w1 + a2 * w2) * inv;
            *(v2u*)(orow + c) = (v2u){pk2(o.x, o.y), pk2(o.z, o.w)};
        }
    }
}

constexpr int HG_QROW = 272, HG_TROW = 40;
constexpr int HG_QE = 0, HG_KE = 16 * HG_QROW, HG_KDT = 2 * 16 * HG_QROW, HG_VT = HG_KDT + 128 * HG_TROW, HG_EBL = HG_VT + 128 * HG_TROW, HG_GS = HG_EBL + 512, HG_BUF = HG_GS + 2048;
constexpr int HG_BASE = 16384;
constexpr size_t WS_O = WS_B;
constexpr size_t WS_XCH = WS_B + (size_t)80 * MiB;
constexpr size_t WS_XP = WS_XCH + (size_t)256 * 65536;
static_assert(WS_O + (size_t)M * D * 4 <= WS_XCH && WS_XP + 256 * 512 <= WS_END, "region B (layer 1)");

template <bool FULL>
__device__ __forceinline__ void hgrn_chunks(Frame& F, const bf16* __restrict__ PC, const float* __restrict__ LB, float* __restrict__ O, f32x4 (&S)[8], float& Lsum, int b, int h, int seg) {
    const int tid = F.tid, c = tid & 127, j = tid >> 7, w = F.wave, tl = F.lane & 15, g4 = F.lane >> 4;
    const int pos = (c & ~31) | (((c >> 2) & 3) << 3) | (((c >> 4) & 1) << 2) | (c & 3);
    const float lb = LB[h * 128 + c];
    const size_t mseg = (size_t)b * T + (size_t)seg * 512;
    const bf16* prow = PC + (mseg + 4 * j) * CC + h * 128 + c;
    unsigned short fw[4], iw[4], qw[4], fn[4], in_[4], qn[4];
#pragma unroll
    for (int i = 0; i < 4; ++i) { fn[i] = prow[(size_t)i * CC + 1024]; in_[i] = prow[(size_t)i * CC + 2048]; qn[i] = FULL ? prow[(size_t)i * CC] : (unsigned short)0; }
    for (int n = 0; n < 32; ++n) {
        LAS unsigned char* buf = F.lds + HG_BASE + (n & 1) * HG_BUF;
#pragma unroll
        for (int i = 0; i < 4; ++i) { fw[i] = fn[i]; iw[i] = in_[i]; qw[i] = qn[i]; }
        if (n + 1 < 32) { const bf16* pn = prow + (size_t)(n + 1) * 16 * CC;
#pragma unroll
            for (int i = 0; i < 4; ++i) { fn[i] = pn[(size_t)i * CC + 1024]; in_[i] = pn[(size_t)i * CC + 2048]; if (FULL) qn[i] = pn[(size_t)i * CC]; } }
        float fg[4], pre[4]; float loc = 0.f;
#pragma unroll
        for (int i = 0; i < 4; ++i) { fg[i] = lb + (1.0f - lb) * sigmoidf_(bf2f(fw[i])); loc += __logf(fg[i]); pre[i] = loc; }
        LAS float* GS = (LAS float*)(buf + HG_GS);
        GS[j * 128 + c] = loc;
        __syncthreads();
        const float g0 = GS[c], g1 = GS[128 + c], g2 = GS[256 + c], g3 = GS[384 + c];
        const float off = (j > 0 ? g0 : 0.f) + (j > 1 ? g1 : 0.f) + (j > 2 ? g2 : 0.f);
        const float tot = (g0 + g1) + (g2 + g3);
        const float ebl = __expf(tot);
        Lsum += tot;
        float kd[4];
#pragma unroll
        for (int i = 0; i < 4; ++i) {
            const float bt = off + pre[i];
            const float eb = __expf(bt), en = rcpf_(eb);
            const float ke = (1.0f - fg[i]) * en;
            kd[i] = ke * ebl;
            if (FULL) {
                const float qe = siluf_(bf2f(qw[i])) * eb;
                *(LAS unsigned short*)(buf + HG_QE + (4 * j + i) * HG_QROW + 2 * pos) = (unsigned short)f2bf(qe);
                *(LAS unsigned short*)(buf + HG_KE + (4 * j + i) * HG_QROW + 2 * pos) = (unsigned short)f2bf(ke);
            }
        }
        *(LAS v2u*)(buf + HG_KDT + c * HG_TROW + 8 * j) = (v2u){pk2(kd[0], kd[1]), pk2(kd[2], kd[3])};
        *(LAS v2u*)(buf + HG_VT + c * HG_TROW + 8 * j) = (v2u){(unsigned)iw[0] | ((unsigned)iw[1] << 16), (unsigned)iw[2] | ((unsigned)iw[3] << 16)};
        if (j == 0) *(LAS float*)(buf + HG_EBL + 4 * c) = ebl;
        __syncthreads();
        const v2u vv = *(const LAS v2u*)(buf + HG_VT + (16 * w + tl) * HG_TROW + 8 * g4);
        const v2u vf = vv;
        if (FULL) {
            bf16x8 qf[4];
#pragma unroll
            for (int ks = 0; ks < 4; ++ks) qf[ks] = *(const LAS bf16x8*)(buf + HG_QE + tl * HG_QROW + 64 * ks + 16 * g4);
            f32x4 att = (f32x4){0.f, 0.f, 0.f, 0.f};
#pragma unroll
            for (int ks = 0; ks < 4; ++ks) att = mfma16(*(const LAS bf16x8*)(buf + HG_KE + tl * HG_QROW + 64 * ks + 16 * g4), qf[ks], att);
            if (4 * g4 + 0 > tl) att.x = 0.f;
            if (4 * g4 + 1 > tl) att.y = 0.f;
            if (4 * g4 + 2 > tl) att.z = 0.f;
            if (4 * g4 + 3 > tl) att.w = 0.f;
            const v2u pB = (v2u){pk2(att.x, att.y), pk2(att.z, att.w)};
            f32x4 o = (f32x4){0.f, 0.f, 0.f, 0.f};
#pragma unroll
            for (int ks = 0; ks < 4; ++ks) {
                const bf16x8 sf = __builtin_bit_cast(bf16x8, (v4u){pk2(S[2 * ks].x, S[2 * ks].y), pk2(S[2 * ks].z, S[2 * ks].w), pk2(S[2 * ks + 1].x, S[2 * ks + 1].y), pk2(S[2 * ks + 1].z, S[2 * ks + 1].w)});
                o = mfma16(sf, qf[ks], o);
            }
            o = mfma16k(vf, pB, o);
            *(f32x4*)(O + (mseg + (size_t)n * 16 + tl) * D + h * 128 + 16 * w + 4 * g4) = o;
        }
#pragma unroll
        for (int kt = 0; kt < 8; ++kt) {
            const v2u kw = *(const LAS v2u*)(buf + HG_KDT + (16 * kt + tl) * HG_TROW + 8 * g4);
            const f32x4 e4 = *(const LAS f32x4*)(buf + HG_EBL + 4 * (16 * kt + 4 * g4));
            S[kt] = S[kt] * e4;
            S[kt] = mfma16k(kw, vf, S[kt]);
        }
    }
}

template <class BarT>
__device__ __forceinline__ void hgrn_fused(const Args& a, Frame& F, const bf16* __restrict__ PC, unsigned char* ws, const BarT& bar) {
    const float* LB = (const float*)(ws + WS_TAB + 8192);
    float* O = (float*)(ws + WS_O);
    {
        const int bs = F.bid >> 3, h = F.bid & 7;
        LAS float* Lq = (LAS float*)F.lds; LAS float* Lf = Lq + 512; LAS float* Lv = Lf + 512; LAS float* Lr = Lv + 512;
        { const int t = F.tid >> 7, k = F.tid & 127; const bf16* pr = PC + ((size_t)MP + bs * 4 + t) * CC + h * 128 + k; const float lb = LB[h * 128 + k];
          Lq[F.tid] = siluf_(bf2f(pr[0])); Lf[F.tid] = lb + (1.0f - lb) * sigmoidf_(bf2f(pr[1024])); Lv[F.tid] = bf2f(pr[2048]); }
        __syncthreads();
        const int v = F.tid & 127, kq = F.tid >> 7;
        float o0 = 0.f, o1 = 0.f, o2 = 0.f, o3 = 0.f;
        const float v0 = Lv[v], v1 = Lv[128 + v], v2 = Lv[256 + v], v3 = Lv[384 + v];
        const size_t sbase = ((size_t)(bs * 8 + h) * 128) * 128;
        for (int kk = 0; kk < 32; ++kk) { const int k = 32 * kq + kk;
            float s = a.in[I_SC][sbase + (size_t)k * 128 + v];
            float fg;
            fg = Lf[k]; s = fg * s + (1.0f - fg) * v0; o0 += Lq[k] * s;
            fg = Lf[128 + k]; s = fg * s + (1.0f - fg) * v1; o1 += Lq[128 + k] * s;
            fg = Lf[256 + k]; s = fg * s + (1.0f - fg) * v2; o2 += Lq[256 + k] * s;
            fg = Lf[384 + k]; s = fg * s + (1.0f - fg) * v3; o3 += Lq[384 + k] * s;
            a.out[O_SC + sbase + (size_t)k * 128 + v] = s; }
        Lr[(kq * 4 + 0) * 128 + v] = o0; Lr[(kq * 4 + 1) * 128 + v] = o1; Lr[(kq * 4 + 2) * 128 + v] = o2; Lr[(kq * 4 + 3) * 128 + v] = o3;
        __syncthreads();
        { const int t = F.tid >> 7, vv = F.tid & 127; const float o = Lr[(0 * 4 + t) * 128 + vv] + Lr[(1 * 4 + t) * 128 + vv] + Lr[(2 * 4 + t) * 128 + vv] + Lr[(3 * 4 + t) * 128 + vv];
          O[((size_t)MP + bs * 4 + t) * D + h * 128 + vv] = o; }
    }
    const int b = F.bid >> 6, h = (F.bid >> 3) & 7, seg = F.bid & 7, w = F.wave, tl = F.lane & 15, g4 = F.lane >> 4;
    f32x4* XCH = (f32x4*)(ws + WS_XCH); float* XP = (float*)(ws + WS_XP);
    f32x4 S[8];
    {
#pragma unroll
        for (int i = 0; i < 8; ++i) S[i] = (f32x4){0.f, 0.f, 0.f, 0.f};
        float Lsum = 0.f;
        hgrn_chunks<false>(F, PC, LB, O, S, Lsum, b, h, seg);
#pragma unroll
        for (int kt = 0; kt < 8; ++kt) XCH[(((size_t)F.bid * 8 + w) * 8 + kt) * 64 + F.lane] = S[kt];
        if (F.tid < 128) XP[F.bid * 128 + F.tid] = __expf(Lsum);
    }
    xcd_barrier(bar);
#pragma unroll
    for (int i = 0; i < 8; ++i) S[i] = (f32x4){0.f, 0.f, 0.f, 0.f};
    for (int sj = 0; sj < seg; ++sj) { const int blk = (F.bid & ~7) + sj;
#pragma unroll
        for (int kt = 0; kt < 8; ++kt) { const f32x4 p4 = *(const f32x4*)(XP + blk * 128 + 16 * kt + 4 * g4); S[kt] = S[kt] * p4 + XCH[(((size_t)blk * 8 + w) * 8 + kt) * 64 + F.lane]; } }
    {
        float Lsum = 0.f;
        hgrn_chunks<true>(F, PC, LB, O, S, Lsum, b, h, seg);
    }
    if (seg == 7) {
#pragma unroll
        for (int kt = 0; kt < 8; ++kt)
#pragma unroll
            for (int i = 0; i < 4; ++i) a.out[O_PC + ((size_t)(b * 8 + h) * 128 + 16 * kt + 4 * g4 + i) * 128 + 16 * w + tl] = S[kt][i];
    }
}

__device__ __forceinline__ void hgrn_out(const Args& a, Frame& F, const bf16* PC, const float* OB, bf16* CO) {
    const float* cn = a.in[I_CNORM];
    for (int m = F.gw; m < M; m += NGW) {
        const float* O = OB + (size_t)m * D;
        const bf16* gate = PC + (size_t)m * CC + 3072;
        f32x4 v[4]; float s = 0.f;
#pragma unroll
        for (int j = 0; j < 4; ++j) { v[j] = *(const f32x4*)(O + 256 * j + 4 * F.lane); s += (v[j].x * v[j].x + v[j].y * v[j].y) + (v[j].z * v[j].z + v[j].w * v[j].w); }
        s = wave_sum(s);
        const float rs = __builtin_amdgcn_rsqf(s * (1.0f / 1024.0f) + EPS);
#pragma unroll
        for (int j = 0; j < 4; ++j) { const int c = 256 * j + 4 * F.lane; const f32x4 g = *(const f32x4*)(cn + c); const v2u gw = *(const v2u*)(gate + c);
            const float x0 = v[j].x * rs * g.x * siluf_(bflo(gw.x)), x1 = v[j].y * rs * g.y * siluf_(bfhi(gw.x)), x2 = v[j].z * rs * g.z * siluf_(bflo(gw.y)), x3 = v[j].w * rs * g.w * siluf_(bfhi(gw.y));
            v2u w; w.x = pk2(x0, x1); w.y = pk2(x2, x3); *(v2u*)(CO + (size_t)m * D + c) = w; }
    }
}

__device__ __forceinline__ void final_norm(const Args& a, Frame& F, const float* rsq) {
    const float* g = a.in[I_NFIN];
    for (int m = F.gw; m < M; m += NGW) {
        float* X = a.out + (size_t)m * D;
        const float rs = __builtin_amdgcn_rsqf(rsq[m] * (1.0f / 1024.0f) + EPS);
#pragma unroll
        for (int j = 0; j < 4; ++j) { const int c = 256 * j + 4 * F.lane; f32x4 v = *(const f32x4*)(X + c); const f32x4 gg = *(const f32x4*)(g + c); v = v * rs * gg; *(f32x4*)(X + c) = v; }
    }
}


constexpr int NPHASE = 16;
__global__ void __launch_bounds__(NTHR, 2) mk_fwd(Args args) {
    extern __shared__ __attribute__((aligned(16))) unsigned char lds[];
    Frame F;
    F.lds = (LAS unsigned char*)lds;
    F.tid = threadIdx.x; F.lane = F.tid & 63; F.wave = __builtin_amdgcn_readfirstlane(F.tid >> 6); F.bid = blockIdx.x; F.gw = F.bid * NWAVES + F.wave;
    unsigned char* ws = args.ws;
    gu32* ctl = (gu32*)(ws + WS_CTL);
    volatile LAS unsigned* MISC = (volatile LAS unsigned*)(F.lds + MISC_OFF);
    for (int u = F.tid; u < (BT_OFF - LDSCTL_OFF) / 4; u += NTHR) ((LAS unsigned*)(F.lds + LDSCTL_OFF))[u] = 0u;
    __syncthreads();
    XcdBarrier bar; bar.bar = (unsigned*)(ctl + CW_BAR); bar.x = 0; bar.st = nullptr;
#if !MK_PER_PHASE
    bar = xcd_barrier_post((unsigned*)(ctl + CW_BAR) + args.li * XCD_BAR_WORDS, MISC + 8);
#define GRID_BAR() xcd_barrier(bar)
#else
#define GRID_BAR() do {} while (0)
#endif
    const int lo = args.ph_lo, hi = args.ph_hi;
#define FRESH(G) Frame G = F; asm volatile("" : "+v"(G.tid)); __builtin_assume(G.tid >= 0 && G.tid < NTHR); G.lane = G.tid & 63
#ifndef PH_MASK
#define PH_MASK 0xFFFF
#endif
#define IN(k) ((((PH_MASK) >> (k)) & 1) && lo <= (k) && (k) < hi)
#define SEAM(k) do { if (IN(k) && IN((k) + 1)) GRID_BAR(); } while (0)

    float* rsq = (float*)(ws + WS_CTL + RSQ_OFF);
    bf16* BUF0 = (bf16*)(ws + WS_BUF0); bf16* BUF1 = (bf16*)(ws + WS_BUF1);
    bf16* RA = (bf16*)(ws + WS_A);
    unsigned char* PREP = ws + WS_B;
    bf16* ATTO = (bf16*)(ws + WS_ATTO); float* LSE = (float*)(ws + WS_LSE);
    const int G = (int)gridDim.x;

    if (IN(0)) { FRESH(G); p0_prologue(args, G); }
    SEAM(0);
    if (IN(1)) {
        pg8::Gemm g{BUF0, (const bf16*)(ws + WS_WIN0), MP, EC, D}; pg8::StaticOrder S; S.init(MP, EC, G, F.bid);
        pg8::EpiScale<0> E{RA, EC, rsq};
        pg8::gemm_phase<pg8::EpiScale<0>, pg8::StaticOrder, true, true>(F.lds, g, S, E);
        { FRESH(G); SEpiScale SE{RA, EC, rsq, 0}; sgemm_phase(G, BUF0, (const bf16*)(ws + WS_WIN0), EC, D, SE); }
    }
    SEAM(1);
    if (IN(2)) {
        FRESH(G);
        { const float* BT = (const float*)(ws + WS_TAB); LAS float* bt = (LAS float*)(F.lds + BT_OFF);
          for (int i = G.tid; i < 12 * BT_LD; i += NTHR) bt[i] = BT[i]; }
        __syncthreads();
        const LAS float* bt = (const LAS float*)(F.lds + BT_OFF);
#ifndef PSKIP
#define PSKIP 0
#endif
        const bool prb = (args.li == 1);
        if (!(prb && (PSKIP & 1)))
        for (int t = F.bid; t < NB * 3 * 4 * 16; t += 256) attn_block(G, RA, bt, ATTO, LSE, t);
        if (!(prb && (PSKIP & 2)))
        for (int t = F.gw; t < SB * 12 * 4; t += NGW) sattn_task(args, RA, bt, ATTO, LSE, (LAS float*)(F.lds + F.wave * 16384), t, G.lane);
        __syncthreads();
#ifndef PREPV
#define PREPV 0
#endif
        if (!prb || PREPV == 0) { if (!(prb && (PSKIP & 4)))
        for (int t = MP / 16 + F.bid; t < M / 16; t += 256) prep_block<0>(args, G, RA, (const bf16*)(ws + WS_TAB + 16384), (const bf16*)(ws + WS_SHB), PREP, t); }
        else { for (int t = F.bid; t < M / 16; t += 256) prep_block<(PREPV ? PREPV : 16)>(args, G, RA, (const bf16*)(ws + WS_TAB + 16384), (const bf16*)(ws + WS_SHB), (unsigned char*)args.out, t); }
        if (!(prb && (PSKIP & 8))) kv_copies(RA, args.out, F.bid * NTHR + G.tid);
        for (int t = F.gw; t < (MP / 16) * 9; t += NGW) wkv_afrag_task(args, RA, (const bf16*)(ws + WS_SHB), (v4u*)(ws + WS_AFG), t / 9, t % 9, G.lane);
    }
    SEAM(2);
    if (IN(3)) { FRESH(G);
#ifdef FRONT_TWICE
#ifndef FRONTV
#define FRONTV 1
#endif
        { LAS unsigned char* area = G.lds + G.wave * FZ_BYTES;
          v4u stg[7];
          wkv_prep_issue(stg, RA, (const bf16*)(ws + WS_SHB), G.gw >> 8, G.gw & 255, G.lane);
          for (int t = G.gw; t < 48 * 256; t += NGW) { const int tn = (t + NGW < 48 * 256) ? t + NGW : t;
              wkv_prep_chunk<FRONTV>(args, stg, (const v4u*)(ws + WS_AFG), RA, (const bf16*)(ws + WS_TAB + 16384), (const bf16*)(ws + WS_SHB), PREP, rec_ptr(ws, args.out, t >> 8, t & 255), area, t >> 8, t & 255, tn >> 8, tn & 255, G.lane); } }
#endif
#ifdef FUSED_TWICE
        { LAS unsigned char* area = G.lds + G.wave * FZ_BYTES;
          v4u stg[7];
          wkv_prep_issue(stg, RA, (const bf16*)(ws + WS_SHB), G.gw >> 8, G.gw & 255, G.lane);
          for (int t = G.gw; t < 48 * 256; t += NGW) { const int tn = (t + NGW < 48 * 256) ? t + NGW : t;
              wkv_prep_chunk<0>(args, stg, (const v4u*)(ws + WS_AFG), RA, (const bf16*)(ws + WS_TAB + 16384), (const bf16*)(ws + WS_SHB), PREP, rec_ptr(ws, args.out, t >> 8, t & 255), area, t >> 8, t & 255, tn >> 8, tn & 255, G.lane); } }
#endif
        { LAS unsigned char* area = G.lds + G.wave * FZ_BYTES;
          v4u stg[7];
          wkv_prep_issue(stg, RA, (const bf16*)(ws + WS_SHB), G.gw >> 8, G.gw & 255, G.lane);
          for (int t = G.gw; t < 48 * 256; t += NGW) { const int tn = (t + NGW < 48 * 256) ? t + NGW : t;
              wkv_prep_chunk<0>(args, stg, (const v4u*)(ws + WS_AFG), RA, (const bf16*)(ws + WS_TAB + 16384), (const bf16*)(ws + WS_SHB), PREP, rec_ptr(ws, args.out, t >> 8, t & 255), area, t >> 8, t & 255, tn >> 8, tn & 255, G.lane); } }
        GRID_BAR();
#ifdef SEQ_PRE
        wkv_phase2<SEQ_PRE>(args, G, PREP, (float*)(ws + WS_YS)); __syncthreads();
#endif
        wkv_phase2<0>(args, G, PREP, (float*)(ws + WS_YS));
#ifdef SEQ_TWICE
        __syncthreads(); wkv_phase2<SEQ_TWICE - 1>(args, G, PREP, (float*)(ws + WS_YS));
#endif
        }
    SEAM(3);
    if (IN(4)) { FRESH(G); mix_phase(args, G, PREP, (const float*)(ws + WS_YS), ATTO, LSE, BUF1); }
    SEAM(4);
    if (IN(5)) {
        pg8::Gemm g{BUF1, (const bf16*)(ws + WS_WOUT0), MP, D, D}; pg8::StaticOrder S; S.init(MP, D, G, F.bid);
        pg8::EpiResid E{args.in[I_XP], args.in[I_XS], args.out, BUF0, rsq + 1 * MPAD, M};
        pg8::gemm_phase<pg8::EpiResid, pg8::StaticOrder, true, true>(F.lds, g, S, E);
        { FRESH(G); SEpiResid SE{args.in[I_XS], args.out + (size_t)MP * D, BUF0, rsq + 1 * MPAD}; sgemm_phase(G, BUF1, (const bf16*)(ws + WS_WOUT0), D, D, SE); }
    }
    SEAM(5);
    if (IN(6)) {
        pg8::Gemm g{BUF0, (const bf16*)(ws + WS_WUP0), MP, FF, D}; pg8::StaticOrder S; S.init(MP, FF, G, F.bid);
        pg8::EpiScale<1> E{RA, FF, rsq + 1 * MPAD};
        pg8::gemm_phase<pg8::EpiScale<1>, pg8::StaticOrder, true, true>(F.lds, g, S, E);
        { FRESH(G); SEpiScale SE{RA, FF, rsq + 1 * MPAD, 1}; sgemm_phase(G, BUF0, (const bf16*)(ws + WS_WUP0), FF, D, SE); }
#ifdef SGEMM_TWICE
        { FRESH(G); SEpiScale SE{RA, FF, rsq + 1 * MPAD, 1}; sgemm_phase(G, BUF0, (const bf16*)(ws + WS_WUP0), FF, D, SE); }
        { FRESH(G); SEpiScale SE{RA, FF, rsq + 1 * MPAD, 1}; sgemm_phase(G, BUF0, (const bf16*)(ws + WS_WUP0), FF, D, SE); }
#endif
    }
    SEAM(6);
    if (IN(7)) {
        pg8::Gemm g{RA, (const bf16*)(ws + WS_WDN0), MP, D, FF}; pg8::StaticOrder S; S.init(MP, D, G, F.bid);
        pg8::EpiResid E{args.out, args.out + (size_t)MP * D, args.out, BUF1, rsq + 2 * MPAD, M};
        pg8::gemm_phase<pg8::EpiResid, pg8::StaticOrder, true, true>(F.lds, g, S, E);
        { FRESH(G); SEpiResid SE{args.out + (size_t)MP * D, args.out + (size_t)MP * D, BUF1, rsq + 2 * MPAD}; sgemm_phase(G, RA, (const bf16*)(ws + WS_WDN0), D, FF, SE); }
    }
    SEAM(7);
    if (IN(8)) {
        pg8::Gemm g{BUF1, (const bf16*)(ws + WS_WCIN), MP, CC, D}; pg8::StaticOrder S; S.init(MP, CC, G, F.bid);
        pg8::EpiScale<0> E{RA, CC, rsq + 2 * MPAD};
        pg8::gemm_phase<pg8::EpiScale<0>, pg8::StaticOrder, true, true>(F.lds, g, S, E);
        { FRESH(G); SEpiScale SE{RA, CC, rsq + 2 * MPAD, 0}; sgemm_phase(G, BUF1, (const bf16*)(ws + WS_WCIN), CC, D, SE); }
    }
    SEAM(8);
    if (IN(9)) { }
    if (IN(10)) { FRESH(G); hgrn_fused(args, G, RA, ws, bar); }
    SEAM(10);
    if (IN(11)) { FRESH(G); hgrn_out(args, G, RA, (const float*)(ws + WS_O), BUF0); }
    SEAM(11);
    if (IN(12)) {
        pg8::Gemm g{BUF0, (const bf16*)(ws + WS_WCOUT), MP, D, D}; pg8::StaticOrder S; S.init(MP, D, G, F.bid);
        pg8::EpiResid E{args.out, args.out + (size_t)MP * D, args.out, BUF1, rsq + 3 * MPAD, M};
        pg8::gemm_phase<pg8::EpiResid, pg8::StaticOrder, true, true>(F.lds, g, S, E);
        { FRESH(G); SEpiResid SE{args.out + (size_t)MP * D, args.out + (size_t)MP * D, BUF1, rsq + 3 * MPAD}; sgemm_phase(G, BUF0, (const bf16*)(ws + WS_WCOUT), D, D, SE); }
    }
    SEAM(12);
    if (IN(13)) {
        pg8::Gemm g{BUF1, (const bf16*)(ws + WS_WUP1), MP, FF, D}; pg8::StaticOrder S; S.init(MP, FF, G, F.bid);
        pg8::EpiScale<1> E{RA, FF, rsq + 3 * MPAD};
        pg8::gemm_phase<pg8::EpiScale<1>, pg8::StaticOrder, true, true>(F.lds, g, S, E);
        { FRESH(G); SEpiScale SE{RA, FF, rsq + 3 * MPAD, 1}; sgemm_phase(G, BUF1, (const bf16*)(ws + WS_WUP1), FF, D, SE); }
    }
    SEAM(13);
    if (IN(14)) {
        pg8::Gemm g{RA, (const bf16*)(ws + WS_WDN1), MP, D, FF}; pg8::StaticOrder S; S.init(MP, D, G, F.bid);
        pg8::EpiResid E{args.out, args.out + (size_t)MP * D, args.out, BUF0, rsq + 4 * MPAD, M};
        pg8::gemm_phase<pg8::EpiResid, pg8::StaticOrder, true, true>(F.lds, g, S, E);
        { FRESH(G); SEpiResid SE{args.out + (size_t)MP * D, args.out + (size_t)MP * D, BUF0, rsq + 4 * MPAD}; sgemm_phase(G, RA, (const bf16*)(ws + WS_WDN1), D, FF, SE); }
    }
    SEAM(14);
    if (IN(15)) { FRESH(G); final_norm(args, G, rsq + 4 * MPAD); }
#undef IN
#undef SEAM
}

extern "C" void kernel_launch(void* const* d_in, const int* in_sizes, int n_in, void* d_out, int out_size, void* d_ws, size_t ws_size, hipStream_t stream) {
    static int grid = 0;
    if (grid == 0) {
        if (n_in != 31 || in_sizes[0] != MP * D || out_size != (int)O_END || ws_size < WS_REQUIRED) {
            fprintf(stderr, "kernel_launch: shape/workspace mismatch: n_in %d in0 %d out %d ws %zu (need %zu); nothing launched\n", n_in, n_in > 0 ? in_sizes[0] : -1, out_size, ws_size, (size_t)WS_REQUIRED); grid = -1; return; }
        if (hipFuncSetAttribute((const void*)mk_fwd, hipFuncAttributeMaxDynamicSharedMemorySize, LDS_BYTES) != hipSuccess) { fprintf(stderr, "kernel_launch: hipFuncSetAttribute failed\n"); grid = -1; return; }
        int per_cu = 0;
        if (hipOccupancyMaxActiveBlocksPerMultiprocessor(&per_cu, (const void*)mk_fwd, NTHR, LDS_BYTES) != hipSuccess || per_cu < 1)
            fprintf(stderr, "kernel_launch: note: occupancy query reports %d workgroups per CU\n", per_cu);
        (void)hipGetLastError();
        grid = 256;
    }
    if (grid < 0) return;
    if (hipMemsetAsync((char*)d_ws + WS_CTL, 0, CTL_ZERO_BYTES, stream) != hipSuccess) { fprintf(stderr, "kernel_launch: hipMemsetAsync failed\n"); return; }
    Args a{};
    for (int i = 0; i < 31; ++i) a.in[i] = (const float*)d_in[i];
    a.out = (float*)d_out; a.ws = (unsigned char*)d_ws;
#if MK_PER_PHASE
    for (int p = 0; p < NPHASE; ++p) { a.ph_lo = p; a.ph_hi = p + 1; hipLaunchKernelGGL(mk_fwd, dim3(grid), dim3(NTHR), LDS_BYTES, stream, a); }
#else
#if defined(PROBE_PHASE)
    a.ph_lo = 0; a.ph_hi = PROBE_PHASE + 1; a.li = 0; hipLaunchKernelGGL(mk_fwd, dim3(grid), dim3(NTHR), LDS_BYTES, stream, a);
    a.ph_lo = PROBE_PHASE; a.ph_hi = PROBE_PHASE + 1; a.li = 1; hipLaunchKernelGGL(mk_fwd, dim3(grid), dim3(NTHR), LDS_BYTES, stream, a);
    a.ph_lo = PROBE_PHASE + 1; a.ph_hi = NPHASE; a.li = 2; hipLaunchKernelGGL(mk_fwd, dim3(grid), dim3(NTHR), LDS_BYTES, stream, a);
#else
    a.ph_lo = 0; a.ph_hi = NPHASE;
    hipLaunchKernelGGL(mk_fwd, dim3(grid), dim3(NTHR), LDS_BYTES, stream, a);
#endif
#endif
    const hipError_t le = hipPeekAtLastError();
    if (le != hipSuccess) fprintf(stderr, "kernel_launch: launch failed: %s\n", hipGetErrorName(le));
}
```

```cpp
#include <hip/hip_runtime.h>
#include <cstdio>
#include <cstdint>

#ifndef MK_PER_PHASE
#define MK_PER_PHASE 0
#endif

namespace pg8 {
#define PG8_LAS __attribute__((address_space(3)))
typedef unsigned short bf16_t;
typedef short bf16x8 __attribute__((ext_vector_type(8)));
typedef float f32x4 __attribute__((ext_vector_type(4)));
typedef unsigned u32x4 __attribute__((ext_vector_type(4)));
constexpr int BM = 256, BK = 64, HALF = 128, HTB = HALF * BK * 2  , STAGE_BYTES = 8 * HTB, NXCD = 8, WGM = 8;

__host__ __device__ __forceinline__ int lds_byte(int r, int c) { const int st = (r >> 4) * 2 + (c >> 5), rr = r & 15, cc = c & 31, ob = rr * 64 + cc * 2; return st * 1024 + (ob ^ (((ob >> 9) & 1) << 5)); }
__host__ __device__ __forceinline__ void stage_rc(int b, int& R, int& C) { const int st = b / 1024, sb = b % 1024, swz = sb ^ (((sb >> 9) & 1) << 5); R = (st >> 1) * 16 + swz / 64; C = (st & 1) * 32 + (swz % 64) / 2; }
__host__ __device__ __forceinline__ int perm32(int rho) { const int n = rho >> 4, i = rho & 15; return 8 * (i >> 2) + 4 * n + (i & 3); }

struct Unit { int pm, pn; };
struct Gemm { const bf16_t* A; const bf16_t* Bt; int M, N, K; };

struct StaticOrder {
    int nM, nN, nwg, G, c;
    __host__ __device__ void init(int M, int N, int G_, int c_) { nM = M / BM; nN = N / BM; nwg = nM * nN; G = G_; c = c_; }
    __host__ __device__ bool next(int i, Unit& u) const {
        const long L = (long)i * G + c; if (L >= nwg) return false;
        int wgid = (int)L; { const int q = nwg / NXCD, r = nwg % NXCD, xcd = wgid % NXCD, off = wgid / NXCD; wgid = (xcd < r ? xcd * (q + 1) : r * (q + 1) + (xcd - r) * q) + off; }
        const int nig = WGM * nN, gid = wgid / nig, fm = gid * WGM, gsz = (nM - fm) < WGM ? (nM - fm) : WGM;
        u.pm = fm + ((wgid % nig) % gsz); u.pn = (wgid % nig) / gsz; return true;
    }
    __device__ __forceinline__ void a_ready(const Unit&) const {}
    __device__ __forceinline__ void done(const Unit&) const {}
};


__device__ __forceinline__ unsigned cvt_pk_bf16(float lo, float hi) { unsigned r; asm volatile("v_cvt_pk_bf16_f32 %0, %1, %2" : "=v"(r) : "v"(lo), "v"(hi)); return r; }
typedef unsigned u32x2 __attribute__((ext_vector_type(2)));

template <int RELU2> struct EpiScale {
    static constexpr bool PERM = true, AFTER_DRAIN = false;
    bf16_t* O; int ldc; const float* rsq;
    __device__ __forceinline__ void operator()(const f32x4 (&acc)[2][2][4][2], const Unit& u, int wr, int wc, int fr, int fq) const {
        const int col0 = u.pn * BM + wc * 32 + 8 * fq;
#pragma unroll
        for (int ai = 0; ai < 2; ++ai)
#pragma unroll
            for (int m = 0; m < 4; ++m) {
                const int row = u.pm * BM + ai * HALF + wr * 64 + m * 16 + fr;
                const float s = __builtin_amdgcn_rsqf(rsq[row] * (1.0f / 1024.0f) + 1e-6f);
                bf16_t* rowp = O + (size_t)row * ldc + col0;
#pragma unroll
                for (int bj = 0; bj < 2; ++bj) {
                    f32x4 v0 = acc[ai][bj][m][0] * s, v1 = acc[ai][bj][m][1] * s;
                    if (RELU2) { v0.x = fmaxf(v0.x, 0.f); v0.y = fmaxf(v0.y, 0.f); v0.z = fmaxf(v0.z, 0.f); v0.w = fmaxf(v0.w, 0.f); v0 = v0 * v0;
                                 v1.x = fmaxf(v1.x, 0.f); v1.y = fmaxf(v1.y, 0.f); v1.z = fmaxf(v1.z, 0.f); v1.w = fmaxf(v1.w, 0.f); v1 = v1 * v1; }
                    u32x4 w; w.x = cvt_pk_bf16(v0.x, v0.y); w.y = cvt_pk_bf16(v0.z, v0.w); w.z = cvt_pk_bf16(v1.x, v1.y); w.w = cvt_pk_bf16(v1.z, v1.w);
                    *(u32x4*)(rowp + bj * HALF) = w;
                }
            }
    }
};

struct EpiResid {
    static constexpr bool PERM = true, AFTER_DRAIN = false;
    const float* Rp; const float* Rs;
    float* X; bf16_t* XB; float* rsq; int Mv;
    __device__ __forceinline__ void operator()(const f32x4 (&acc)[2][2][4][2], const Unit& u, int wr, int wc, int fr, int fq) const {
        const int col0 = u.pn * BM + wc * 32 + 8 * fq;
#pragma unroll
        for (int ai = 0; ai < 2; ++ai)
#pragma unroll
            for (int m = 0; m < 4; ++m) {
                const int row = u.pm * BM + ai * HALF + wr * 64 + m * 16 + fr;
                const bool valid = row < Mv;
                const float* rrow = (row < 16384) ? (Rp + (size_t)row * 1024) : (Rs + (size_t)(row - 16384) * 1024);
                float ss = 0.f;
#pragma unroll
                for (int bj = 0; bj < 2; ++bj) {
                    const int col = col0 + bj * HALF;
                    f32x4 x0 = (f32x4){0.f, 0.f, 0.f, 0.f}, x1 = x0;
                    if (valid) {
                        x0 = *(const f32x4*)(rrow + col) + acc[ai][bj][m][0]; x1 = *(const f32x4*)(rrow + col + 4) + acc[ai][bj][m][1];
                        *(f32x4*)(X + (size_t)row * 1024 + col) = x0; *(f32x4*)(X + (size_t)row * 1024 + col + 4) = x1;
                        ss += ((x0.x * x0.x + x0.y * x0.y) + (x0.z * x0.z + x0.w * x0.w)) + ((x1.x * x1.x + x1.y * x1.y) + (x1.z * x1.z + x1.w * x1.w));
                    }
                    u32x4 w; w.x = cvt_pk_bf16(x0.x, x0.y); w.y = cvt_pk_bf16(x0.z, x0.w); w.z = cvt_pk_bf16(x1.x, x1.y); w.w = cvt_pk_bf16(x1.z, x1.w);
                    *(u32x4*)(XB + (size_t)row * 1024 + col) = w;
                }
                ss += __shfl_xor(ss, 16); ss += __shfl_xor(ss, 32);
                if (fq == 0 && valid) unsafeAtomicAdd(rsq + row, ss);
            }
    }
};

template <class Epi, class Sched, bool ALIGN_EPI = false, bool SP2 = false>
__device__ __forceinline__ void gemm_phase(PG8_LAS unsigned char* lds, const Gemm g, const Sched& S, const Epi& E) {
    int tid_ = threadIdx.x; asm volatile("" : "+v"(tid_)); __builtin_assume(tid_ >= 0 && tid_ < 512);
    const int tid = tid_, wid = __builtin_amdgcn_readfirstlane(tid >> 6), lane = tid & 63, wr = wid >> 2, wc = wid & 3, fr = lane & 15, fq = lane >> 4;
    const int K = g.K, nt = K / BK;
    unsigned voffA[2], voffB[2];
#pragma unroll
    for (int i = 0; i < 2; ++i) { int R, C; stage_rc(tid * 16 + i * 8192, R, C); const int Rb = Epi::PERM ? ((R & ~31) + perm32(R & 31)) : R;
        voffA[i] = (unsigned)(R * K + C) * 2u; voffB[i] = (unsigned)(Rb * K + C) * 2u; }
    const size_t kstep = (size_t)(BK * 2);
    const size_t hstep = (size_t)HALF * K * 2;
    const size_t tstep = 2 * hstep;
    const unsigned ldsw = (unsigned)wid * 1024u;
    const int aoff = lds_byte(wr * 64 + fr, fq * 8), boff = lds_byte(wc * 32 + fr, fq * 8);
#define PG8_SA(b, h) (((b) * 2 + (h)) * HTB)
#define PG8_SB(b, h) ((4 + (b) * 2 + (h)) * HTB)
#define PG8_STAGE(bufoff, gbase, voff) do { _Pragma("unroll") for (int _i = 0; _i < 2; ++_i) \
        __builtin_amdgcn_global_load_lds((const unsigned*)((const char*)(gbase) + (voff)[_i]), (PG8_LAS unsigned*)(lds + (bufoff) + ldsw + _i * 8192), 16, 0, 0); } while (0)
#define PG8_LDA(dst, b, h) do { _Pragma("unroll") for (int m = 0; m < 4; ++m) _Pragma("unroll") for (int k = 0; k < 2; ++k) dst[m][k] = *(const PG8_LAS bf16x8*)(lds + PG8_SA(b, h) + aoff + m * 2048 + k * 1024); } while (0)
#define PG8_LDB(dst, b, h) do { _Pragma("unroll") for (int n = 0; n < 2; ++n) _Pragma("unroll") for (int k = 0; k < 2; ++k) dst[n][k] = *(const PG8_LAS bf16x8*)(lds + PG8_SB(b, h) + boff + n * 2048 + k * 1024); } while (0)
#define PG8_MMA(ai, bj, At, Bt) do { __builtin_amdgcn_s_setprio(1); _Pragma("unroll") for (int m = 0; m < 4; ++m) _Pragma("unroll") for (int n = 0; n < 2; ++n) _Pragma("unroll") for (int k = 0; k < 2; ++k) \
        acc[ai][bj][m][n] = __builtin_amdgcn_mfma_f32_16x16x32_bf16(Bt[n][k], At[m][k], acc[ai][bj][m][n], 0, 0, 0); __builtin_amdgcn_s_setprio(0); } while (0)
#define PG8_WAIT_V(n) asm volatile("s_waitcnt vmcnt(" #n ")" ::: "memory")
#define PG8_WAIT_L(n) asm volatile("s_waitcnt lgkmcnt(" #n ")" ::: "memory")
#define PG8_BAR __builtin_amdgcn_s_barrier()
#define PG8_SCHED __builtin_amdgcn_sched_barrier(0)
    Unit cur, nxt; int ui = 0;
    if (!S.next(0, cur)) return;
    f32x4 acc[2][2][4][2];
#pragma unroll
    for (int a = 0; a < 2; ++a)
#pragma unroll
        for (int b = 0; b < 2; ++b)
#pragma unroll
            for (int m = 0; m < 4; ++m)
#pragma unroll
                for (int n = 0; n < 2; ++n) acc[a][b][m][n] = (f32x4){0.f, 0.f, 0.f, 0.f};
    bf16x8 At[4][2], B0[2][2], B1[2][2];
    const char* cA = (const char*)g.A + (size_t)cur.pm * tstep; const char* cB = (const char*)g.Bt + (size_t)cur.pn * tstep;
    S.a_ready(cur);
    if constexpr (SP2) {
        PG8_STAGE(PG8_SB(0, 0), cB, voffB); PG8_STAGE(PG8_SB(0, 1), cB + hstep, voffB); PG8_STAGE(PG8_SA(0, 0), cA, voffA); PG8_STAGE(PG8_SA(0, 1), cA + hstep, voffA);
        if (wr == 1) PG8_BAR;
        PG8_WAIT_V(2); PG8_BAR;
        PG8_STAGE(PG8_SB(1, 0), cB + kstep, voffB); PG8_STAGE(PG8_SA(1, 0), cA + kstep, voffA); PG8_STAGE(PG8_SB(1, 1), cB + hstep + kstep, voffB);
        PG8_WAIT_V(6); PG8_BAR;
    } else {
        PG8_STAGE(PG8_SB(0, 0), cB, voffB); PG8_STAGE(PG8_SA(0, 0), cA, voffA); PG8_STAGE(PG8_SB(0, 1), cB + hstep, voffB); PG8_STAGE(PG8_SA(0, 1), cA + hstep, voffA);
        if (wr == 1) PG8_BAR;
        PG8_WAIT_V(4); PG8_BAR;
        PG8_STAGE(PG8_SB(1, 0), cB + kstep, voffB); PG8_STAGE(PG8_SA(1, 0), cA + kstep, voffA); PG8_STAGE(PG8_SB(1, 1), cB + hstep + kstep, voffB);
        PG8_WAIT_V(6); PG8_BAR;
    }
    for (;;) {
        const bool has_next = S.next(ui + 1, nxt);
        const char* nA = has_next ? (const char*)g.A + (size_t)nxt.pm * tstep : cA; const char* nB = has_next ? (const char*)g.Bt + (size_t)nxt.pn * tstep : cB;
        for (int t = 0; t < nt; t += 2) {
            const bool last = (t == nt - 2);
            const char* a1 = cA + (size_t)(t + 1) * kstep;
            const char* a2 = last ? nA : cA + (size_t)(t + 2) * kstep; const char* b2 = last ? nB : cB + (size_t)(t + 2) * kstep;
            const char* a3 = a2 + kstep; const char* b3 = b2 + kstep;
            if (last && has_next) S.a_ready(nxt);
            if constexpr (SP2) {
            PG8_LDB(B0, 0, 0); PG8_LDB(B1, 0, 1); PG8_SCHED; PG8_LDA(At, 0, 0); PG8_STAGE(PG8_SA(1, 1), a1 + hstep, voffA);
            PG8_WAIT_V(8); PG8_WAIT_L(0); PG8_BAR; PG8_MMA(0, 0, At, B0); PG8_MMA(0, 1, At, B1); PG8_BAR; PG8_SCHED;
            PG8_LDA(At, 0, 1); PG8_STAGE(PG8_SB(0, 0), b2, voffB); PG8_STAGE(PG8_SB(0, 1), b2 + hstep, voffB); PG8_STAGE(PG8_SA(0, 0), a2, voffA);
            PG8_WAIT_V(8); PG8_WAIT_L(0); PG8_BAR; PG8_MMA(1, 0, At, B0); PG8_MMA(1, 1, At, B1); PG8_BAR; PG8_SCHED;
            PG8_LDB(B0, 1, 0); PG8_LDB(B1, 1, 1); PG8_SCHED; PG8_LDA(At, 1, 0); PG8_STAGE(PG8_SA(0, 1), a2 + hstep, voffA);
            PG8_WAIT_V(8); PG8_WAIT_L(0); PG8_BAR; PG8_MMA(0, 0, At, B0); PG8_MMA(0, 1, At, B1); PG8_BAR; PG8_SCHED;
            PG8_LDA(At, 1, 1); PG8_STAGE(PG8_SB(1, 0), b3, voffB); PG8_STAGE(PG8_SB(1, 1), b3 + hstep, voffB); PG8_STAGE(PG8_SA(1, 0), a3, voffA);
            PG8_WAIT_V(8); PG8_WAIT_L(0); PG8_BAR; PG8_MMA(1, 0, At, B0); PG8_MMA(1, 1, At, B1); PG8_BAR; PG8_SCHED;
            } else {
            PG8_LDB(B0, 0, 0); PG8_SCHED; PG8_LDA(At, 0, 0); PG8_STAGE(PG8_SA(1, 1), a1 + hstep, voffA);
            PG8_WAIT_L(8); PG8_BAR; PG8_WAIT_L(0); PG8_MMA(0, 0, At, B0); PG8_BAR; PG8_SCHED;
            PG8_LDB(B1, 0, 1); PG8_STAGE(PG8_SB(0, 0), b2, voffB);
            PG8_BAR; PG8_WAIT_L(0); PG8_MMA(0, 1, At, B1); PG8_BAR;
            PG8_LDA(At, 0, 1); PG8_STAGE(PG8_SA(0, 0), a2, voffA);
            PG8_BAR; PG8_WAIT_L(0); PG8_MMA(1, 0, At, B0); PG8_BAR; PG8_SCHED;
            PG8_STAGE(PG8_SB(0, 1), b2 + hstep, voffB);
            PG8_WAIT_V(6); PG8_BAR; PG8_MMA(1, 1, At, B1); PG8_BAR;
            PG8_LDB(B0, 1, 0); PG8_SCHED; PG8_LDA(At, 1, 0); PG8_STAGE(PG8_SA(0, 1), a2 + hstep, voffA);
            PG8_WAIT_L(8); PG8_BAR; PG8_WAIT_L(0); PG8_MMA(0, 0, At, B0); PG8_BAR; PG8_SCHED;
            PG8_LDB(B1, 1, 1); PG8_STAGE(PG8_SB(1, 0), b3, voffB);
            PG8_BAR; PG8_WAIT_L(0); PG8_MMA(0, 1, At, B1); PG8_BAR;
            PG8_LDA(At, 1, 1); PG8_STAGE(PG8_SA(1, 0), a3, voffA);
            PG8_BAR; PG8_WAIT_L(0); PG8_MMA(1, 0, At, B0); PG8_BAR; PG8_SCHED;
            PG8_STAGE(PG8_SB(1, 1), b3 + hstep, voffB);
            PG8_WAIT_V(6); PG8_BAR; PG8_MMA(1, 1, At, B1); PG8_BAR;
            }
        }
        if constexpr (ALIGN_EPI) { if (wr == 0) PG8_BAR; }
        if constexpr (!Epi::AFTER_DRAIN) { E(acc, cur, wr, wc, fr, fq); S.done(cur); }
        if (!has_next) break;
#pragma unroll
        for (int a = 0; a < 2; ++a)
#pragma unroll
            for (int b = 0; b < 2; ++b)
#pragma unroll
                for (int m = 0; m < 4; ++m)
#pragma unroll
                    for (int n = 0; n < 2; ++n) acc[a][b][m][n] = (f32x4){0.f, 0.f, 0.f, 0.f};
        cur = nxt; cA = nA; cB = nB; ++ui;
        if constexpr (ALIGN_EPI) { if (wr == 1) PG8_BAR; }
    }
    PG8_WAIT_V(0);
    if constexpr (!ALIGN_EPI) { if (wr == 0) PG8_BAR; }
    PG8_BAR;
    if constexpr (Epi::AFTER_DRAIN) { E.fused(acc, cur, wr, wc, fr, fq, lds, wid, lane); S.done(cur); }
#undef PG8_SA
#undef PG8_SB
#undef PG8_STAGE
#undef PG8_LDA
#undef PG8_LDB
#undef PG8_MMA
#undef PG8_WAIT_V
#undef PG8_WAIT_L
#undef PG8_BAR
#undef PG8_SCHED
}
}

#define GAS __attribute__((address_space(1)))
#define LAS __attribute__((address_space(3)))
typedef unsigned short bf16;
typedef unsigned v4u __attribute__((ext_vector_type(4)));
typedef unsigned v2u __attribute__((ext_vector_type(2)));
typedef float f32x4 __attribute__((ext_vector_type(4)));
typedef float f32x2 __attribute__((ext_vector_type(2)));
typedef float f32x16 __attribute__((ext_vector_type(16)));
typedef short bf16x8 __attribute__((ext_vector_type(8)));
typedef GAS unsigned gu32;

constexpr int NWAVES = 8, NTHR = 512;
constexpr int D = 1024, T = 4096, NB = 4, MP = NB * T, SB = 32, ST = 4, MS = SB * ST, M = MP + MS, MPAD = 16640;
constexpr int EC = 5120, ECR = 4896, AQKV = 2304, BCOLS = 2592, CC = 4096, FF = 4096, BW = 768;
constexpr int LORA = 288;
constexpr float EPS = 1e-6f, LNX_EPS = 64e-5f, LOG2E = 1.4426950408889634f;
constexpr float QSCALE2 = 0.125f * LOG2E;
constexpr int BT_LD = 132;

constexpr size_t O_YP = 0, O_YS = (size_t)MP * D, O_PA0 = (size_t)M * D;
constexpr size_t O_PA1 = O_PA0 + (size_t)4 * 128 * 512, O_PA2 = O_PA1 + (size_t)4 * 512 * 512, O_PSH = O_PA2 + (size_t)4 * 2048 * 512;
constexpr size_t O_PWKV = O_PSH + (size_t)4 * BCOLS, O_PC = O_PWKV + (size_t)4 * 12 * 64 * 64, O_SA0 = O_PC + (size_t)4 * 8 * 128 * 128;
constexpr size_t O_SA1 = O_SA0 + (size_t)32 * 4 * 512, O_SA2 = O_SA1 + (size_t)32 * 4 * 512, O_SSH = O_SA2 + (size_t)32 * 4 * 512;
constexpr size_t O_SWKV = O_SSH + (size_t)32 * BCOLS, O_SC = O_SWKV + (size_t)32 * 12 * 64 * 64, O_END = O_SC + (size_t)32 * 8 * 128 * 128;
static_assert(O_END == 29191296, "output size");

constexpr size_t MiB = 1u << 20;
constexpr size_t WS_CTL = 0, CTL_ZERO_BYTES = 1 * MiB;
constexpr int CW_BAR = 4096;
constexpr int CW_PROG = 15360;
constexpr size_t RSQ_OFF = 65536;
constexpr size_t WS_TAB = 1 * MiB;
constexpr size_t WS_SHB = 1 * MiB + 512 * 1024;
constexpr size_t WS_WIN0 = 2 * MiB;
constexpr size_t WS_WOUT0 = WS_WIN0 + (size_t)EC * D * 2;
constexpr size_t WS_WUP0 = WS_WOUT0 + (size_t)D * D * 2;
constexpr size_t WS_WDN0 = WS_WUP0 + (size_t)FF * D * 2;
constexpr size_t WS_WCIN = WS_WDN0 + (size_t)FF * D * 2;
constexpr size_t WS_WCOUT = WS_WCIN + (size_t)CC * D * 2;
constexpr size_t WS_WUP1 = WS_WCOUT + (size_t)D * D * 2;
constexpr size_t WS_WDN1 = WS_WUP1 + (size_t)FF * D * 2;
constexpr size_t WS_BUF0 = WS_WDN1 + (size_t)FF * D * 2;
constexpr size_t WS_BUF1 = WS_BUF0 + (size_t)MPAD * D * 2;
constexpr size_t WS_ATTO = WS_BUF1 + (size_t)MPAD * D * 2;
constexpr size_t WS_LSE = WS_ATTO + (size_t)3 * M * 256 * 2;
constexpr size_t WS_SQ = WS_LSE + (size_t)3 * M * 4 * 4;
constexpr size_t WS_A = ((WS_SQ + (size_t)MS * 3 * 1024 * 4 + 255) / 256) * 256;
constexpr size_t WS_B = WS_A + (size_t)MPAD * EC * 2;
constexpr int NPREP = 48 * T + 384 * ST;
constexpr size_t WS_END = WS_B + (size_t)NPREP * 1024;
constexpr size_t WS_QE = WS_B, WS_KE = WS_QE + (size_t)MP * D * 2, WS_KET = WS_KE + (size_t)MP * D * 2, WS_VT = WS_KET + (size_t)MP * D * 2, WS_EBL = WS_VT + (size_t)MP * D * 2;
static_assert(WS_EBL + (size_t)(MP / 16) * D * 4 <= WS_END, "region B");

constexpr int RING_BYTES = 131072, LDSCTL_OFF = RING_BYTES, MISC_OFF = LDSCTL_OFF + 320, BT_OFF = 135168, LDS_BYTES = 147456;
static_assert(BT_OFF + 12 * BT_LD * 4 <= LDS_BYTES && MISC_OFF + 128 <= BT_OFF, "LDS map");

#define RLX_AGENT __ATOMIC_RELAXED, __HIP_MEMORY_SCOPE_AGENT
#define LDS_WAIT() asm volatile("s_waitcnt lgkmcnt(0)" ::: "memory")
#define VM_WAIT() asm volatile("s_waitcnt vmcnt(0)" ::: "memory")
#define LDS_BARRIER() do { asm volatile("s_waitcnt lgkmcnt(0)" ::: "memory"); __builtin_amdgcn_s_barrier(); asm volatile("" ::: "memory"); } while (0)
typedef __bf16 bf16x2_t __attribute__((ext_vector_type(2)));
__device__ __forceinline__ unsigned pk2(float lo, float hi) { const f32x2 v = {lo, hi}; const bf16x2_t b = __builtin_convertvector(v, bf16x2_t); return __builtin_bit_cast(unsigned, b); }
__device__ __forceinline__ unsigned f2bf(float f) { return pk2(f, 0.f) & 0xffffu; }
__device__ __forceinline__ float bf2f(unsigned short b) { return __uint_as_float((unsigned)b << 16); }
__device__ __forceinline__ float bflo(unsigned w) { return __uint_as_float(w << 16); }
__device__ __forceinline__ float bfhi(unsigned w) { return __uint_as_float(w & 0xffff0000u); }
__device__ __forceinline__ float wave_sum(float v) {
#pragma unroll
    for (int o = 1; o < 64; o <<= 1) v += __shfl_xor(v, o);
    return v;
}
__device__ __forceinline__ float wave_max(float v) {
#pragma unroll
    for (int o = 1; o < 64; o <<= 1) v = fmaxf(v, __shfl_xor(v, o));
    return v;
}
__device__ __forceinline__ float rcpf_(float x) { return __builtin_amdgcn_rcpf(x); }
__device__ __forceinline__ float sigmoidf_(float x) { return rcpf_(1.0f + __expf(-x)); }
__device__ __forceinline__ float siluf_(float x) { return x * rcpf_(1.0f + __expf(-x)); }

#define XB_TMO      128
#define XB_XCNT(j)  (256  + 64 * (j))
#define XB_XSUB(j)  (1280 + 64 * (j))
#define XB_XGEN(j)  (2304 + 64 * (j))
#define XB_TOP      3328
#define XB_TOPGEN   3392
#define XCD_BAR_WORDS 3456
#define XB_SPIN_CAP (1u << 18)

__device__ __forceinline__ unsigned xb_ld(unsigned* p)              { return __hip_atomic_load(p, __ATOMIC_RELAXED, __HIP_MEMORY_SCOPE_AGENT); }
__device__ __forceinline__ unsigned xb_add(unsigned* p, unsigned v) { return __hip_atomic_fetch_add(p, v, __ATOMIC_RELAXED, __HIP_MEMORY_SCOPE_AGENT); }
__device__ __forceinline__ unsigned xb_xcc_id() { return (unsigned)__builtin_amdgcn_s_getreg((3 << 11) | 20) & 0xFu; }
#define XB_SPIN(cond, bar) do { unsigned _sp = 0; while (cond) { __builtin_amdgcn_s_sleep(1); \
    if ((++_sp & 255u) == 0u) { if (xb_ld(&(bar)[XB_TMO])) break; if (_sp > XB_SPIN_CAP) { atomicAdd(&(bar)[XB_TMO], 1u); break; } } } } while (0)

struct XcdBarrier {
    unsigned* bar; unsigned x;
    volatile LAS unsigned* st;
};

__device__ __forceinline__ XcdBarrier xcd_barrier_post(unsigned* bar, volatile LAS unsigned* st) {
    XcdBarrier b; b.bar = bar; b.x = xb_xcc_id(); b.st = st;
    if (threadIdx.x == 0) (void)xb_add(&bar[XB_XCNT(b.x)], 1u);
    return b;
}
__device__ __forceinline__ void xcd_barrier_complete(unsigned* bar, unsigned x, unsigned& nloc, unsigned& nx) {
    const unsigned G = gridDim.x * gridDim.y * gridDim.z;
    unsigned sum, cnt, mine, sp = 0u;
    for (;;) {
        sum = 0u; cnt = 0u; mine = 0u;
#pragma unroll
        for (unsigned j = 0; j < 16; ++j) { const unsigned c = xb_ld(&bar[XB_XCNT(j)]); sum += c; cnt += (c > 0u) ? 1u : 0u; mine = (j == x) ? c : mine; }
        if (sum == G) break;
        __builtin_amdgcn_s_sleep(1);
        if ((++sp & 255u) == 0u) { if (xb_ld(&bar[XB_TMO])) break; if (sp > XB_SPIN_CAP) { atomicAdd(&bar[XB_TMO], 1u); break; } }
    }
    nloc = mine > 0u ? mine : 1u; nx = cnt > 0u ? cnt : 1u;
}

__device__ __forceinline__ void xcd_barrier(const XcdBarrier& b) {
    asm volatile("s_waitcnt vmcnt(0)" ::: "memory");
    __syncthreads();
    if (threadIdx.x == 0) {
        unsigned* bar = b.bar;
        __builtin_amdgcn_s_waitcnt(0);
        unsigned nloc = b.st[0], nx = b.st[1];
        if (nloc == 0u) { xcd_barrier_complete(bar, b.x, nloc, nx); b.st[0] = nloc; b.st[1] = nx; }
        const unsigned old = xb_add(&bar[XB_XSUB(b.x)], 1u);
        const unsigned gen = old / nloc;
        if (old + 1u == (gen + 1u) * nloc) {
            __builtin_amdgcn_fence(__ATOMIC_RELEASE, "agent");
            asm volatile("s_waitcnt vmcnt(0)" ::: "memory");
            const unsigned og = xb_add(&bar[XB_TOP], 1u);
            const unsigned tg = og / nx;
            if (og + 1u == (tg + 1u) * nx) xb_add(&bar[XB_TOPGEN], 1u);
            else XB_SPIN(xb_ld(&bar[XB_TOPGEN]) == tg, bar);
            __builtin_amdgcn_fence(__ATOMIC_ACQUIRE, "agent");
            xb_add(&bar[XB_XGEN(b.x)], 1u);
            asm volatile("s_waitcnt vmcnt(0)" ::: "memory");
        } else {
            XB_SPIN(xb_ld(&bar[XB_XGEN(b.x)]) == gen, bar);
            __builtin_amdgcn_fence(__ATOMIC_ACQUIRE, "agent");
            asm volatile("s_waitcnt vmcnt(0)" ::: "memory");
        }
    }
    __syncthreads();
}

struct Args { const float* in[31]; float* out; unsigned char* ws; int ph_lo, ph_hi, li, pad; };
enum { I_XP = 0, I_XS, I_CA0, I_CA1, I_CA2, I_SSH, I_SWKV, I_SC, I_RELB, I_NMIX, I_NMLP, I_NFIN, I_EWIN, I_EMU, I_EW0, I_EW2, I_EA0, I_EA2, I_EG2,
       I_EKK, I_EKA, I_ERK, I_ELNW, I_ELNB, I_EWOUT, I_CWIN, I_CLB, I_CNORM, I_CWOUT, I_MUP, I_MDN };

struct Frame {
    LAS unsigned char* lds;
    int tid, lane, wave, bid, gw;
};
constexpr int NGW = 256 * NWAVES, NGT = 256 * NTHR;

__device__ __forceinline__ void p0_transpose_item(const float* W, int K, int N, bf16* WT, const float* gain, LAS float* scr, int item, int lane) {
    const int nblk = N / 32, kb = item / nblk, nb = item % nblk, k0 = 64 * kb, n0 = 32 * nb;
    f32x4 x[8];
#pragma unroll
    for (int i = 0; i < 8; ++i) x[i] = *(const f32x4*)(W + (size_t)(k0 + 8 * i + (lane >> 3)) * N + n0 + 4 * (lane & 7));
    if (gain) {
#pragma unroll
        for (int i = 0; i < 8; ++i) x[i] = x[i] * gain[k0 + 8 * i + (lane >> 3)];
    }
#pragma unroll
    for (int i = 0; i < 8; ++i) { LAS float* d = scr + (8 * i + (lane >> 3)) * 33 + 4 * (lane & 7); d[0] = x[i].x; d[1] = x[i].y; d[2] = x[i].z; d[3] = x[i].w; }
    LDS_WAIT(); asm volatile("" ::: "memory");
    const int c = lane & 7;
#pragma unroll
    for (int j = 0; j < 4; ++j) { const int n = (lane >> 3) + 8 * j; const LAS float* s = scr + (8 * c) * 33 + n;
        v4u o; o.x = pk2(s[0 * 33], s[1 * 33]); o.y = pk2(s[2 * 33], s[3 * 33]); o.z = pk2(s[4 * 33], s[5 * 33]); o.w = pk2(s[6 * 33], s[7 * 33]);
        *(GAS v4u*)(WT + (size_t)(n0 + n) * K + k0 + 8 * c) = o; }
    LDS_WAIT(); asm volatile("" ::: "memory");
}

__device__ __forceinline__ int t5_bucket(int dist) {
    if (dist < 16) return dist;
    const float d = (float)dist;
    int large = 16 + (int)(logf(d * (1.0f / 16.0f)) / 4.852030263919617f * 16.0f);
    return large < 31 ? large : 31;
}

constexpr int P0_I_IN = 16 * (ECR / 32), P0_I_SQ = 16 * 32, P0_I_UP = 16 * 128, P0_I_DN = 64 * 32;
constexpr int P0_NITEMS = P0_I_IN + P0_I_SQ + P0_I_UP + P0_I_DN + P0_I_UP + P0_I_SQ + P0_I_UP + P0_I_DN;
__device__ __forceinline__ void p0_convert_items(const Args& a, LAS float* scr, int lane, int first, int last, int wid, int nw) {
    unsigned char* ws = a.ws;
    for (int it = first + wid; it < last; it += nw) {
        int r = it;
        if (r < P0_I_IN) { p0_transpose_item(a.in[I_EWIN], D, ECR, (bf16*)(ws + WS_WIN0), a.in[I_NMIX], scr, r, lane); continue; } r -= P0_I_IN;
        if (r < P0_I_SQ) { p0_transpose_item(a.in[I_EWOUT], D, D, (bf16*)(ws + WS_WOUT0), nullptr, scr, r, lane); continue; } r -= P0_I_SQ;
        if (r < P0_I_UP) { p0_transpose_item(a.in[I_MUP], D, FF, (bf16*)(ws + WS_WUP0), a.in[I_NMLP], scr, r, lane); continue; } r -= P0_I_UP;
        if (r < P0_I_DN) { p0_transpose_item(a.in[I_MDN], FF, D, (bf16*)(ws + WS_WDN0), nullptr, scr, r, lane); continue; } r -= P0_I_DN;
        if (r < P0_I_UP) { p0_transpose_item(a.in[I_CWIN], D, CC, (bf16*)(ws + WS_WCIN), a.in[I_NMIX] + D, scr, r, lane); continue; } r -= P0_I_UP;
        if (r < P0_I_SQ) { p0_transpose_item(a.in[I_CWOUT], D, D, (bf16*)(ws + WS_WCOUT), nullptr, scr, r, lane); continue; } r -= P0_I_SQ;
        if (r < P0_I_UP) { p0_transpose_item(a.in[I_MUP] + (size_t)D * FF, D, FF, (bf16*)(ws + WS_WUP1), a.in[I_NMLP] + D, scr, r, lane); continue; } r -= P0_I_UP;
        p0_transpose_item(a.in[I_MDN] + (size_t)FF * D, FF, D, (bf16*)(ws + WS_WDN1), nullptr, scr, r, lane);
    }
}

__device__ __forceinline__ void p0_prologue(const Args& a, Frame& F) {
    unsigned char* ws = a.ws;
    LAS float* scr = (LAS float*)(F.lds + F.wave * 16384);
    p0_convert_items(a, scr, F.lane, 0, P0_I_IN, F.gw, NGW);
    const int gt = F.bid * NTHR + F.tid;
    { v4u* z = (v4u*)(ws + WS_WIN0 + (size_t)ECR * D * 2); const int n = (EC - ECR) * D * 2 / 16;
      for (int i = gt; i < n; i += NGT) z[i] = (v4u){0u, 0u, 0u, 0u}; }
    { float* BT = (float*)(ws + WS_TAB); const float* rb = a.in[I_RELB];
      for (int i = gt; i < 12 * 129; i += NGT) { const int hd = i / 129, j = i % 129, g = hd >> 2; const int dist = j << (2 * g);
          BT[hd * BT_LD + j] = rb[t5_bucket(dist) * 12 + hd] * LOG2E; }
      float* LB = (float*)(ws + WS_TAB + 8192); const float* lr = a.in[I_CLB];
      for (int i = gt; i < 1024; i += NGT) LB[i] = 1.0f / (1.0f + expf(lr[i] - lr[1024 + i]));
      bf16* LW = (bf16*)(ws + WS_TAB + 16384); const float* w2 = a.in[I_EW2]; const float* a2 = a.in[I_EA2]; const float* g2 = a.in[I_EG2];
      for (int i = gt; i < BW * LORA; i += NGT) { const int ch = i / LORA, j = i % LORA;
          const float v = j < 64 ? w2[j * BW + ch] : (j < 128 ? a2[(j - 64) * BW + ch] : g2[(j - 128) * BW + ch]);
          LW[i] = (bf16)f2bf(v); } }
    { bf16* SHB = (bf16*)(ws + WS_SHB); const float* ss = a.in[I_SSH];
      for (int i = gt; i < 33 * BCOLS; i += NGT) SHB[i] = (i < 32 * BCOLS) ? (bf16)f2bf(ss[i]) : (bf16)0; }
    { bf16* B0 = (bf16*)(ws + WS_BUF0); bf16* B1 = (bf16*)(ws + WS_BUF1); float* rsq0 = (float*)(ws + WS_CTL + RSQ_OFF);
      for (int m = F.gw; m < MPAD; m += NGW) {
          unsigned long long* o8 = (unsigned long long*)(B0 + (size_t)m * D) + F.lane;
          if (m < M) {
              const float* xr = (m < MP) ? (a.in[I_XP] + (size_t)m * D) : (a.in[I_XS] + (size_t)(m - MP) * D);
              const f32x4* x4 = (const f32x4*)xr + F.lane; f32x4 v[4]; float s = 0.f;
#pragma unroll
              for (int j = 0; j < 4; ++j) { v[j] = x4[64 * j]; s += (v[j].x * v[j].x + v[j].y * v[j].y) + (v[j].z * v[j].z + v[j].w * v[j].w); }
              s = wave_sum(s);
#pragma unroll
              for (int j = 0; j < 4; ++j) o8[64 * j] = (unsigned long long)pk2(v[j].x, v[j].y) | ((unsigned long long)pk2(v[j].z, v[j].w) << 32);
              if (F.lane == 0) rsq0[m] = s;
          } else {
              unsigned long long* p8 = (unsigned long long*)(B1 + (size_t)m * D) + F.lane;
#pragma unroll
              for (int j = 0; j < 4; ++j) { o8[64 * j] = 0ull; p8[64 * j] = 0ull; }
          }
      } }
}

__device__ __forceinline__ f32x16 mfma32(bf16x8 a, bf16x8 b, f32x16 c) { return __builtin_amdgcn_mfma_f32_32x32x16_bf16(a, b, c, 0, 0, 0); }
__device__ __forceinline__ f32x4 mfma16(bf16x8 a, bf16x8 b, f32x4 c) { return __builtin_amdgcn_mfma_f32_16x16x32_bf16(a, b, c, 0, 0, 0); }

struct SEpiScale {
    bf16* O; int ldc; const float* rsq; int relu2;
    __device__ __forceinline__ void operator()(int row, int col, f32x4 v, int fq) const {
        const float s = __builtin_amdgcn_rsqf(rsq[row] * (1.0f / 1024.0f) + EPS);
        v = v * s;
        if (relu2) { v.x = fmaxf(v.x, 0.f); v.y = fmaxf(v.y, 0.f); v.z = fmaxf(v.z, 0.f); v.w = fmaxf(v.w, 0.f); v = v * v; }
        v2u w; w.x = pk2(v.x, v.y); w.y = pk2(v.z, v.w);
        *(v2u*)(O + (size_t)row * ldc + col) = w;
    }
};
struct SEpiResid {
    const float* R; float* X; bf16* XB; float* rsq;
    __device__ __forceinline__ void operator()(int row, int col, f32x4 v, int fq) const {
        const size_t o = (size_t)(row - MP) * 1024 + col;
        const f32x4 x = *(const f32x4*)(R + o) + v;
        *(f32x4*)(X + o) = x;
        v2u w; w.x = pk2(x.x, x.y); w.y = pk2(x.z, x.w);
        *(v2u*)(XB + (size_t)row * 1024 + col) = w;
        float ss = (x.x * x.x + x.y * x.y) + (x.z * x.z + x.w * x.w);
        ss += __shfl_xor(ss, 16); ss += __shfl_xor(ss, 32);
        if (fq == 0) unsafeAtomicAdd(rsq + row, ss);
    }
};
template <class Epi>
__device__ __forceinline__ void sgemm_phase(Frame& F, const bf16* __restrict__ A, const bf16* __restrict__ Bt, int N, int K, const Epi& E) {
    const int fr = F.lane & 15, fq = F.lane >> 4, w = F.wave;
    const int kw = K >> 3;
    LAS f32x4* red = (LAS f32x4*)F.lds;
    for (int u = F.bid; u < (N >> 4); u += 256) {
        const int n0 = u << 4;
        f32x4 acc[8];
#pragma unroll
        for (int mt = 0; mt < 8; ++mt) acc[mt] = (f32x4){0.f, 0.f, 0.f, 0.f};
        const bf16* ap = A + (size_t)(MP + fr) * K + w * kw + 8 * fq;
        const bf16* bp = Bt + (size_t)(n0 + fr) * K + w * kw + 8 * fq;
        for (int k0 = 0; k0 < kw; k0 += 128) {
            bf16x8 bfr[4], afr[4][8];
#pragma unroll
            for (int kk = 0; kk < 4; ++kk) { const int k = k0 + 32 * kk;
                bfr[kk] = *(const bf16x8*)(bp + k);
#pragma unroll
                for (int mt = 0; mt < 8; ++mt) afr[kk][mt] = *(const bf16x8*)(ap + (size_t)(16 * mt) * K + k); }
#pragma unroll
            for (int kk = 0; kk < 4; ++kk)
#pragma unroll
                for (int mt = 0; mt < 8; ++mt) acc[mt] = mfma16(bfr[kk], afr[kk][mt], acc[mt]);
        }
#pragma unroll
        for (int mt = 0; mt < 8; ++mt) red[(w * 8 + mt) * 64 + F.lane] = acc[mt];
        __syncthreads();
        f32x4 sum = red[(0 * 8 + w) * 64 + F.lane];
#pragma unroll
        for (int j = 1; j < 8; ++j) sum = sum + red[(j * 8 + w) * 64 + F.lane];
        E(MP + 16 * w + fr, n0 + 4 * fq, sum, fq);
        __syncthreads();
    }
}


constexpr int AT_ROW = 144, AT_K = 0, AT_V = 384 * AT_ROW;
static_assert(2 * 384 * AT_ROW <= RING_BYTES && 8 * 32 * AT_ROW <= AT_V, "attention LDS");
__device__ __forceinline__ void attn_block(Frame& F, const bf16* __restrict__ PROJ, const LAS float* bt, bf16* ATTO, float* LSE, int btask) {
    const int lane = F.lane, w = F.wave;
    const int ti8 = btask & 15; int rest = btask >> 4; const int hs = rest & 3; rest >>= 2; const int g = rest % 3; const int b = rest / 3;
    const int dsh = 2 * g, dil = 1 << dsh, tpr = (T >> dsh) >> 5;
    const int r = (ti8 * 8) / tpr, s0blk = ((ti8 * 8) % tpr) * 32, hd = 4 * g + hs;
    const int q = lane & 31, hh = lane >> 5;
    const size_t rowbase = (size_t)b * T + r;
    const int s0 = s0blk + 32 * w;
    const bf16* Qp = PROJ + (rowbase + (size_t)dil * (s0 + q)) * EC + hd * 64 + 8 * hh;
    bf16x8 qf[4];
#pragma unroll
    for (int ks = 0; ks < 4; ++ks) qf[ks] = *(const bf16x8*)(Qp + 16 * ks);
    {
        v4u stg[12];
#pragma unroll
        for (int i = 0; i < 12; ++i) { const int idx = F.tid + NTHR * i, kv = idx / 3072, rem = idx - kv * 3072, row = rem >> 3, piece = rem & 7;
            int sk = s0blk - 128 + row; sk = sk < 0 ? 0 : sk;
            stg[i] = *(const v4u*)(PROJ + (rowbase + (size_t)dil * sk) * EC + (1 + kv) * BW + hd * 64 + piece * 8); }
#pragma unroll
        for (int i = 0; i < 12; ++i) { const int idx = F.tid + NTHR * i, kv = idx / 3072, rem = idx - kv * 3072, row = rem >> 3, piece = rem & 7;
            *(LAS v4u*)(F.lds + (kv ? AT_V : AT_K) + row * AT_ROW + piece * 16) = stg[i]; }
    }
    __syncthreads();
    f32x16 o0, o1;
#pragma unroll
    for (int i = 0; i < 16; ++i) { o0[i] = 0.f; o1[i] = 0.f; }
    float mrun = -1e30f, lrun = 0.f;
    const LAS float* btp = bt + hd * BT_LD;
    for (int kt = 4; kt >= 0; --kt) {
        const int kbase = s0 - 128 + 32 * kt;
        if (kbase + 31 < 0) break;
        const int kb = 32 * w + 32 * kt;
        const LAS unsigned char* kp = F.lds + AT_K + (kb + q) * AT_ROW + 16 * hh;
        bf16x8 kf[4];
#pragma unroll
        for (int ks = 0; ks < 4; ++ks) kf[ks] = *(const LAS bf16x8*)(kp + 32 * ks);
        bf16x8 vf[2][2];
#pragma unroll
        for (int s = 0; s < 2; ++s)
#pragma unroll
            for (int j = 0; j < 8; ++j) {
                const int key = 16 * s + 8 * (j >> 2) + 4 * hh + (j & 3);
                const LAS unsigned short* vp = (const LAS unsigned short*)(F.lds + AT_V + (kb + key) * AT_ROW) + q;
                vf[s][0][j] = (short)vp[0]; vf[s][1][j] = (short)vp[32];
            }
        f32x16 sacc;
#pragma unroll
        for (int i = 0; i < 16; ++i) sacc[i] = 0.f;
#pragma unroll
        for (int ks = 0; ks < 4; ++ks) sacc = mfma32(kf[ks], qf[ks], sacc);
        float x[16]; float tmax = -1e30f;
#pragma unroll
        for (int reg = 0; reg < 16; ++reg) {
            const int i = (reg & 3) + 8 * (reg >> 2) + 4 * hh;
            const int jj = q - i + 128 - 32 * kt;
            const bool valid = (jj >= 0) && (jj <= 128) && (kbase + i >= 0);
            const int jc = jj < 0 ? 0 : (jj > 128 ? 128 : jj);
            const float bv = btp[jc];
            x[reg] = valid ? (sacc[reg] * QSCALE2 + bv) : -1e30f;
            tmax = fmaxf(tmax, x[reg]);
        }
        tmax = fmaxf(tmax, __shfl_xor(tmax, 32));
        const float mnew = fmaxf(mrun, tmax);
        const float alpha = __builtin_amdgcn_exp2f(mrun - mnew);
        float psum = 0.f; float p[16];
#pragma unroll
        for (int reg = 0; reg < 16; ++reg) { p[reg] = __builtin_amdgcn_exp2f(x[reg] - mnew); psum += p[reg]; }
        psum += __shfl_xor(psum, 32);
        lrun = lrun * alpha + psum; mrun = mnew;
#pragma unroll
        for (int i = 0; i < 16; ++i) { o0[i] *= alpha; o1[i] *= alpha; }
        v4u pw0, pw1;
        pw0.x = pk2(p[0], p[1]); pw0.y = pk2(p[2], p[3]); pw0.z = pk2(p[4], p[5]); pw0.w = pk2(p[6], p[7]);
        pw1.x = pk2(p[8], p[9]); pw1.y = pk2(p[10], p[11]); pw1.z = pk2(p[12], p[13]); pw1.w = pk2(p[14], p[15]);
        const bf16x8 pf0 = __builtin_bit_cast(bf16x8, pw0), pf1 = __builtin_bit_cast(bf16x8, pw1);
        o0 = mfma32(vf[0][0], pf0, o0); o0 = mfma32(vf[1][0], pf1, o0);
        o1 = mfma32(vf[0][1], pf0, o1); o1 = mfma32(vf[1][1], pf1, o1);
    }
    const float inv = rcpf_(lrun);
    __syncthreads();
    {
        LAS unsigned char* ob = F.lds + w * (32 * AT_ROW);
        LAS unsigned char* op = ob + q * AT_ROW + 8 * hh;
#pragma unroll
        for (int rg = 0; rg < 4; ++rg) {
            *(LAS v2u*)(op + 16 * rg) = (v2u){pk2(o0[4 * rg] * inv, o0[4 * rg + 1] * inv), pk2(o0[4 * rg + 2] * inv, o0[4 * rg + 3] * inv)};
            *(LAS v2u*)(op + 64 + 16 * rg) = (v2u){pk2(o1[4 * rg] * inv, o1[4 * rg + 1] * inv), pk2(o1[4 * rg + 2] * inv, o1[4 * rg + 3] * inv)};
        }
#pragma unroll
        for (int ps = 0; ps < 4; ++ps) { const int row = 8 * ps + (lane >> 3), piece = lane & 7;
            const v4u v = *(const LAS v4u*)(ob + row * AT_ROW + piece * 16);
            *(v4u*)(ATTO + ((size_t)g * M + rowbase + (size_t)dil * (s0 + row)) * 256 + hs * 64 + piece * 8) = v; }
    }
    if (hh == 0) LSE[((size_t)g * M + rowbase + (size_t)dil * (s0 + q)) * 4 + hs] = mrun + __log2f(lrun);
    LDS_BARRIER();
}

__device__ __forceinline__ void sattn_task(const Args& a, const bf16* __restrict__ PROJ, const LAS float* bt, bf16* ATTO, float* LSE, LAS float* scr, int task, int lane) {
    const int t = task & 3, hd = (task >> 2) % 12, bs = task / 48, g = hd >> 2, hs = hd & 3, dsh = 2 * g, dil = 1 << dsh, W = 128 << dsh;
    const float* cache = a.in[I_CA0 + g];
    const LAS float* btp = bt + hd * BT_LD;
    LAS float* qs = scr; LAS float* ps = scr + 64;
    const size_t m0 = (size_t)MP + bs * 4;
    qs[lane] = bf2f(PROJ[(m0 + t) * EC + hd * 64 + lane]) * QSCALE2;
    LDS_WAIT(); asm volatile("" ::: "memory");
    float xv[3]; float mx = -1e30f;
#pragma unroll
    for (int ksl = 0; ksl < 3; ++ksl) {
        const int j = lane + 64 * ksl; float x = -1e30f;
        if (j <= 128) {
            const int rho = W + t - j * dil; float dot = 0.f;
            if (rho >= W) {
                const bf16* kp = PROJ + (m0 + (rho - W)) * EC + BW + hd * 64;
#pragma unroll 8
                for (int d = 0; d < 64; ++d) dot += bf2f(kp[d]) * qs[d];
            } else {
                const float* kp = cache + (((size_t)bs * W + rho) * 2 + 0) * 256 + hs * 64;
                f32x4 kv[16];
#pragma unroll
                for (int d4 = 0; d4 < 16; ++d4) kv[d4] = *(const f32x4*)(kp + 4 * d4);
#pragma unroll
                for (int d4 = 0; d4 < 16; ++d4) { const LAS float* qq = qs + 4 * d4; dot += kv[d4].x * qq[0] + kv[d4].y * qq[1] + kv[d4].z * qq[2] + kv[d4].w * qq[3]; }
            }
            x = dot + btp[j];
        }
        xv[ksl] = x; mx = fmaxf(mx, x);
    }
    mx = wave_max(mx);
    float psum = 0.f;
#pragma unroll
    for (int ksl = 0; ksl < 3; ++ksl) { const int j = lane + 64 * ksl; const float p = (j <= 128) ? __builtin_amdgcn_exp2f(xv[ksl] - mx) : 0.f; psum += p; if (j <= 128) ps[j] = p; }
    psum = wave_sum(psum);
    LDS_WAIT(); asm volatile("" ::: "memory");
    float acc = 0.f;
    for (int j = 0; j <= 128; ++j) { const int rho = W + t - j * dil; if (rho < W) break; acc += ps[j] * bf2f(PROJ[(m0 + (rho - W)) * EC + 2 * BW + hd * 64 + lane]); }
    const int jc0 = t / dil + 1;
    const float* vb = cache + (((size_t)bs * W + (W + t)) * 2 + 1) * 256 + hs * 64 + lane;
    int j = jc0;
    for (; j + 16 <= 129; j += 16) {
        float vv[16];
#pragma unroll
        for (int u = 0; u < 16; ++u) vv[u] = vb[-(long)(j + u) * dil * 512];
#pragma unroll
        for (int u = 0; u < 16; ++u) acc += ps[j + u] * vv[u];
    }
    for (; j <= 128; ++j) acc += ps[j] * vb[-(long)j * dil * 512];
    ATTO[((size_t)g * M + m0 + t) * 256 + hs * 64 + lane] = (bf16)f2bf(acc * rcpf_(psum));
    if (lane == 0) LSE[((size_t)g * M + m0 + t) * 4 + hs] = mx + __log2f(psum);
    LDS_WAIT(); asm volatile("" ::: "memory");
}

__device__ __forceinline__ f32x4 ld4bf(const bf16* p) { const v2u w = *(const v2u*)p; return (f32x4){bflo(w.x), bfhi(w.x), bflo(w.y), bfhi(w.y)}; }
__device__ __forceinline__ void kv_copies(const bf16* __restrict__ PROJ, float* out, int gt) {
#pragma unroll
    for (int g = 0; g < 3; ++g) {
        const int Wp = 128 << (2 * g); const size_t off = g == 0 ? O_PA0 : (g == 1 ? O_PA1 : O_PA2);
        const int n4 = NB * Wp * 128;
        for (int i4 = gt; i4 < n4; i4 += NGT) { const int i = i4 * 4; const int d = i & 63, hs = (i >> 6) & 3, kv = (i >> 8) & 1, rr = i >> 9, ii = rr % Wp, b = rr / Wp;
            *(f32x4*)(out + off + i) = ld4bf(PROJ + ((size_t)b * T + (T - Wp) + ii) * EC + (1 + kv) * BW + (4 * g + hs) * 64 + d); }
        const size_t soff = g == 0 ? O_SA0 : (g == 1 ? O_SA1 : O_SA2);
        for (int i4 = gt; i4 < SB * ST * 128; i4 += NGT) { const int i = i4 * 4; const int d = i & 63, hs = (i >> 6) & 3, kv = (i >> 8) & 1, rr = i >> 9;
            *(f32x4*)(out + soff + i) = ld4bf(PROJ + ((size_t)MP + rr) * EC + (1 + kv) * BW + (4 * g + hs) * 64 + d); }
    }
    for (int i4 = gt; i4 < NB * BCOLS / 4; i4 += NGT) { const int i = i4 * 4; const int b = i / BCOLS, c = i % BCOLS; *(f32x4*)(out + O_PSH + i) = ld4bf(PROJ + ((size_t)b * T + T - 1) * EC + AQKV + c); }
    for (int i4 = gt; i4 < SB * BCOLS / 4; i4 += NGT) { const int i = i4 * 4; const int b = i / BCOLS, c = i % BCOLS; *(f32x4*)(out + O_SSH + i) = ld4bf(PROJ + ((size_t)MP + b * 4 + 3) * EC + AQKV + c); }
}

__device__ __forceinline__ void xs8(const bf16* cur, const bf16* prv, const float* mu, int col, float* o) {
    const v4u c8 = *(const v4u*)(cur + col), p8 = *(const v4u*)(prv + col);
    const f32x4 m0 = *(const f32x4*)(mu + col), m1 = *(const f32x4*)(mu + col + 4);
    const float c[8] = {bflo(c8.x), bfhi(c8.x), bflo(c8.y), bfhi(c8.y), bflo(c8.z), bfhi(c8.z), bflo(c8.w), bfhi(c8.w)};
    const float p[8] = {bflo(p8.x), bfhi(p8.x), bflo(p8.y), bfhi(p8.y), bflo(p8.z), bfhi(p8.z), bflo(p8.w), bfhi(p8.w)};
    const float mm[8] = {m0.x, m0.y, m0.z, m0.w, m1.x, m1.y, m1.z, m1.w};
#pragma unroll
    for (int i = 0; i < 8; ++i) o[i] = c[i] + (p[i] - c[i]) * mm[i];
}
__device__ __forceinline__ f32x4 xs4(const bf16* cur, const bf16* prv, const float* mu, int col) {
    const v2u c4 = *(const v2u*)(cur + col), p4 = *(const v2u*)(prv + col);
    const f32x4 c = (f32x4){bflo(c4.x), bfhi(c4.x), bflo(c4.y), bfhi(c4.y)}, p = (f32x4){bflo(p4.x), bfhi(p4.x), bflo(p4.y), bfhi(p4.y)};
    const f32x4 m = *(const f32x4*)(mu + col);
    return c + (p - c) * m;
}

constexpr int PB_ROW = BCOLS * 2, PB_PIECES = PB_ROW / 16, PB_AF_OFF = 20 * PB_ROW, PB_SCR_OFF = PB_AF_OFF + 9 * 64 * 16, PB_SCR_W = 2048;
static_assert(PB_SCR_OFF + 8 * PB_SCR_W <= BT_OFF, "prep LDS");
__device__ __forceinline__ f32x4 lxs4(const LAS unsigned char* cur, const float* mu, int col) {
    const v2u c4 = *(const LAS v2u*)(cur + 2 * col), p4 = *(const LAS v2u*)(cur - PB_ROW + 2 * col);
    const f32x4 c = (f32x4){bflo(c4.x), bfhi(c4.x), bflo(c4.y), bfhi(c4.y)}, p = (f32x4){bflo(p4.x), bfhi(p4.x), bflo(p4.y), bfhi(p4.y)};
    const f32x4 m = *(const f32x4*)(mu + col);
    return c + (p - c) * m;
}
template <int PV>
__device__ __forceinline__ void prep_block(const Args& a, Frame& F, const bf16* __restrict__ PROJ, const bf16* __restrict__ LW, const bf16* __restrict__ SHB, unsigned char* PREP, int task) {
    const int lane = F.lane, tok = lane & 15, g4 = lane >> 4, w = F.wave;
    const bool samp = task >= MP / 16;
    const int nrows = samp ? 20 : 17;
    if (!(PV & 8)) {
        v4u stg[13];
#pragma unroll
        for (int i = 0; i < 13; ++i) { const int idx = F.tid + NTHR * i;
            if (idx < nrows * PB_PIECES) {
                const int row = idx / PB_PIECES, piece = idx - row * PB_PIECES;
                const bf16* src;
                if (!samp) { const int m = task * 16 - 1 + row; src = (row == 0 && ((task * 16) & (T - 1)) == 0) ? (SHB + 32 * BCOLS) : (PROJ + (size_t)m * EC + AQKV); }
                else { const int q = row / 5, rr = row - 5 * q, seq = (task - MP / 16) * 4 + q; src = (rr == 0) ? (SHB + seq * BCOLS) : (PROJ + (size_t)(MP + seq * 4 + rr - 1) * EC + AQKV); }
                stg[i] = *(const v4u*)(src + piece * 8); }
            else stg[i] = (v4u){0u, 0u, 0u, 0u}; }
#pragma unroll
        for (int i = 0; i < 13; ++i) { const int idx = F.tid + NTHR * i;
            if (idx < nrows * PB_PIECES) { const int row = idx / PB_PIECES, piece = idx - row * PB_PIECES; *(LAS v4u*)(F.lds + row * PB_ROW + piece * 16) = stg[i]; } }
    }
    __syncthreads();
    const int crow = samp ? (5 * (tok >> 2) + 1 + (tok & 3)) : (tok + 1);
    const LAS unsigned char* cur = F.lds + crow * PB_ROW;
    const float* mu = a.in[I_EMU];
    for (int ks = w; ks < 9; ks += 8) {
        const int col = 3 * BW + 32 * ks + 8 * g4;
        const v4u c8 = *(const LAS v4u*)(cur + 2 * col), p8 = *(const LAS v4u*)(cur - PB_ROW + 2 * col);
        const f32x4 m0 = *(const f32x4*)(mu + col), m1 = *(const f32x4*)(mu + col + 4);
        const float c[8] = {bflo(c8.x), bfhi(c8.x), bflo(c8.y), bfhi(c8.y), bflo(c8.z), bfhi(c8.z), bflo(c8.w), bfhi(c8.w)};
        const float p[8] = {bflo(p8.x), bfhi(p8.x), bflo(p8.y), bfhi(p8.y), bflo(p8.z), bfhi(p8.z), bflo(p8.w), bfhi(p8.w)};
        const float mm[8] = {m0.x, m0.y, m0.z, m0.w, m1.x, m1.y, m1.z, m1.w};
        float v[8];
#pragma unroll
        for (int i = 0; i < 8; ++i) {
            v[i] = c[i] + (p[i] - c[i]) * mm[i];
            if (ks < 2) { const float e = __expf(2.0f * v[i]); v[i] = 1.0f - 2.0f * rcpf_(e + 1.0f); }
            else if (ks >= 4) v[i] = sigmoidf_(v[i]);
        }
        *(LAS v4u*)(F.lds + PB_AF_OFF + (ks * 64 + lane) * 16) = (v4u){pk2(v[0], v[1]), pk2(v[2], v[3]), pk2(v[4], v[5]), pk2(v[6], v[7])};
    }
    __syncthreads();
    bf16x8 af[9];
#pragma unroll
    for (int ks = 0; ks < 9; ++ks) af[ks] = *(const LAS bf16x8*)(F.lds + PB_AF_OFF + (ks * 64 + lane) * 16);
    size_t ebase0; int estride;
    if (!samp) { const int m0 = task * 16, t0 = m0 & (T - 1), b = m0 >> 12; ebase0 = (size_t)(b * 12) * T + t0; estride = T; }
    else { const int sb0 = (task - MP / 16) * 4; ebase0 = (size_t)48 * T + (size_t)(sb0 * 12) * 4; estride = 4; }
    LAS unsigned char* scr = F.lds + PB_SCR_OFF + w * PB_SCR_W;
    const float* k_k = a.in[I_EKK];
#pragma unroll 1
    for (int h = w; h < 12; h += 8) {
        f32x4 kr[4];
        float ssq = 0.f;
#pragma unroll
        for (int nt = 0; nt < 4; ++nt) {
            const int c4 = h * 64 + 16 * nt + 4 * g4;
            kr[nt] = lxs4(cur, mu, BW + c4);
            const f32x4 kkr = kr[nt] * *(const f32x4*)(k_k + c4);
            ssq += (kkr.x * kkr.x + kkr.y * kkr.y) + (kkr.z * kkr.z + kkr.w * kkr.w);
        }
        ssq += __shfl_xor(ssq, 16); ssq += __shfl_xor(ssq, 32);
        const float kinv = rcpf_(fmaxf(__builtin_amdgcn_sqrtf(ssq), 1e-12f));
        v2u pkv[7][4];
#pragma unroll
        for (int nt = 0; nt < 4; ++nt) {
            const bf16* lwp = LW + (size_t)(h * 64 + 16 * nt + tok) * LORA + 8 * g4;
            f32x4 aw = (f32x4){0.f, 0.f, 0.f, 0.f}, aa = aw, ag = aw;
            if (!(PV & 1)) {
#pragma unroll
            for (int ks = 0; ks < 9; ++ks) { const bf16x8 bw = *(const bf16x8*)(lwp + 32 * ks);
                if (ks < 2) aw = mfma16(bw, af[ks], aw); else if (ks < 4) aa = mfma16(bw, af[ks], aa); else ag = mfma16(bw, af[ks], ag); }
            } else { aw = __builtin_bit_cast(f32x4, af[nt]); aa = __builtin_bit_cast(f32x4, af[nt + 4]); ag = aw; }
            const int c4 = h * 64 + 16 * nt + 4 * g4, cl = 16 * nt + 4 * g4;
            const f32x4 w0 = *(const f32x4*)(a.in[I_EW0] + c4), a0 = *(const f32x4*)(a.in[I_EA0] + c4), kkc = *(const f32x4*)(k_k + c4), kac = *(const f32x4*)(a.in[I_EKA] + c4);
            f32x4 dec, av, kk, kp, bb;
#pragma unroll
            for (int i = 0; i < 4; ++i) {
                const float z = -(w0[i] + aw[i]);
                if (!(PV & 2)) {
                const float sp = fmaxf(z, 0.f) + __logf(1.0f + __expf(-fabsf(z)));
                const float ww = -sp - 0.5f;
                dec[i] = __expf(ww);
                av[i] = sigmoidf_(a0[i] + aa[i]);
                } else { dec[i] = z; av[i] = a0[i] + aa[i]; }
                kk[i] = kr[nt][i] * kkc[i] * kinv;
                kp[i] = kr[nt][i] * (1.0f + (av[i] - 1.0f) * kac[i]);
                bb[i] = kk[i] * av[i];
            }
            const f32x4 rr4 = lxs4(cur, mu, c4), vr4 = lxs4(cur, mu, 2 * BW + c4);
            const f32x4 ew = dec;
            pkv[0][nt] = (v2u){pk2(rr4.x, rr4.y), pk2(rr4.z, rr4.w)};
            pkv[1][nt] = (v2u){pk2(kp.x, kp.y), pk2(kp.z, kp.w)};
            pkv[2][nt] = (v2u){pk2(vr4.x, vr4.y), pk2(vr4.z, vr4.w)};
            pkv[3][nt] = (v2u){pk2(kk.x, kk.y), pk2(kk.z, kk.w)};
            pkv[4][nt] = (v2u){pk2(bb.x, bb.y), pk2(bb.z, bb.w)};
            pkv[5][nt] = (v2u){pk2(ag.x, ag.y), pk2(ag.z, ag.w)};
            pkv[6][nt] = (v2u){pk2(ew.x, ew.y), pk2(ew.z, ew.w)};
        }
        unsigned char* Et[4];
#pragma unroll
        for (int sI = 0; sI < 4; ++sI) { const int tt = 4 * sI + (lane >> 4);
            size_t eidx = ebase0 + (size_t)h * estride + (samp ? (size_t)((tt >> 2) * 48 + (tt & 3)) : (size_t)tt);
            if (PV) eidx &= 65535;
            Et[sI] = PREP + eidx * 1024 + 8 * (lane & 15); }
#pragma unroll
        for (int vI = 0; vI < 7; ++vI) {
#pragma unroll
            for (int nt = 0; nt < 4; ++nt) *(LAS v2u*)(scr + tok * 128 + 2 * (16 * nt + 4 * g4)) = pkv[vI][nt];
#pragma unroll
            for (int sI = 0; sI < 4; ++sI) { const v2u ov = *(const LAS v2u*)(scr + (4 * sI + (lane >> 4)) * 128 + 8 * (lane & 15)); if (!(PV & 4)) *(v2u*)(Et[sI] + 128 * vI) = ov; else asm volatile("" :: "v"(ov.x), "v"(ov.y)); }
        }
    }
    LDS_BARRIER();
}

__device__ __forceinline__ float row16_sum(float x) {
    x += __int_as_float(__builtin_amdgcn_mov_dpp(__float_as_int(x), 0x128, 0xf, 0xf, false));
    x += __int_as_float(__builtin_amdgcn_mov_dpp(__float_as_int(x), 0x124, 0xf, 0xf, false));
    x += __int_as_float(__builtin_amdgcn_mov_dpp(__float_as_int(x), 0x122, 0xf, 0xf, false));
    x += __int_as_float(__builtin_amdgcn_mov_dpp(__float_as_int(x), 0x121, 0xf, 0xf, false));
    return x;
}
__device__ __forceinline__ void row16_sum2(float& a, float& b) {
    asm("s_nop 1\n\t"
        "v_add_f32_dpp %0, %0, %0 row_ror:8 row_mask:0xf bank_mask:0xf\n\t"
        "v_add_f32_dpp %1, %1, %1 row_ror:8 row_mask:0xf bank_mask:0xf\n\t"
        "s_nop 0\n\t"
        "v_add_f32_dpp %0, %0, %0 row_ror:4 row_mask:0xf bank_mask:0xf\n\t"
        "v_add_f32_dpp %1, %1, %1 row_ror:4 row_mask:0xf bank_mask:0xf\n\t"
        "s_nop 0\n\t"
        "v_add_f32_dpp %0, %0, %0 row_ror:2 row_mask:0xf bank_mask:0xf\n\t"
        "v_add_f32_dpp %1, %1, %1 row_ror:2 row_mask:0xf bank_mask:0xf\n\t"
        "s_nop 0\n\t"
        "v_add_f32_dpp %0, %0, %0 row_ror:1 row_mask:0xf bank_mask:0xf\n\t"
        "v_add_f32_dpp %1, %1, %1 row_ror:1 row_mask:0xf bank_mask:0xf\n\t"
        "s_nop 1"
        : "+v"(a), "+v"(b));
}
__device__ __forceinline__ float wkv_step(f32x4& S, const f32x4 d, const f32x4 kk, const f32x4 bb, const f32x4 kp, const f32x4 r, const float v) {
    float p = S.x * kk.x; p = fmaf(S.y, kk.y, p); p = fmaf(S.z, kk.z, p); p = fmaf(S.w, kk.w, p);
    const float sa = -row16_sum(p);
    S.x = fmaf(sa, bb.x, fmaf(S.x, d.x, v * kp.x));
    S.y = fmaf(sa, bb.y, fmaf(S.y, d.y, v * kp.y));
    S.z = fmaf(sa, bb.z, fmaf(S.z, d.z, v * kp.z));
    S.w = fmaf(sa, bb.w, fmaf(S.w, d.w, v * kp.w));
    float y = S.x * r.x; y = fmaf(S.y, r.y, y); y = fmaf(S.z, r.z, y); y = fmaf(S.w, r.w, y);
    return row16_sum(y);
}
__device__ __forceinline__ float wkv_step_p(f32x4& S, float& ypart, const f32x4 d, const f32x4 kk, const f32x4 bb, const f32x4 kp, const f32x4 r, const float v) {
    float s0 = S.x, s1 = S.y, s2 = S.z, s3 = S.w, y = ypart, p, t;
    asm("v_mul_f32 %5, %0, %7\n\t"
        "v_fmac_f32 %5, %1, %8\n\t"
        "v_fmac_f32 %5, %2, %9\n\t"
        "v_fmac_f32 %5, %3, %10\n\t"
        "v_mul_f32 %6, %27, %19\n\t"
        "v_add_f32_dpp %4, %4, %4 row_ror:8 row_mask:0xf bank_mask:0xf\n\t"
        "v_add_f32_dpp %5, %5, %5 row_ror:8 row_mask:0xf bank_mask:0xf\n\t"
        "v_fma_f32 %0, %0, %11, %6\n\t"
        "v_add_f32_dpp %4, %4, %4 row_ror:4 row_mask:0xf bank_mask:0xf\n\t"
        "v_add_f32_dpp %5, %5, %5 row_ror:4 row_mask:0xf bank_mask:0xf\n\t"
        "v_mul_f32 %6, %27, %20\n\t"
        "v_add_f32_dpp %4, %4, %4 row_ror:2 row_mask:0xf bank_mask:0xf\n\t"
        "v_add_f32_dpp %5, %5, %5 row_ror:2 row_mask:0xf bank_mask:0xf\n\t"
        "v_fma_f32 %1, %1, %12, %6\n\t"
        "v_add_f32_dpp %4, %4, %4 row_ror:1 row_mask:0xf bank_mask:0xf\n\t"
        "v_add_f32_dpp %5, %5, %5 row_ror:1 row_mask:0xf bank_mask:0xf\n\t"
        "v_mul_f32 %6, %27, %21\n\t"
        "v_fma_f32 %2, %2, %13, %6\n\t"
        "v_mul_f32 %6, %27, %22\n\t"
        "v_fma_f32 %3, %3, %14, %6\n\t"
        "v_fma_f32 %0, -%5, %15, %0\n\t"
        "v_fma_f32 %1, -%5, %16, %1\n\t"
        "v_fma_f32 %2, -%5, %17, %2\n\t"
        "v_fma_f32 %3, -%5, %18, %3\n\t"
        "v_mul_f32 %6, %0, %23\n\t"
        "v_fmac_f32 %6, %1, %24\n\t"
        "v_fmac_f32 %6, %2, %25\n\t"
        "v_fmac_f32 %6, %3, %26"
        : "+v"(s0), "+v"(s1), "+v"(s2), "+v"(s3), "+v"(y), "=&v"(p), "=&v"(t)
        : "v"(kk.x), "v"(kk.y), "v"(kk.z), "v"(kk.w), "v"(d.x), "v"(d.y), "v"(d.z), "v"(d.w), "v"(bb.x), "v"(bb.y), "v"(bb.z), "v"(bb.w),
          "v"(kp.x), "v"(kp.y), "v"(kp.z), "v"(kp.w), "v"(r.x), "v"(r.y), "v"(r.z), "v"(r.w), "v"(v));
    S.x = s0; S.y = s1; S.z = s2; S.w = s3;
    ypart = t;
    return y;
}
__device__ __forceinline__ f32x4 ld_bf4(const unsigned char* p) { const v2u w = *(const v2u*)p; return (f32x4){bflo(w.x), bfhi(w.x), bflo(w.y), bfhi(w.y)}; }

constexpr int WK_TCH = 32, WK_STEP_F = 336, WK_BUF_F = WK_TCH * WK_STEP_F;
constexpr int WK_NG = WK_TCH * 84;
__device__ __forceinline__ void wkv_fetch(v2u (&raw)[11], const unsigned char* Eb, int c, int li, int rowq) {
    const unsigned char* Ec = Eb + (size_t)c * WK_TCH * 1024;
#pragma unroll
    for (int i = 0; i < 11; ++i) { const int gi = li + 256 * i;
        if (gi < WK_NG) { const int st = gi / 84, gg = gi % 84; int off;
            if (gg < 16) off = 768 + 8 * gg; else if (gg < 32) off = 384 + 8 * (gg - 16); else if (gg < 48) off = 512 + 8 * (gg - 32);
            else if (gg < 64) off = 128 + 8 * (gg - 48); else if (gg < 80) off = 8 * (gg - 64); else off = 256 + 2 * (16 * rowq + 4 * (gg - 80));
            raw[i] = *(const v2u*)(Ec + (size_t)st * 1024 + off); }
        else raw[i] = (v2u){0u, 0u}; }
}
__device__ __forceinline__ void wkv_put(const v2u (&raw)[11], LAS float* L, int c, int li) {
    LAS float* buf = L + (c & 1) * WK_BUF_F;
#pragma unroll
    for (int i = 0; i < 11; ++i) { const int gi = li + 256 * i;
        if (gi < WK_NG) { const int st = gi / 84, gg = gi % 84; LAS float* sp = buf + st * WK_STEP_F;
            f32x4 v = (f32x4){bflo(raw[i].x), bfhi(raw[i].x), bflo(raw[i].y), bfhi(raw[i].y)};
            if (gg < 16) { v.x = __expf(-v.x); v.y = __expf(-v.y); v.z = __expf(-v.z); v.w = __expf(-v.w); }
            *(LAS f32x4*)(sp + 4 * gg) = v; } }
}
__device__ __forceinline__ void wkv_phase(const Args& a, Frame& F, unsigned char* PREP, bf16* PROJ) {
    if (F.bid < 192) {
        const int chain = F.bid >> 2, rowq = F.bid & 3, b = chain / 12, h = chain % 12;
        LAS float* L = (LAS float*)F.lds;
        const unsigned char* Eb = PREP + (size_t)chain * T * 1024;
        const bool loader = F.wave >= 4; const int li = F.tid - 256;
        f32x4 S = (f32x4){0.f, 0.f, 0.f, 0.f};
        const int k4 = F.lane & 15, rloc = 4 * (F.wave & 3) + (F.lane >> 4);
        constexpr int NCH = T / WK_TCH;
        float ypart = 0.f, yreg = 0.f;
        float* ybase = (float*)(PROJ + ((size_t)b * T + k4) * EC) + 1152 + h * 64 + 16 * rowq + rloc;
        v2u raw[11];
        if (loader) { wkv_fetch(raw, Eb, 0, li, rowq); wkv_put(raw, L, 0, li); wkv_fetch(raw, Eb, 1, li, rowq); }
        __syncthreads();
        for (int c = 0; c < NCH; ++c) {
            if (loader) { if (c + 1 < NCH) wkv_put(raw, L, c + 1, li); if (c + 2 < NCH) wkv_fetch(raw, Eb, c + 2, li, rowq); }
            else {
                const LAS float* buf = L + (c & 1) * WK_BUF_F;
                f32x4 od[2], okk[2], obb[2], okp[2], orr[2]; float ov[2];
                od[0] = *(const LAS f32x4*)(buf + 4 * k4); okk[0] = *(const LAS f32x4*)(buf + 64 + 4 * k4); obb[0] = *(const LAS f32x4*)(buf + 128 + 4 * k4);
                okp[0] = *(const LAS f32x4*)(buf + 192 + 4 * k4); orr[0] = *(const LAS f32x4*)(buf + 256 + 4 * k4); ov[0] = buf[320 + rloc];
#pragma unroll
                for (int s = 0; s < WK_TCH; ++s) {
                    if (s + 1 < WK_TCH) { const LAS float* sp = buf + (s + 1) * WK_STEP_F; const int nb = (s + 1) & 1;
                        od[nb] = *(const LAS f32x4*)(sp + 4 * k4); okk[nb] = *(const LAS f32x4*)(sp + 64 + 4 * k4); obb[nb] = *(const LAS f32x4*)(sp + 128 + 4 * k4);
                        okp[nb] = *(const LAS f32x4*)(sp + 192 + 4 * k4); orr[nb] = *(const LAS f32x4*)(sp + 256 + 4 * k4); ov[nb] = sp[320 + rloc]; }
                    const int cb = s & 1;
                    const float yprev = wkv_step_p(S, ypart, od[cb], okk[cb], obb[cb], okp[cb], orr[cb], ov[cb]);
                    yreg = (k4 == ((s + 15) & 15)) ? yprev : yreg;
                    if ((s & 15) == 0 && (c > 0 || s > 0)) ybase[(size_t)(32 * c + s - 16) * (EC / 2)] = yreg;
                }
            }
            __syncthreads();
        }
        if (!loader) {
            float dummy = 0.f; row16_sum2(ypart, dummy);
            yreg = (k4 == 15) ? ypart : yreg;
            ybase[(size_t)(T - 16) * (EC / 2)] = yreg;
            *(f32x4*)(a.out + O_PWKV + ((size_t)chain * 64 + 16 * rowq + rloc) * 64 + 4 * k4) = S;
        }
    } else {
        const int w = (F.bid - 192) * NWAVES + F.wave; const int k4 = F.lane & 15;
        for (int st = w; st < 384 * 16; st += 64 * NWAVES) {
            const int sc = st >> 4, rg = st & 15, row = 4 * rg + (F.lane >> 4), bs = sc / 12, h = sc % 12;
            f32x4 S = *(const f32x4*)(a.in[I_SWKV] + ((size_t)sc * 64 + row) * 64 + 4 * k4);
#pragma unroll
            for (int t = 0; t < 4; ++t) {
                const unsigned char* E = PREP + ((size_t)48 * T + (size_t)sc * 4 + t) * 1024;
                f32x4 d = ld_bf4(E + 768 + 8 * k4); d.x = __expf(-d.x); d.y = __expf(-d.y); d.z = __expf(-d.z); d.w = __expf(-d.w);
                const f32x4 kk = ld_bf4(E + 384 + 8 * k4), bb = ld_bf4(E + 512 + 8 * k4), kp = ld_bf4(E + 128 + 8 * k4), r = ld_bf4(E + 8 * k4);
                const float v = bf2f(*(const bf16*)(E + 256 + 2 * row));
                const float y = wkv_step(S, d, kk, bb, kp, r, v);
                if (k4 == 0) ((float*)(PROJ + ((size_t)MP + bs * 4 + t) * EC))[1152 + h * 64 + row] = y;
            }
            *(f32x4*)(a.out + O_SWKV + ((size_t)sc * 64 + row) * 64 + 4 * k4) = S;
        }
        p0_convert_items(a, (LAS float*)(F.lds + F.wave * 16384), F.lane, P0_I_IN, P0_NITEMS, w, 64 * NWAVES);
    }
}

constexpr int REC_BYTES = 8960, REC_AB = 0, REC_BT = 2048, REC_RB = 4096, REC_PST = 6144, REC_HT = 8192, REC_PC = 8704;
constexpr size_t REC_CHAIN = (size_t)256 * REC_BYTES;
constexpr size_t WS_REQUIRED = WS_END;
static_assert(14 * REC_CHAIN <= (size_t)MPAD * D * 2 && 20 * REC_CHAIN <= (size_t)M * D * 4, "record placement");
__device__ __forceinline__ unsigned char* rec_ptr(unsigned char* ws, float* out, int chain, int ck) {
    const size_t o = (size_t)ck * REC_BYTES;
    if (chain < 14) return ws + WS_BUF0 + (size_t)chain * REC_CHAIN + o;
    if (chain < 28) return ws + WS_BUF1 + (size_t)(chain - 14) * REC_CHAIN + o;
    return (unsigned char*)out + (size_t)(chain - 28) * REC_CHAIN + o;
}
constexpr size_t WS_YS = WS_SQ;
static_assert((size_t)MS * BW * 4 <= (size_t)MS * 3 * 1024 * 4, "YS region");
constexpr int CP_RT = 0, CP_X = 2304, CP_MAB = CP_X + 9216, CP_TT = CP_MAB + 1024, CP_PC = CP_TT + 1024, CP_BYTES = CP_PC + 256;
static_assert(8 * CP_BYTES <= RING_BYTES, "chunk precompute LDS");
typedef short bf16x4 __attribute__((ext_vector_type(4)));
__device__ __forceinline__ f32x4 mfma16k(v2u a, v2u b, f32x4 c) { return __builtin_amdgcn_mfma_f32_16x16x16bf16_1k(__builtin_bit_cast(bf16x4, a), __builtin_bit_cast(bf16x4, b), c, 0, 0, 0); }
__device__ __forceinline__ v2u frag4(f32x4 v) { return (v2u){pk2(v.x, v.y), pk2(v.z, v.w)}; }
__device__ __forceinline__ bf16x8 frag_lo(float x, float y, float z, float w) { return __builtin_bit_cast(bf16x8, (v4u){pk2(x, y), pk2(z, w), 0u, 0u}); }
__device__ __forceinline__ bf16x8 frag_lo4(f32x4 v) { return frag_lo(v.x, v.y, v.z, v.w); }
__device__ __forceinline__ int kpos(int k) { return (k & ~31) | (((k >> 2) & 3) << 3) | (((k >> 4) & 1) << 2) | (k & 3); }

__device__ __forceinline__ void wkv_chunk_core(unsigned char* __restrict__ REC, LAS unsigned char* scr, LAS unsigned char* scm, int lane, const float eLC) {
    const int tl = lane & 15, g4 = lane >> 4, c = lane;
    f32x4 Mab = (f32x4){0.f, 0.f, 0.f, 0.f}, MakT = Mab, Nrb = Mab, Nrk = Mab;
#pragma unroll
    for (int ks = 0; ks < 2; ++ks) {
        const int fo = tl * 144 + 64 * ks + 16 * g4;
        const bf16x8 fA = *(const LAS bf16x8*)(scr + CP_X + 0 * 2304 + fo), fB = *(const LAS bf16x8*)(scr + CP_X + 1 * 2304 + fo), fK = *(const LAS bf16x8*)(scr + CP_X + 2 * 2304 + fo), fR = *(const LAS bf16x8*)(scr + CP_RT + fo);
        Mab = mfma16(fB, fA, Mab);
        MakT = mfma16(fA, fK, MakT);
        Nrb = mfma16(fB, fR, Nrb);
        Nrk = mfma16(fK, fR, Nrk);
    }
#pragma unroll
    for (int i = 0; i < 4; ++i) { const int row = 4 * g4 + i;
        if (!(row < tl)) Mab[i] = 0.f;
        if (!(tl < row)) MakT[i] = 0.f;
        if (!(row <= tl)) { Nrb[i] = 0.f; Nrk[i] = 0.f; } }
    *(LAS f32x4*)(scm + 0 + (tl * 16 + 4 * g4) * 4) = Mab;
    float Trow[16];
#pragma unroll
    for (int t = 0; t < 16; ++t) {
        float acc = (t == tl) ? 1.0f : 0.0f;
        if (t > 0) {
            const LAS float* col = (const LAS float*)(scm + 0 + t * 64);
#pragma unroll
            for (int tp = 0; tp < t; ++tp) acc = fmaf(Trow[tp], col[tp], acc);
        }
        Trow[t] = acc;
    }
#pragma unroll
    for (int t = 0; t < 16; ++t) *(LAS float*)(scm + 1024 + (t * 16 + tl) * 4) = Trow[t];
    const v2u Tf = frag4(*(const LAS f32x4*)(scm + 1024 + (tl * 16 + 4 * g4) * 4));
    {
        unsigned short ra_[16], rb_[16], rk_[16];
#pragma unroll
        for (int t = 0; t < 16; ++t) { ra_[t] = *(const LAS unsigned short*)(scr + CP_X + 0 * 2304 + t * 144 + 2 * c); rb_[t] = *(const LAS unsigned short*)(scr + CP_X + 1 * 2304 + t * 144 + 2 * c);
            rk_[t] = *(const LAS unsigned short*)(scr + CP_X + 2 * 2304 + t * 144 + 2 * c); }
        unsigned wa[8], wb[8], wk[8];
#pragma unroll
        for (int i = 0; i < 8; ++i) { wa[i] = (unsigned)ra_[2 * i] | ((unsigned)ra_[2 * i + 1] << 16);
            wb[i] = pk2(bf2f(rb_[2 * i]) * eLC, bf2f(rb_[2 * i + 1]) * eLC); wk[i] = pk2(bf2f(rk_[2 * i]) * eLC, bf2f(rk_[2 * i + 1]) * eLC); }
        asm volatile("" ::: "memory");
        LAS unsigned char* ra = scr + CP_X + c * 48;
        *(LAS v4u*)(ra) = (v4u){wa[0], wa[1], wa[2], wa[3]}; *(LAS v4u*)(ra + 16) = (v4u){wa[4], wa[5], wa[6], wa[7]};
        *(LAS v4u*)(ra + 3072) = (v4u){wb[0], wb[1], wb[2], wb[3]}; *(LAS v4u*)(ra + 3072 + 16) = (v4u){wb[4], wb[5], wb[6], wb[7]};
        *(LAS v4u*)(ra + 6144) = (v4u){wk[0], wk[1], wk[2], wk[3]}; *(LAS v4u*)(ra + 6144 + 16) = (v4u){wk[4], wk[5], wk[6], wk[7]};
        *(LAS float*)(scm + 2048 + 4 * c) = eLC;
    }
    f32x4 Abar[4];
#pragma unroll
    for (int nt = 0; nt < 4; ++nt) { const v2u w = *(const LAS v2u*)(scr + CP_X + (16 * nt + tl) * 48 + 8 * g4);
        Abar[nt] = mfma16k(Tf, w, (f32x4){0.f, 0.f, 0.f, 0.f}); }
    const v2u fMakT = frag4(MakT), fNrb = frag4(Nrb);
    const f32x4 GT = mfma16k(Tf, fMakT, (f32x4){0.f, 0.f, 0.f, 0.f});
    const v2u fGT = frag4(GT);
    unsigned char* R = REC;
    LAS unsigned char* SB = scm + 2304;
    v2u fAb[4];
#pragma unroll
    for (int kt = 0; kt < 4; ++kt) fAb[kt] = frag4(Abar[kt]);
    {
        const f32x4 Hm = mfma16k(fGT, fNrb, Nrk);
        v2u rbw[4];
#pragma unroll
        for (int kt = 0; kt < 4; ++kt) {
            f32x4 rb = mfma16k(fAb[kt], fNrb, (f32x4){0.f, 0.f, 0.f, 0.f});
            const v2u rw = *(const LAS v2u*)(scr + CP_RT + tl * 144 + 2 * (16 * kt + 4 * g4));
            rb.x += bflo(rw.x); rb.y += bfhi(rw.x); rb.z += bflo(rw.y); rb.w += bfhi(rw.y);
            rbw[kt] = (v2u){pk2(rb.x, rb.y), pk2(rb.z, rb.w)};
        }
        asm volatile("" ::: "memory");
#pragma unroll
        for (int kt = 0; kt < 4; ++kt) *(LAS v2u*)(SB + tl * 128 + 2 * kpos(16 * kt + 4 * g4)) = rbw[kt];
        *(LAS v2u*)(SB + 2048 + tl * 32 + 8 * g4) = (v2u){pk2(Hm.x, Hm.y), pk2(Hm.z, Hm.w)};
        *(v4u*)(R + REC_RB + lane * 16) = *(const LAS v4u*)(SB + lane * 16);
        *(v4u*)(R + REC_RB + 1024 + lane * 16) = *(const LAS v4u*)(SB + 1024 + lane * 16);
        if (lane < 32) *(v4u*)(R + REC_HT + lane * 16) = *(const LAS v4u*)(SB + 2048 + lane * 16);
    }
#pragma unroll
    for (int nt = 0; nt < 4; ++nt) {
        const int pk_ = 2 * kpos(16 * nt + tl);
        const unsigned w01 = pk2(Abar[nt].x, Abar[nt].y), w23 = pk2(Abar[nt].z, Abar[nt].w);
        *(LAS unsigned short*)(SB + (4 * g4 + 0) * 128 + pk_) = (unsigned short)(w01 & 0xffffu); *(LAS unsigned short*)(SB + (4 * g4 + 1) * 128 + pk_) = (unsigned short)(w01 >> 16);
        *(LAS unsigned short*)(SB + (4 * g4 + 2) * 128 + pk_) = (unsigned short)(w23 & 0xffffu); *(LAS unsigned short*)(SB + (4 * g4 + 3) * 128 + pk_) = (unsigned short)(w23 >> 16);
    }
    *(v4u*)(R + REC_AB + lane * 16) = *(const LAS v4u*)(SB + lane * 16);
    *(v4u*)(R + REC_AB + 1024 + lane * 16) = *(const LAS v4u*)(SB + 1024 + lane * 16);
#pragma unroll
    for (int i = 0; i < 2; ++i) { const int p = lane + 64 * i;
        *(v4u*)(R + REC_BT + p * 16) = *(const LAS v4u*)(scr + CP_X + 3072 + (p >> 1) * 48 + (p & 1) * 16); }
    if (lane < 16) *(v4u*)(R + REC_PC + lane * 16) = *(const LAS v4u*)(scm + 2048 + lane * 16);
#pragma unroll
    for (int nt = 0; nt < 4; ++nt) {
        const v2u bw = *(const LAS v2u*)(scr + CP_X + 3072 + (16 * nt + tl) * 48 + 8 * g4);
        f32x4 ps = mfma16k(fGT, bw, (f32x4){0.f, 0.f, 0.f, 0.f});
        const v2u kw = *(const LAS v2u*)(scr + CP_X + 6144 + (16 * nt + tl) * 48 + 8 * g4);
        ps.x += bflo(kw.x); ps.y += bfhi(kw.x); ps.z += bflo(kw.y); ps.w += bfhi(kw.y);
        *(LAS v2u*)(SB + 2048 + nt * 512 + tl * 32 + 8 * g4) = (v2u){pk2(ps.x, ps.y), pk2(ps.z, ps.w)};
    }
    *(v4u*)(R + REC_PST + lane * 16) = *(const LAS v4u*)(SB + 2048 + lane * 16);
    *(v4u*)(R + REC_PST + 1024 + lane * 16) = *(const LAS v4u*)(SB + 2048 + 1024 + lane * 16);
}

constexpr int FZ_L = 0, FZ_LROW = 576, FZ_R = 17 * 576, FZ_RROW = 384, FZ_BYTES = 17 * 960;
constexpr int FZ_TILES = 4096, FZ_SMALL = 0;
static_assert(8 * FZ_BYTES <= RING_BYTES && FZ_TILES + 2304 + 9216 <= FZ_BYTES && FZ_R + 3 * 2048 <= FZ_BYTES, "fused prep LDS");
constexpr size_t WS_AFG = WS_WUP1;
static_assert((size_t)(MP / 16) * 9 * 1024 <= 2 * (size_t)FF * D * 2, "A-fragment cache");
__device__ __forceinline__ void wkv_afrag_task(const Args& a, const bf16* __restrict__ PROJ, const bf16* __restrict__ SHB, v4u* __restrict__ AFG, int grp, int ks, int lane) {
    const int tok = lane & 15, g4 = lane >> 4, ck = grp & 255;
    const size_t m = (size_t)grp * 16 + tok;
    const bf16* cur = PROJ + m * EC + AQKV;
    const bf16* prv = (tok == 0 && ck == 0) ? (SHB + 32 * BCOLS) : (cur - EC);
    const float* mu = a.in[I_EMU];
    const int col = 3 * BW + 32 * ks + 8 * g4;
    const v4u c8 = *(const v4u*)(cur + col), p8 = *(const v4u*)(prv + col);
    const f32x4 m0v = *(const f32x4*)(mu + col), m1v = *(const f32x4*)(mu + col + 4);
    const float cc[8] = {bflo(c8.x), bfhi(c8.x), bflo(c8.y), bfhi(c8.y), bflo(c8.z), bfhi(c8.z), bflo(c8.w), bfhi(c8.w)};
    const float pp[8] = {bflo(p8.x), bfhi(p8.x), bflo(p8.y), bfhi(p8.y), bflo(p8.z), bfhi(p8.z), bflo(p8.w), bfhi(p8.w)};
    const float mm[8] = {m0v.x, m0v.y, m0v.z, m0v.w, m1v.x, m1v.y, m1v.z, m1v.w};
    float v[8];
#pragma unroll
    for (int i = 0; i < 8; ++i) {
        v[i] = cc[i] + (pp[i] - cc[i]) * mm[i];
        const float e = __expf(ks < 2 ? 2.0f * v[i] : -v[i]);
        const float rc = rcpf_(e + 1.0f);
        v[i] = ks < 2 ? (1.0f - 2.0f * rc) : (ks >= 4 ? rc : v[i]);
    }
    AFG[((size_t)grp * 9 + ks) * 64 + lane] = (v4u){pk2(v[0], v[1]), pk2(v[2], v[3]), pk2(v[4], v[5]), pk2(v[6], v[7])};
}
__device__ __forceinline__ void wkv_prep_issue(v4u (&stg)[7], const bf16* __restrict__ PROJ, const bf16* __restrict__ SHB, int chain, int ck, int lane) {
    const int b = chain / 12, h = chain % 12; const size_t m0 = (size_t)b * T + (size_t)ck * 16;
#pragma unroll
    for (int i = 0; i < 7; ++i) { int p = lane + 64 * i; p = p < 408 ? p : 407;
        const int row = p / 24, q = p - row * 24;
        const int col = (q >> 3) * BW + h * 64 + 8 * (q & 7);
        const bf16* src = (row == 0 && ck == 0) ? (SHB + 32 * BCOLS) : (PROJ + (m0 - 1 + row) * EC + AQKV);
        stg[i] = *(const v4u*)(src + col); }
}
template <int NOCORE>
__device__ __forceinline__ void wkv_prep_chunk(const Args& a, v4u (&stg)[7], const v4u* __restrict__ AFG, const bf16* __restrict__ PROJ, const bf16* __restrict__ LW, const bf16* __restrict__ SHB, unsigned char* PREP, unsigned char* REC,
                                               LAS unsigned char* area, int chain, int ck, int nchain, int nck, int lane_in) {
    int lane = lane_in; asm volatile("" : "+v"(lane)); __builtin_assume(lane >= 0 && lane < 64);
    const int tok = lane & 15, g4 = lane >> 4, b = chain / 12, h = chain % 12;
    const size_t m0 = (size_t)b * T + (size_t)ck * 16;
#pragma unroll
    for (int i = 0; i < 7; ++i) { int p = lane + 64 * i; p = p < 408 ? p : 407; const int row = p / 24, q = p - row * 24;
        *(LAS v4u*)(area + FZ_R + row * FZ_RROW + q * 16) = stg[i]; }
    asm volatile("" ::: "memory");
    wkv_prep_issue(stg, PROJ, SHB, nchain, nck, lane);
    const float* mu = a.in[I_EMU];
    bf16x8 af[9];
#pragma unroll
    for (int ks = 0; ks < 9; ++ks) af[ks] = __builtin_bit_cast(bf16x8, AFG[((size_t)(b * 256 + ck) * 9 + ks) * 64 + lane]);
    const LAS unsigned char* curR = area + FZ_R + (tok + 1) * FZ_RROW;
#define FZ_XS4(which, cl_) ({ const v2u c4_ = *(const LAS v2u*)(curR + 128 * (which) + 2 * (cl_)), p4_ = *(const LAS v2u*)(curR - FZ_RROW + 128 * (which) + 2 * (cl_)); \
        const f32x4 cv_ = (f32x4){bflo(c4_.x), bfhi(c4_.x), bflo(c4_.y), bfhi(c4_.y)}, pv_ = (f32x4){bflo(p4_.x), bfhi(p4_.x), bflo(p4_.y), bfhi(p4_.y)}; \
        cv_ + (pv_ - cv_) * *(const f32x4*)(mu + (which) * BW + h * 64 + (cl_)); })
    const float* k_k = a.in[I_EKK];
    f32x4 kr[4];
    float ssq = 0.f;
#pragma unroll
    for (int nt = 0; nt < 4; ++nt) {
        const int cl = 16 * nt + 4 * g4;
        kr[nt] = FZ_XS4(1, cl);
        const f32x4 kkr = kr[nt] * *(const f32x4*)(k_k + h * 64 + cl);
        ssq += (kkr.x * kkr.x + kkr.y * kkr.y) + (kkr.z * kkr.z + kkr.w * kkr.w);
    }
    ssq += __shfl_xor(ssq, 16); ssq += __shfl_xor(ssq, 32);
    const float kinv = rcpf_(fmaxf(__builtin_amdgcn_sqrtf(ssq), 1e-12f));
    v2u pk_kk[4], pk_b[4], pk_ew[4];
    LAS unsigned char* tbw = area + tok * 128 + 8 * g4;
#pragma unroll
    for (int nt = 0; nt < 4; ++nt) {
        const bf16* lwp = LW + (size_t)(h * 64 + 16 * nt + tok) * LORA + 8 * g4;
        f32x4 aw = (f32x4){0.f, 0.f, 0.f, 0.f}, aa = aw, ag = aw;
        if (!(NOCORE & 2)) {
#pragma unroll
        for (int ks = 0; ks < 9; ++ks) { const bf16x8 bw = *(const bf16x8*)(lwp + 32 * ks);
            if (ks < 2) aw = mfma16(bw, af[ks], aw); else if (ks < 4) aa = mfma16(bw, af[ks], aa); else ag = mfma16(bw, af[ks], ag); }
        } else { aw = __builtin_bit_cast(f32x4, af[nt]); aa = __builtin_bit_cast(f32x4, af[nt + 4]); ag = aw; }
        const int cl = 16 * nt + 4 * g4, c4 = h * 64 + cl;
        const f32x4 w0 = *(const f32x4*)(a.in[I_EW0] + c4), a0 = *(const f32x4*)(a.in[I_EA0] + c4), kkc = *(const f32x4*)(k_k + c4), kac = *(const f32x4*)(a.in[I_EKA] + c4);
        f32x4 ew, av, kk, kp, bb;
#pragma unroll
        for (int i = 0; i < 4; ++i) {
            const float z = -(w0[i] + aw[i]);
            if (!(NOCORE & 4)) {
            const float sp = fmaxf(z, 0.f) + __logf(1.0f + __expf(-fabsf(z)));
            ew[i] = __expf(-sp - 0.5f);
            av[i] = sigmoidf_(a0[i] + aa[i]);
            } else { ew[i] = z; av[i] = a0[i] + aa[i]; }
            kk[i] = kr[nt][i] * kkc[i] * kinv;
            kp[i] = kr[nt][i] * (1.0f + (av[i] - 1.0f) * kac[i]);
            bb[i] = kk[i] * av[i];
        }
        const f32x4 rr4 = FZ_XS4(0, cl), vr4 = FZ_XS4(2, cl);
        *(LAS v2u*)(tbw + 0 * 2048 + 32 * nt) = (v2u){pk2(rr4.x, rr4.y), pk2(rr4.z, rr4.w)};
        *(LAS v2u*)(tbw + 1 * 2048 + 32 * nt) = (v2u){pk2(kp.x, kp.y), pk2(kp.z, kp.w)};
        *(LAS v2u*)(tbw + 2 * 2048 + 32 * nt) = (v2u){pk2(vr4.x, vr4.y), pk2(vr4.z, vr4.w)};
        *(LAS v2u*)(tbw + 3 * 2048 + 32 * nt) = (v2u){pk2(ag.x, ag.y), pk2(ag.z, ag.w)};
        pk_kk[nt] = (v2u){pk2(kk.x, kk.y), pk2(kk.z, kk.w)};
        pk_b[nt] = (v2u){pk2(bb.x, bb.y), pk2(bb.z, bb.w)};
        pk_ew[nt] = (v2u){pk2(ew.x, ew.y), pk2(ew.z, ew.w)};
        asm volatile("" ::: "memory");
    }
#undef FZ_XS4
    {
        LAS unsigned char* tbr = area + FZ_R + tok * 128 + 8 * g4;
#pragma unroll
        for (int nt = 0; nt < 4; ++nt) { *(LAS v2u*)(tbr + 0 * 2048 + 32 * nt) = pk_kk[nt]; *(LAS v2u*)(tbr + 1 * 2048 + 32 * nt) = pk_b[nt]; *(LAS v2u*)(tbr + 2 * 2048 + 32 * nt) = pk_ew[nt]; }
    }
#pragma unroll
    for (int sI = 0; sI < 4; ++sI) { const int tt = 4 * sI + (lane >> 4);
        unsigned char* Et = PREP + ((size_t)chain * T + (size_t)ck * 16 + tt) * 1024 + 8 * (lane & 15);
        const LAS unsigned char* tbs = area + tt * 128 + 8 * (lane & 15);
        if (!(NOCORE & 16)) { *(v2u*)(Et + 0) = *(const LAS v2u*)(tbs + 0 * 2048); *(v2u*)(Et + 128) = *(const LAS v2u*)(tbs + 1 * 2048);
        *(v2u*)(Et + 256) = *(const LAS v2u*)(tbs + 2 * 2048); *(v2u*)(Et + 640) = *(const LAS v2u*)(tbs + 3 * 2048); } }
    const int c = lane;
    float eLCv = 1.f;
    if (!(NOCORE & 8)) {
        unsigned short s_r[16], s_kp[16], s_kk[16], s_b[16], s_ew[16];
        const LAS unsigned short* t_r = (const LAS unsigned short*)(area + 0 * 2048) + c; const LAS unsigned short* t_kp = (const LAS unsigned short*)(area + 1 * 2048) + c;
        const LAS unsigned short* t_kk = (const LAS unsigned short*)(area + FZ_R + 0 * 2048) + c; const LAS unsigned short* t_b = (const LAS unsigned short*)(area + FZ_R + 1 * 2048) + c;
        const LAS unsigned short* t_ew = (const LAS unsigned short*)(area + FZ_R + 2 * 2048) + c;
#pragma unroll
        for (int t = 0; t < 16; ++t) { s_r[t] = t_r[t * 64]; s_kp[t] = t_kp[t * 64]; s_kk[t] = t_kk[t * 64]; s_b[t] = t_b[t * 64]; s_ew[t] = t_ew[t * 64]; }
        asm volatile("" ::: "memory");
        LAS unsigned char* scr0 = area + FZ_TILES;
        float L = 0.f;
#pragma unroll
        for (int t = 0; t < 16; ++t) {
            const float eprev = __expf(L);
            L -= bf2f(s_ew[t]);
            const float e = __expf(L), einv = rcpf_(e);
            *(LAS unsigned short*)(scr0 + CP_X + 0 * 2304 + t * 144 + 2 * c) = (unsigned short)f2bf(-bf2f(s_kk[t]) * eprev);
            *(LAS unsigned short*)(scr0 + CP_X + 1 * 2304 + t * 144 + 2 * c) = (unsigned short)f2bf(bf2f(s_b[t]) * einv);
            *(LAS unsigned short*)(scr0 + CP_X + 2 * 2304 + t * 144 + 2 * c) = (unsigned short)f2bf(bf2f(s_kp[t]) * einv);
            *(LAS unsigned short*)(scr0 + CP_RT + t * 144 + 2 * c) = (unsigned short)f2bf(bf2f(s_r[t]) * e);
        }
        eLCv = __expf(L);
    }
    LAS unsigned char* scr = area + FZ_TILES;
    if (!(NOCORE & 1)) wkv_chunk_core(REC, scr, area + FZ_SMALL, lane, eLCv); else if (eLCv == 12345.678f) *(float*)REC = eLCv;
}

constexpr int SQ_D = 10, SQ_SLOT = 11264, SQ_YST = SQ_D * SQ_SLOT, SQ_LOOK = SQ_D / 2 - 1;
static_assert(SQ_YST + 4 * 4096 <= RING_BYTES, "sequential pass LDS");
__device__ __forceinline__ void wkv_seq_issue(LAS unsigned char* slot, const unsigned char* R, const unsigned char* E0, int lw, int lane) {
#pragma unroll
    for (int i = 0; i < 3; ++i) {
        int q = lw * 3 + i; q = q > 10 ? 9 : q;
        const unsigned char* src;
        if (q < 2 || q == 4 || q == 5) { const int row = 8 * (q & 1) + (lane >> 3), pc = (lane & 7) ^ (row & 7); src = R + (q < 2 ? REC_AB : REC_RB) + row * 128 + pc * 16; }
        else if (q < 4) src = R + REC_BT + (q - 2) * 1024 + lane * 16;
        else if (q < 8) src = R + REC_PST + (q - 6) * 1024 + lane * 16;
        else if (q == 8) src = R + REC_HT + (lane < 48 ? lane : 47) * 16;
        else src = E0 + (size_t)(8 * (q - 9) + (lane >> 3)) * 1024 + 256 + (lane & 7) * 16;
        __builtin_amdgcn_global_load_lds((const unsigned*)src, (LAS unsigned*)(slot + q * 1024), 16, 0, 0);
    }
}
struct SeqOps { bf16x8 rb0, rb1, ab0, ab1; v2u hw; unsigned v0, v1, v2, v3; f32x4 pc0, pc1, pc2, pc3; v2u bw0, bw1, bw2, bw3, pw0, pw1, pw2, pw3; };
__device__ __forceinline__ void wkv_seq_load(SeqOps& o, const LAS unsigned char* buf, int w, int tl, int g4) {
    const LAS unsigned short* vp = (const LAS unsigned short*)(buf + 9 * 1024) + (4 * g4) * 64 + 16 * w + tl;
    const int swz = (tl >> 3) * 1024 + (tl & 7) * 128, po0 = ((g4) ^ (tl & 7)) << 4, po1 = ((4 + g4) ^ (tl & 7)) << 4;
    o.ab0 = *(const LAS bf16x8*)(buf + swz + po0); o.ab1 = *(const LAS bf16x8*)(buf + swz + po1);
    o.rb0 = *(const LAS bf16x8*)(buf + 4096 + swz + po0); o.rb1 = *(const LAS bf16x8*)(buf + 4096 + swz + po1);
    o.hw = *(const LAS v2u*)(buf + 8192 + tl * 32 + 8 * g4);
    o.v0 = vp[0]; o.v1 = vp[64]; o.v2 = vp[128]; o.v3 = vp[192];
    o.pc0 = *(const LAS f32x4*)(buf + 8192 + 512 + 4 * (0 + 4 * g4)); o.pc1 = *(const LAS f32x4*)(buf + 8192 + 512 + 4 * (16 + 4 * g4));
    o.pc2 = *(const LAS f32x4*)(buf + 8192 + 512 + 4 * (32 + 4 * g4)); o.pc3 = *(const LAS f32x4*)(buf + 8192 + 512 + 4 * (48 + 4 * g4));
    o.bw0 = *(const LAS v2u*)(buf + 2048 + (0 + tl) * 32 + 8 * g4); o.bw1 = *(const LAS v2u*)(buf + 2048 + (16 + tl) * 32 + 8 * g4);
    o.bw2 = *(const LAS v2u*)(buf + 2048 + (32 + tl) * 32 + 8 * g4); o.bw3 = *(const LAS v2u*)(buf + 2048 + (48 + tl) * 32 + 8 * g4);
    o.pw0 = *(const LAS v2u*)(buf + 6144 + (0 + tl) * 32 + 8 * g4); o.pw1 = *(const LAS v2u*)(buf + 6144 + (16 + tl) * 32 + 8 * g4);
    o.pw2 = *(const LAS v2u*)(buf + 6144 + (32 + tl) * 32 + 8 * g4); o.pw3 = *(const LAS v2u*)(buf + 6144 + (48 + tl) * 32 + 8 * g4);
}
__device__ __forceinline__ void wkv_seq_math(f32x4 (&S)[4], const SeqOps& o, LAS unsigned char* ystage, int w, int tl, int g4) {
    const bf16x8 sf0 = __builtin_bit_cast(bf16x8, (v4u){pk2(S[0].x, S[0].y), pk2(S[0].z, S[0].w), pk2(S[1].x, S[1].y), pk2(S[1].z, S[1].w)});
    const bf16x8 sf1 = __builtin_bit_cast(bf16x8, (v4u){pk2(S[2].x, S[2].y), pk2(S[2].z, S[2].w), pk2(S[3].x, S[3].y), pk2(S[3].z, S[3].w)});
    const v2u vf = (v2u){o.v0 | (o.v1 << 16), o.v2 | (o.v3 << 16)};
    f32x4 z = mfma16(o.ab0, sf0, (f32x4){0.f, 0.f, 0.f, 0.f});
    f32x4 y = mfma16(o.rb0, sf0, (f32x4){0.f, 0.f, 0.f, 0.f});
    z = mfma16(o.ab1, sf1, z);
    y = mfma16(o.rb1, sf1, y);
    f32x4 s0 = S[0] * o.pc0, s1 = S[1] * o.pc1, s2 = S[2] * o.pc2, s3 = S[3] * o.pc3;
    s0 = mfma16k(o.pw0, vf, s0); s1 = mfma16k(o.pw1, vf, s1); s2 = mfma16k(o.pw2, vf, s2); s3 = mfma16k(o.pw3, vf, s3);
    y = mfma16k(o.hw, vf, y);
    const v2u zf = (v2u){pk2(z.x, z.y), pk2(z.z, z.w)};
    S[0] = mfma16k(o.bw0, zf, s0); S[1] = mfma16k(o.bw1, zf, s1); S[2] = mfma16k(o.bw2, zf, s2); S[3] = mfma16k(o.bw3, zf, s3);
    const unsigned y01 = pk2(y.x, y.y), y23 = pk2(y.z, y.w);
    LAS unsigned short* yp = (LAS unsigned short*)(ystage + (4 * g4) * 128 + 2 * (16 * w + tl));
    yp[0] = (unsigned short)y01; yp[64] = (unsigned short)(y01 >> 16); yp[128] = (unsigned short)y23; yp[192] = (unsigned short)(y23 >> 16);
}
template <int ONLYCHAINS>
__device__ __forceinline__ void wkv_phase2(const Args& a, Frame& F, unsigned char* PREP, float* YS) {
    if (F.bid < 48) {
        const int chain = F.bid;
        unsigned char* Eb = PREP + (size_t)chain * T * 1024;
        unsigned* prog = (unsigned*)(a.ws + WS_CTL) + CW_PROG + 16 * chain;
        if (F.wave >= 4) {
            const int lw = F.wave - 4;
#pragma unroll
            for (int j = 0; j < 2 * SQ_LOOK; ++j) if (!(ONLYCHAINS & 2)) wkv_seq_issue(F.lds + j * SQ_SLOT, rec_ptr(a.ws, a.out, chain, j), Eb + (size_t)j * 16 * 1024, lw, F.lane);
            asm volatile("s_waitcnt vmcnt(%0)" :: "n"(6 * (SQ_LOOK - 2)) : "memory");
            __builtin_amdgcn_s_barrier();
            for (int p = 0; p < 128; ++p) {
                if (p > 0 && !(ONLYCHAINS & 8)) {
                    const int e = lw >> 1, hf = lw & 1, ck = 2 * (p - 1) + e;
                    const v4u yv = *(const LAS v4u*)(F.lds + SQ_YST + (((p - 1) & 1) * 2 + e) * 4096 + hf * 1024 + F.lane * 16);
                    *(v4u*)(Eb + ((size_t)ck * 16 + 8 * hf + (F.lane >> 3)) * 1024 + 384 + 16 * (F.lane & 7)) = yv; }
                if (lw == 0 && F.lane == 0) __hip_atomic_store(prog, (unsigned)(2 * p), __ATOMIC_RELAXED, __HIP_MEMORY_SCOPE_AGENT);
#pragma unroll
                for (int e = 0; e < 2; ++e) { int cn = 2 * (p + SQ_LOOK) + e; cn = cn < 256 ? cn : 255;
                    if (!(ONLYCHAINS & 2)) wkv_seq_issue(F.lds + ((2 * (p + SQ_LOOK) + e) % SQ_D) * SQ_SLOT, rec_ptr(a.ws, a.out, chain, cn), Eb + (size_t)cn * 16 * 1024, lw, F.lane); }
                asm volatile("s_waitcnt vmcnt(%0)" :: "n"(6 * (SQ_LOOK - 2)) : "memory");
                __builtin_amdgcn_s_barrier();
            }
            { const int e = lw >> 1, hf = lw & 1, ck = 254 + e;
                const v4u yv = *(const LAS v4u*)(F.lds + SQ_YST + ((127 & 1) * 2 + e) * 4096 + hf * 1024 + F.lane * 16);
                *(v4u*)(Eb + ((size_t)ck * 16 + 8 * hf + (F.lane >> 3)) * 1024 + 384 + 16 * (F.lane & 7)) = yv; }
            asm volatile("s_waitcnt vmcnt(0)" ::: "memory");
        } else {
            const int w = F.wave, tl = F.lane & 15, g4 = F.lane >> 4;
            f32x4 S[4];
#pragma unroll
            for (int i = 0; i < 4; ++i) S[i] = (f32x4){0.f, 0.f, 0.f, 0.f};
            __builtin_amdgcn_s_barrier();
            SeqOps oa, ob;
            wkv_seq_load(oa, F.lds, w, tl, g4);
            for (int p = 0; p < 128; ++p) {
                if (!(ONLYCHAINS & 4)) {
                asm volatile("s_waitcnt lgkmcnt(0)" ::: "memory");
                wkv_seq_load(ob, F.lds + ((2 * p + 1) % SQ_D) * SQ_SLOT, w, tl, g4);
                __builtin_amdgcn_sched_barrier(0);
                wkv_seq_math(S, oa, F.lds + SQ_YST + ((p & 1) * 2 + 0) * 4096, w, tl, g4);
                __builtin_amdgcn_sched_barrier(0);
                asm volatile("s_waitcnt lgkmcnt(0)" ::: "memory");
                wkv_seq_load(oa, F.lds + ((2 * p + 2) % SQ_D) * SQ_SLOT, w, tl, g4);
                __builtin_amdgcn_sched_barrier(0);
                wkv_seq_math(S, ob, F.lds + SQ_YST + ((p & 1) * 2 + 1) * 4096, w, tl, g4);
                __builtin_amdgcn_sched_barrier(0); }
                asm volatile("s_waitcnt lgkmcnt(0)" ::: "memory");
                __builtin_amdgcn_s_barrier();
            }
#pragma unroll
            for (int kt = 0; kt < 4; ++kt) *(f32x4*)(a.out + O_PWKV + ((size_t)chain * 64 + 16 * w + tl) * 64 + 16 * kt + 4 * g4) = S[kt];
        }
    } else if (!(ONLYCHAINS & 1) || (ONLYCHAINS & 16)) {
        if (F.bid < 192 && F.wave < 4) {
            const int chain = F.bid % 48, k = F.bid / 48 - 1, hw = F.wave;
            const unsigned* prog = (const unsigned*)(a.ws + WS_CTL) + CW_PROG + 16 * chain;
            const unsigned char* Eb = PREP + (size_t)chain * T * 1024;
            for (int g = k; g < 64; g += 3) {
                const int ck = 4 * g + hw;
                for (unsigned sp = 0; sp < 20000u; ++sp) {
                    const unsigned pr = (unsigned)__builtin_amdgcn_readfirstlane((int)__hip_atomic_load(prog, __ATOMIC_RELAXED, __HIP_MEMORY_SCOPE_AGENT));
                    if ((int)pr + 24 >= ck) break;
                    __builtin_amdgcn_s_sleep(8);
                }
                const unsigned char* R = rec_ptr(a.ws, a.out, chain, ck);
                v4u x[11];
#pragma unroll
                for (int i = 0; i < 9; ++i) { int pz = F.lane + 64 * i; pz = pz < 560 ? pz : 559; x[i] = *(const v4u*)(R + (size_t)pz * 16); }
#pragma unroll
                for (int i = 0; i < 2; ++i) x[9 + i] = *(const v4u*)(Eb + ((size_t)ck * 16 + 8 * i + (F.lane >> 3)) * 1024 + 256 + (F.lane & 7) * 16);
#pragma unroll
                for (int i = 0; i < 11; ++i) asm volatile("" :: "v"(x[i].x), "v"(x[i].y), "v"(x[i].z), "v"(x[i].w));
            }
        } else if (!(ONLYCHAINS & 16)) {
        const int w = (F.bid < 192) ? ((F.bid - 48) * 4 + (F.wave - 4)) : (144 * 4 + (F.bid - 192) * NWAVES + F.wave); const int k4 = F.lane & 15;
        constexpr int NW_OTHER = 144 * 4 + 64 * NWAVES;
        for (int st = w; st < 384 * 16; st += NW_OTHER) {
            const int sc = st >> 4, rg = st & 15, row = 4 * rg + (F.lane >> 4), bs = sc / 12, h = sc % 12;
            f32x4 S = *(const f32x4*)(a.in[I_SWKV] + ((size_t)sc * 64 + row) * 64 + 4 * k4);
#pragma unroll
            for (int t = 0; t < 4; ++t) {
                const unsigned char* E = PREP + ((size_t)48 * T + (size_t)sc * 4 + t) * 1024;
                f32x4 d = ld_bf4(E + 768 + 8 * k4); d.x = __expf(-d.x); d.y = __expf(-d.y); d.z = __expf(-d.z); d.w = __expf(-d.w);
                const f32x4 kk = ld_bf4(E + 384 + 8 * k4), bb = ld_bf4(E + 512 + 8 * k4), kp = ld_bf4(E + 128 + 8 * k4), r = ld_bf4(E + 8 * k4);
                const float v = bf2f(*(const bf16*)(E + 256 + 2 * row));
                const float y = wkv_step(S, d, kk, bb, kp, r, v);
                if (k4 == 0) YS[((size_t)bs * 4 + t) * BW + h * 64 + row] = y;
            }
            *(f32x4*)(a.out + O_SWKV + ((size_t)sc * 64 + row) * 64 + 4 * k4) = S;
        }
        p0_convert_items(a, (LAS float*)(F.lds + F.wave * 16384), F.lane, P0_I_IN, P0_NITEMS, w, NW_OTHER);
        }
    }
}

__device__ __forceinline__ void mix_phase(const Args& a, Frame& F, const unsigned char* PREP, const float* YS, const bf16* ATTO, const float* LSE, bf16* MIX) {
    const int u = F.lane >> 4, cq = F.lane & 15;
    for (int m = F.gw; m < M; m += NGW) {
        bf16* orow = MIX + (size_t)m * D;
        size_t e0; int es;
        if (m < MP) { e0 = (size_t)((m >> 12) * 12) * T + (m & (T - 1)); es = T; } else { const int s = m - MP; e0 = (size_t)48 * T + (size_t)((s >> 2) * 12) * 4 + (s & 3); es = 4; }
#pragma unroll
        for (int it = 0; it < 3; ++it) {
            const int h = 4 * it + u, c = h * 64 + 4 * cq;
            const unsigned char* E = PREP + (e0 + (size_t)h * es) * 1024 + 8 * cq;
            const f32x4 y = (m < MP) ? ld_bf4(E + 384) : *(const f32x4*)(YS + (size_t)(m - MP) * BW + c);
            const f32x4 r = ld_bf4(E), kp = ld_bf4(E + 128), v = ld_bf4(E + 256), g = ld_bf4(E + 640);
            const f32x4 lw = *(const f32x4*)(a.in[I_ELNW] + c), lb = *(const f32x4*)(a.in[I_ELNB] + c), rk = *(const f32x4*)(a.in[I_ERK] + c);
            const float mean = row16_sum((y.x + y.y) + (y.z + y.w)) * (1.0f / 64.0f);
            const f32x4 dy = y - mean;
            const float var = row16_sum((dy.x * dy.x + dy.y * dy.y) + (dy.z * dy.z + dy.w * dy.w)) * (1.0f / 64.0f);
            const float rs = __builtin_amdgcn_rsqf(var + LNX_EPS);
            const f32x4 rkk = r * kp * rk;
            const float bsum = row16_sum((rkk.x + rkk.y) + (rkk.z + rkk.w));
            const f32x4 o = (dy * rs * lw + lb + v * bsum) * g;
            *(v2u*)(orow + 256 + c) = (v2u){pk2(o.x, o.y), pk2(o.z, o.w)};
        }
        {
            const int hs = u, c = hs * 64 + 4 * cq;
            const float l0 = LSE[((size_t)0 * M + m) * 4 + hs], l1 = LSE[((size_t)1 * M + m) * 4 + hs], l2 = LSE[((size_t)2 * M + m) * 4 + hs];
            const f32x4 a0 = ld_bf4((const unsigned char*)(ATTO + ((size_t)0 * M + m) * 256 + c)), a1 = ld_bf4((const unsigned char*)(ATTO + ((size_t)1 * M + m) * 256 + c)), a2 = ld_bf4((const unsigned char*)(ATTO + ((size_t)2 * M + m) * 256 + c));
            const float mx = fmaxf(l0, fmaxf(l1, l2));
            const float w0 = __builtin_amdgcn_exp2f(l0 - mx), w1 = __builtin_amdgcn_exp2f(l1 - mx), w2 = __builtin_amdgcn_exp2f(l2 - mx);
            const float inv = rcpf_(w0 + w1 + w2);
            const f32x4 o = (a0 * w0 + a1 * w1 + a2 * w2) * inv;
            *(v2u*)(orow + c) = (v2u){pk2(o.x, o.y), pk2(o.z, o.w)};
        }
    }
}

constexpr int HG_QROW = 272, HG_TROW = 40;
constexpr int HG_QE = 0, HG_KE = 16 * HG_QROW, HG_KDT = 2 * 16 * HG_QROW, HG_VT = HG_KDT + 128 * HG_TROW, HG_EBL = HG_VT + 128 * HG_TROW, HG_GS = HG_EBL + 512, HG_BUF = HG_GS + 2048;
constexpr int HG_OT = 16384 + 2 * HG_BUF, HG_OROW = 272;
constexpr int HG_BASE = 16384;
constexpr size_t WS_O = WS_B;
constexpr size_t WS_XCH = WS_B + (size_t)80 * MiB;
constexpr size_t WS_XP = WS_XCH + (size_t)256 * 65536;
static_assert(WS_O + (size_t)M * D * 4 <= WS_XCH && WS_XP + 256 * 512 <= WS_END, "region B (layer 1)");

#define HG_BARRIER() LDS_BARRIER()
template <bool FULL, int SKIP = 0>
__device__ __forceinline__ void hgrn_chunks(Frame& F, const bf16* __restrict__ PC, const float* __restrict__ LB, bf16* __restrict__ O, f32x4 (&S)[8], float& Lsum, int b, int h, int seg) {
    const int tid = F.tid, c = tid & 127, j = tid >> 7, w = F.wave, tl = F.lane & 15, g4 = F.lane >> 4;
    const int pos = (c & ~31) | (((c >> 2) & 3) << 3) | (((c >> 4) & 1) << 2) | (c & 3);
    const float lb = LB[h * 128 + c];
    const size_t mseg = (size_t)b * T + (size_t)seg * 512;
    const bf16* prow = PC + (mseg + 4 * j) * CC + h * 128 + c;
    unsigned short fw[4], iw[4], qw[4], fn[4], in_[4], qn[4];
#pragma unroll
    for (int i = 0; i < 4; ++i) { fn[i] = prow[(size_t)i * CC + 1024]; in_[i] = prow[(size_t)i * CC + 2048]; qn[i] = FULL ? prow[(size_t)i * CC] : (unsigned short)0; }
    for (int n = 0; n < 32; ++n) {
        LAS unsigned char* buf = F.lds + HG_BASE + (n & 1) * HG_BUF;
#pragma unroll
        for (int i = 0; i < 4; ++i) { fw[i] = fn[i]; iw[i] = in_[i]; qw[i] = qn[i]; }
        if (n + 1 < 32) { const bf16* pn = prow + (size_t)(n + 1) * 16 * CC;
#pragma unroll
            for (int i = 0; i < 4; ++i) { fn[i] = pn[(size_t)i * CC + 1024]; in_[i] = pn[(size_t)i * CC + 2048]; if (FULL) qn[i] = pn[(size_t)i * CC]; } }
        float fg[4], pre[4]; float loc = 0.f;
#pragma unroll
        for (int i = 0; i < 4; ++i) { fg[i] = lb + (1.0f - lb) * sigmoidf_(bf2f(fw[i])); loc += __logf(fg[i]); pre[i] = loc; }
        LAS float* GS = (LAS float*)(buf + HG_GS);
        GS[j * 128 + c] = loc;
        HG_BARRIER();
        if (FULL && n > 0 && !(SKIP & 1) && w < 4) { const int row = 4 * w + (F.lane >> 4), pc = F.lane & 15;
            *(v4u*)(O + (mseg + (size_t)(n - 1) * 16 + row) * D + h * 128 + 8 * pc) = *(const LAS v4u*)(F.lds + HG_OT + row * HG_OROW + 16 * pc); }
        const float g0 = GS[c], g1 = GS[128 + c], g2 = GS[256 + c], g3 = GS[384 + c];
        const float off = (j > 0 ? g0 : 0.f) + (j > 1 ? g1 : 0.f) + (j > 2 ? g2 : 0.f);
        const float tot = (g0 + g1) + (g2 + g3);
        const float ebl = __expf(tot);
        Lsum += tot;
        float kd[4];
#pragma unroll
        for (int i = 0; i < 4; ++i) {
            const float bt = off + pre[i];
            const float eb = __expf(bt), en = rcpf_(eb);
            const float ke = (1.0f - fg[i]) * en;
            kd[i] = ke * ebl;
            if (FULL && !(SKIP & 4)) {
                const float qe = siluf_(bf2f(qw[i])) * eb;
                *(LAS unsigned short*)(buf + HG_QE + (4 * j + i) * HG_QROW + 2 * pos) = (unsigned short)f2bf(qe);
                *(LAS unsigned short*)(buf + HG_KE + (4 * j + i) * HG_QROW + 2 * pos) = (unsigned short)f2bf(ke);
            }
        }
        *(LAS v2u*)(buf + HG_KDT + c * HG_TROW + 8 * j) = (v2u){pk2(kd[0], kd[1]), pk2(kd[2], kd[3])};
        *(LAS v2u*)(buf + HG_VT + c * HG_TROW + 8 * j) = (v2u){(unsigned)iw[0] | ((unsigned)iw[1] << 16), (unsigned)iw[2] | ((unsigned)iw[3] << 16)};
        if (j == 0) *(LAS float*)(buf + HG_EBL + 4 * c) = ebl;
        HG_BARRIER();
        const v2u vv = *(const LAS v2u*)(buf + HG_VT + (16 * w + tl) * HG_TROW + 8 * g4);
        const v2u vf = vv;
        if (FULL && !(SKIP & 2)) {
            bf16x8 qf[4];
#pragma unroll
            for (int ks = 0; ks < 4; ++ks) qf[ks] = *(const LAS bf16x8*)(buf + HG_QE + tl * HG_QROW + 64 * ks + 16 * g4);
            f32x4 att = (f32x4){0.f, 0.f, 0.f, 0.f};
#pragma unroll
            for (int ks = 0; ks < 4; ++ks) att = mfma16(*(const LAS bf16x8*)(buf + HG_KE + tl * HG_QROW + 64 * ks + 16 * g4), qf[ks], att);
            if (4 * g4 + 0 > tl) att.x = 0.f;
            if (4 * g4 + 1 > tl) att.y = 0.f;
            if (4 * g4 + 2 > tl) att.z = 0.f;
            if (4 * g4 + 3 > tl) att.w = 0.f;
            const v2u pB = (v2u){pk2(att.x, att.y), pk2(att.z, att.w)};
            f32x4 o = (f32x4){0.f, 0.f, 0.f, 0.f};
#pragma unroll
            for (int ks = 0; ks < 4; ++ks) {
                const bf16x8 sf = __builtin_bit_cast(bf16x8, (v4u){pk2(S[2 * ks].x, S[2 * ks].y), pk2(S[2 * ks].z, S[2 * ks].w), pk2(S[2 * ks + 1].x, S[2 * ks + 1].y), pk2(S[2 * ks + 1].z, S[2 * ks + 1].w)});
                o = mfma16(sf, qf[ks], o);
            }
            o = mfma16k(vf, pB, o);
            *(LAS v2u*)(F.lds + HG_OT + tl * HG_OROW + 32 * w + 8 * g4) = (v2u){pk2(o.x, o.y), pk2(o.z, o.w)};
        }
#pragma unroll
        for (int kt = 0; kt < 8; ++kt) {
            const v2u kw = *(const LAS v2u*)(buf + HG_KDT + (16 * kt + tl) * HG_TROW + 8 * g4);
            const f32x4 e4 = *(const LAS f32x4*)(buf + HG_EBL + 4 * (16 * kt + 4 * g4));
            S[kt] = S[kt] * e4;
            S[kt] = mfma16k(kw, vf, S[kt]);
        }
    }
    if (FULL) { __syncthreads();
        if (w < 4) { const int row = 4 * w + (F.lane >> 4), pc = F.lane & 15;
            *(v4u*)(O + (mseg + (size_t)31 * 16 + row) * D + h * 128 + 8 * pc) = *(const LAS v4u*)(F.lds + HG_OT + row * HG_OROW + 16 * pc); } }
}

template <class BarT>
__device__ __forceinline__ void hgrn_fused(const Args& a, Frame& F, const bf16* __restrict__ PC, unsigned char* ws, const BarT& bar) {
    const float* LB = (const float*)(ws + WS_TAB + 8192);
    bf16* O = (bf16*)(ws + WS_O);
    {
        const int bs = F.bid >> 3, h = F.bid & 7;
        LAS float* Lq = (LAS float*)F.lds; LAS float* Lf = Lq + 512; LAS float* Lv = Lf + 512; LAS float* Lr = Lv + 512;
        { const int t = F.tid >> 7, k = F.tid & 127; const bf16* pr = PC + ((size_t)MP + bs * 4 + t) * CC + h * 128 + k; const float lb = LB[h * 128 + k];
          Lq[F.tid] = siluf_(bf2f(pr[0])); Lf[F.tid] = lb + (1.0f - lb) * sigmoidf_(bf2f(pr[1024])); Lv[F.tid] = bf2f(pr[2048]); }
        __syncthreads();
        const int v = F.tid & 127, kq = F.tid >> 7;
        float o0 = 0.f, o1 = 0.f, o2 = 0.f, o3 = 0.f;
        const float v0 = Lv[v], v1 = Lv[128 + v], v2 = Lv[256 + v], v3 = Lv[384 + v];
        const size_t sbase = ((size_t)(bs * 8 + h) * 128) * 128;
        for (int kk = 0; kk < 32; ++kk) { const int k = 32 * kq + kk;
            float s = a.in[I_SC][sbase + (size_t)k * 128 + v];
            float fg;
            fg = Lf[k]; s = fg * s + (1.0f - fg) * v0; o0 += Lq[k] * s;
            fg = Lf[128 + k]; s = fg * s + (1.0f - fg) * v1; o1 += Lq[128 + k] * s;
            fg = Lf[256 + k]; s = fg * s + (1.0f - fg) * v2; o2 += Lq[256 + k] * s;
            fg = Lf[384 + k]; s = fg * s + (1.0f - fg) * v3; o3 += Lq[384 + k] * s;
            a.out[O_SC + sbase + (size_t)k * 128 + v] = s; }
        Lr[(kq * 4 + 0) * 128 + v] = o0; Lr[(kq * 4 + 1) * 128 + v] = o1; Lr[(kq * 4 + 2) * 128 + v] = o2; Lr[(kq * 4 + 3) * 128 + v] = o3;
        __syncthreads();
        { const int t = F.tid >> 7, vv = F.tid & 127; const float o = Lr[(0 * 4 + t) * 128 + vv] + Lr[(1 * 4 + t) * 128 + vv] + Lr[(2 * 4 + t) * 128 + vv] + Lr[(3 * 4 + t) * 128 + vv];
          O[((size_t)MP + bs * 4 + t) * D + h * 128 + vv] = (bf16)f2bf(o); }
    }
    const int b = F.bid >> 6, h = (F.bid >> 3) & 7, seg = F.bid & 7, w = F.wave, tl = F.lane & 15, g4 = F.lane >> 4;
    v2u* XCH = (v2u*)(ws + WS_XCH); float* XP = (float*)(ws + WS_XP);
    f32x4 S[8];
    {
#pragma unroll
        for (int i = 0; i < 8; ++i) S[i] = (f32x4){0.f, 0.f, 0.f, 0.f};
        float Lsum = 0.f;
#ifdef HG_PRE
        { float L2 = 0.f; hgrn_chunks<(HG_PRE >= 2), (HG_PRE >> 2)>(F, PC, LB, O, S, L2, b, h, seg); __syncthreads();
#pragma unroll
          for (int i = 0; i < 8; ++i) S[i] = (f32x4){0.f, 0.f, 0.f, 0.f}; }
#endif
        hgrn_chunks<false>(F, PC, LB, O, S, Lsum, b, h, seg);
#pragma unroll
        for (int kt = 0; kt < 8; ++kt) XCH[(((size_t)F.bid * 8 + w) * 8 + kt) * 64 + F.lane] = (v2u){pk2(S[kt].x, S[kt].y), pk2(S[kt].z, S[kt].w)};
        if (F.tid < 128) XP[F.bid * 128 + F.tid] = __expf(Lsum);
    }
    xcd_barrier(bar);
    {
        v2u X[7][8];
#pragma unroll
        for (int sj = 0; sj < 7; ++sj) { const int blk = (F.bid & ~7) + (sj < seg ? sj : 0);
#pragma unroll
            for (int kt = 0; kt < 8; ++kt) X[sj][kt] = XCH[(((size_t)blk * 8 + w) * 8 + kt) * 64 + F.lane]; }
#pragma unroll
        for (int i = 0; i < 8; ++i) S[i] = (f32x4){0.f, 0.f, 0.f, 0.f};
#pragma unroll
        for (int sj = 0; sj < 7; ++sj) { const int blk = (F.bid & ~7) + sj;
            if (sj < seg) {
#pragma unroll
                for (int kt = 0; kt < 8; ++kt) { const f32x4 p4 = *(const f32x4*)(XP + blk * 128 + 16 * kt + 4 * g4);
                    S[kt] = S[kt] * p4 + (f32x4){bflo(X[sj][kt].x), bfhi(X[sj][kt].x), bflo(X[sj][kt].y), bfhi(X[sj][kt].y)}; } } }
    }
    {
        float Lsum = 0.f;
        hgrn_chunks<true>(F, PC, LB, O, S, Lsum, b, h, seg);
    }
    if (seg == 7) {
#pragma unroll
        for (int kt = 0; kt < 8; ++kt)
#pragma unroll
            for (int i = 0; i < 4; ++i) a.out[O_PC + ((size_t)(b * 8 + h) * 128 + 16 * kt + 4 * g4 + i) * 128 + 16 * w + tl] = S[kt][i];
    }
}

__device__ __forceinline__ void hgrn_out(const Args& a, Frame& F, const bf16* PC, const bf16* OB, bf16* CO) {
    const float* cn = a.in[I_CNORM];
    for (int m = F.gw; m < M; m += NGW) {
        const bf16* O = OB + (size_t)m * D;
        const bf16* gate = PC + (size_t)m * CC + 3072;
        f32x4 v[4]; float s = 0.f;
#pragma unroll
        for (int j = 0; j < 4; ++j) { v[j] = ld_bf4((const unsigned char*)(O + 256 * j + 4 * F.lane)); s += (v[j].x * v[j].x + v[j].y * v[j].y) + (v[j].z * v[j].z + v[j].w * v[j].w); }
        s = wave_sum(s);
        const float rs = __builtin_amdgcn_rsqf(s * (1.0f / 1024.0f) + EPS);
#pragma unroll
        for (int j = 0; j < 4; ++j) { const int c = 256 * j + 4 * F.lane; const f32x4 g = *(const f32x4*)(cn + c); const v2u gw = *(const v2u*)(gate + c);
            const float x0 = v[j].x * rs * g.x * siluf_(bflo(gw.x)), x1 = v[j].y * rs * g.y * siluf_(bfhi(gw.x)), x2 = v[j].z * rs * g.z * siluf_(bflo(gw.y)), x3 = v[j].w * rs * g.w * siluf_(bfhi(gw.y));
            v2u w; w.x = pk2(x0, x1); w.y = pk2(x2, x3); *(v2u*)(CO + (size_t)m * D + c) = w; }
    }
}

__device__ __forceinline__ void final_norm(const Args& a, Frame& F, const float* rsq) {
    const float* g = a.in[I_NFIN];
    for (int m = F.gw; m < M; m += NGW) {
        float* X = a.out + (size_t)m * D;
        const float rs = __builtin_amdgcn_rsqf(rsq[m] * (1.0f / 1024.0f) + EPS);
#pragma unroll
        for (int j = 0; j < 4; ++j) { const int c = 256 * j + 4 * F.lane; f32x4 v = *(const f32x4*)(X + c); const f32x4 gg = *(const f32x4*)(g + c); v = v * rs * gg; *(f32x4*)(X + c) = v; }
    }
}


constexpr int NPHASE = 16;
__global__ void __launch_bounds__(NTHR, 2) mk_fwd(Args args) {
    extern __shared__ __attribute__((aligned(16))) unsigned char lds[];
    Frame F;
    F.lds = (LAS unsigned char*)lds;
    F.tid = threadIdx.x; F.lane = F.tid & 63; F.wave = __builtin_amdgcn_readfirstlane(F.tid >> 6); F.bid = blockIdx.x; F.gw = F.bid * NWAVES + F.wave;
    unsigned char* ws = args.ws;
    gu32* ctl = (gu32*)(ws + WS_CTL);
    volatile LAS unsigned* MISC = (volatile LAS unsigned*)(F.lds + MISC_OFF);
    for (int u = F.tid; u < (BT_OFF - LDSCTL_OFF) / 4; u += NTHR) ((LAS unsigned*)(F.lds + LDSCTL_OFF))[u] = 0u;
    __syncthreads();
    XcdBarrier bar; bar.bar = (unsigned*)(ctl + CW_BAR); bar.x = 0; bar.st = nullptr;
#if !MK_PER_PHASE
    bar = xcd_barrier_post((unsigned*)(ctl + CW_BAR) + args.li * XCD_BAR_WORDS, MISC + 8);
#define GRID_BAR() xcd_barrier(bar)
#else
#define GRID_BAR() do {} while (0)
#endif
    const int lo = args.ph_lo, hi = args.ph_hi;
#define FRESH(G) Frame G = F; asm volatile("" : "+v"(G.tid)); __builtin_assume(G.tid >= 0 && G.tid < NTHR); G.lane = G.tid & 63
#ifndef PH_MASK
#define PH_MASK 0xFFFF
#endif
#define IN(k) ((((PH_MASK) >> (k)) & 1) && lo <= (k) && (k) < hi)
#define SEAM(k) do { if (IN(k) && IN((k) + 1)) GRID_BAR(); } while (0)

    float* rsq = (float*)(ws + WS_CTL + RSQ_OFF);
    bf16* BUF0 = (bf16*)(ws + WS_BUF0); bf16* BUF1 = (bf16*)(ws + WS_BUF1);
    bf16* RA = (bf16*)(ws + WS_A);
    unsigned char* PREP = ws + WS_B;
    bf16* ATTO = (bf16*)(ws + WS_ATTO); float* LSE = (float*)(ws + WS_LSE);
    const int G = (int)gridDim.x;

    if (IN(0)) { FRESH(G); p0_prologue(args, G); }
    SEAM(0);
    if (IN(1)) {
        pg8::Gemm g{BUF0, (const bf16*)(ws + WS_WIN0), MP, EC, D}; pg8::StaticOrder S; S.init(MP, EC, G, F.bid);
        pg8::EpiScale<0> E{RA, EC, rsq};
        pg8::gemm_phase<pg8::EpiScale<0>, pg8::StaticOrder, true, true>(F.lds, g, S, E);
        { FRESH(G); SEpiScale SE{RA, EC, rsq, 0}; sgemm_phase(G, BUF0, (const bf16*)(ws + WS_WIN0), EC, D, SE); }
    }
    SEAM(1);
    if (IN(2)) {
        FRESH(G);
        { const float* BT = (const float*)(ws + WS_TAB); LAS float* bt = (LAS float*)(F.lds + BT_OFF);
          for (int i = G.tid; i < 12 * BT_LD; i += NTHR) bt[i] = BT[i]; }
        __syncthreads();
        const LAS float* bt = (const LAS float*)(F.lds + BT_OFF);
#ifndef PSKIP
#define PSKIP 0
#endif
        const bool prb = (args.li == 1);
        if (!(prb && (PSKIP & 1)))
        for (int t = F.bid; t < NB * 3 * 4 * 16; t += 256) attn_block(G, RA, bt, ATTO, LSE, t);
        if (!(prb && (PSKIP & 2)))
        for (int t = F.gw; t < SB * 12 * 4; t += NGW) sattn_task(args, RA, bt, ATTO, LSE, (LAS float*)(F.lds + F.wave * 16384), t, G.lane);
        __syncthreads();
#ifndef PREPV
#define PREPV 0
#endif
        if (!prb || PREPV == 0) { if (!(prb && (PSKIP & 4)))
        for (int t = MP / 16 + F.bid; t < M / 16; t += 256) prep_block<0>(args, G, RA, (const bf16*)(ws + WS_TAB + 16384), (const bf16*)(ws + WS_SHB), PREP, t); }
        else { for (int t = F.bid; t < M / 16; t += 256) prep_block<(PREPV ? PREPV : 16)>(args, G, RA, (const bf16*)(ws + WS_TAB + 16384), (const bf16*)(ws + WS_SHB), (unsigned char*)args.out, t); }
        if (!(prb && (PSKIP & 8))) kv_copies(RA, args.out, F.bid * NTHR + G.tid);
        for (int t = F.gw; t < (MP / 16) * 9; t += NGW) wkv_afrag_task(args, RA, (const bf16*)(ws + WS_SHB), (v4u*)(ws + WS_AFG), t / 9, t % 9, G.lane);
    }
    SEAM(2);
    if (IN(3)) { FRESH(G);
#ifdef FRONT_TWICE
#ifndef FRONTV
#define FRONTV 1
#endif
        { LAS unsigned char* area = G.lds + G.wave * FZ_BYTES;
          v4u stg[7];
          wkv_prep_issue(stg, RA, (const bf16*)(ws + WS_SHB), G.gw >> 8, G.gw & 255, G.lane);
          for (int t = G.gw; t < 48 * 256; t += NGW) { const int tn = (t + NGW < 48 * 256) ? t + NGW : t;
              wkv_prep_chunk<FRONTV>(args, stg, (const v4u*)(ws + WS_AFG), RA, (const bf16*)(ws + WS_TAB + 16384), (const bf16*)(ws + WS_SHB), PREP, rec_ptr(ws, args.out, t >> 8, t & 255), area, t >> 8, t & 255, tn >> 8, tn & 255, G.lane); } }
#endif
#ifdef FUSED_TWICE
        { LAS unsigned char* area = G.lds + G.wave * FZ_BYTES;
          v4u stg[7];
          wkv_prep_issue(stg, RA, (const bf16*)(ws + WS_SHB), G.gw >> 8, G.gw & 255, G.lane);
          for (int t = G.gw; t < 48 * 256; t += NGW) { const int tn = (t + NGW < 48 * 256) ? t + NGW : t;
              wkv_prep_chunk<0>(args, stg, (const v4u*)(ws + WS_AFG), RA, (const bf16*)(ws + WS_TAB + 16384), (const bf16*)(ws + WS_SHB), PREP, rec_ptr(ws, args.out, t >> 8, t & 255), area, t >> 8, t & 255, tn >> 8, tn & 255, G.lane); } }
#endif
        { LAS unsigned char* area = G.lds + G.wave * FZ_BYTES;
          v4u stg[7];
          wkv_prep_issue(stg, RA, (const bf16*)(ws + WS_SHB), G.gw >> 8, G.gw & 255, G.lane);
          for (int t = G.gw; t < 48 * 256; t += NGW) { const int tn = (t + NGW < 48 * 256) ? t + NGW : t;
              wkv_prep_chunk<0>(args, stg, (const v4u*)(ws + WS_AFG), RA, (const bf16*)(ws + WS_TAB + 16384), (const bf16*)(ws + WS_SHB), PREP, rec_ptr(ws, args.out, t >> 8, t & 255), area, t >> 8, t & 255, tn >> 8, tn & 255, G.lane); } }
        GRID_BAR();
#ifdef SEQ_PRE
        wkv_phase2<SEQ_PRE>(args, G, PREP, (float*)(ws + WS_YS)); __syncthreads();
#endif
        wkv_phase2<0>(args, G, PREP, (float*)(ws + WS_YS));
#ifdef SEQ_TWICE
        __syncthreads(); wkv_phase2<SEQ_TWICE - 1>(args, G, PREP, (float*)(ws + WS_YS));
#endif
        }
    SEAM(3);
    if (IN(4)) { FRESH(G); mix_phase(args, G, PREP, (const float*)(ws + WS_YS), ATTO, LSE, BUF1); }
    SEAM(4);
    if (IN(5)) {
        pg8::Gemm g{BUF1, (const bf16*)(ws + WS_WOUT0), MP, D, D}; pg8::StaticOrder S; S.init(MP, D, G, F.bid);
        pg8::EpiResid E{args.in[I_XP], args.in[I_XS], args.out, BUF0, rsq + 1 * MPAD, M};
        pg8::gemm_phase<pg8::EpiResid, pg8::StaticOrder, true, true>(F.lds, g, S, E);
        { FRESH(G); SEpiResid SE{args.in[I_XS], args.out + (size_t)MP * D, BUF0, rsq + 1 * MPAD}; sgemm_phase(G, BUF1, (const bf16*)(ws + WS_WOUT0), D, D, SE); }
    }
    SEAM(5);
    if (IN(6)) {
        pg8::Gemm g{BUF0, (const bf16*)(ws + WS_WUP0), MP, FF, D}; pg8::StaticOrder S; S.init(MP, FF, G, F.bid);
        pg8::EpiScale<1> E{RA, FF, rsq + 1 * MPAD};
        pg8::gemm_phase<pg8::EpiScale<1>, pg8::StaticOrder, true, true>(F.lds, g, S, E);
        { FRESH(G); SEpiScale SE{RA, FF, rsq + 1 * MPAD, 1}; sgemm_phase(G, BUF0, (const bf16*)(ws + WS_WUP0), FF, D, SE); }
#ifdef SGEMM_TWICE
        { FRESH(G); SEpiScale SE{RA, FF, rsq + 1 * MPAD, 1}; sgemm_phase(G, BUF0, (const bf16*)(ws + WS_WUP0), FF, D, SE); }
        { FRESH(G); SEpiScale SE{RA, FF, rsq + 1 * MPAD, 1}; sgemm_phase(G, BUF0, (const bf16*)(ws + WS_WUP0), FF, D, SE); }
#endif
    }
    SEAM(6);
    if (IN(7)) {
        pg8::Gemm g{RA, (const bf16*)(ws + WS_WDN0), MP, D, FF}; pg8::StaticOrder S; S.init(MP, D, G, F.bid);
        pg8::EpiResid E{args.out, args.out + (size_t)MP * D, args.out, BUF1, rsq + 2 * MPAD, M};
        pg8::gemm_phase<pg8::EpiResid, pg8::StaticOrder, true, true>(F.lds, g, S, E);
        { FRESH(G); SEpiResid SE{args.out + (size_t)MP * D, args.out + (size_t)MP * D, BUF1, rsq + 2 * MPAD}; sgemm_phase(G, RA, (const bf16*)(ws + WS_WDN0), D, FF, SE); }
    }
    SEAM(7);
    if (IN(8)) {
        pg8::Gemm g{BUF1, (const bf16*)(ws + WS_WCIN), MP, CC, D}; pg8::StaticOrder S; S.init(MP, CC, G, F.bid);
        pg8::EpiScale<0> E{RA, CC, rsq + 2 * MPAD};
        pg8::gemm_phase<pg8::EpiScale<0>, pg8::StaticOrder, true, true>(F.lds, g, S, E);
        { FRESH(G); SEpiScale SE{RA, CC, rsq + 2 * MPAD, 0}; sgemm_phase(G, BUF1, (const bf16*)(ws + WS_WCIN), CC, D, SE); }
    }
    SEAM(8);
    if (IN(9)) { }
    if (IN(10)) { FRESH(G); hgrn_fused(args, G, RA, ws, bar); }
    SEAM(10);
    if (IN(11)) { FRESH(G); hgrn_out(args, G, RA, (const bf16*)(ws + WS_O), BUF0); }
    SEAM(11);
    if (IN(12)) {
        pg8::Gemm g{BUF0, (const bf16*)(ws + WS_WCOUT), MP, D, D}; pg8::StaticOrder S; S.init(MP, D, G, F.bid);
        pg8::EpiResid E{args.out, args.out + (size_t)MP * D, args.out, BUF1, rsq + 3 * MPAD, M};
        pg8::gemm_phase<pg8::EpiResid, pg8::StaticOrder, true, true>(F.lds, g, S, E);
        { FRESH(G); SEpiResid SE{args.out + (size_t)MP * D, args.out + (size_t)MP * D, BUF1, rsq + 3 * MPAD}; sgemm_phase(G, BUF0, (const bf16*)(ws + WS_WCOUT), D, D, SE); }
    }
    SEAM(12);
    if (IN(13)) {
        pg8::Gemm g{BUF1, (const bf16*)(ws + WS_WUP1), MP, FF, D}; pg8::StaticOrder S; S.init(MP, FF, G, F.bid);
        pg8::EpiScale<1> E{RA, FF, rsq + 3 * MPAD};
        pg8::gemm_phase<pg8::EpiScale<1>, pg8::StaticOrder, true, true>(F.lds, g, S, E);
        { FRESH(G); SEpiScale SE{RA, FF, rsq + 3 * MPAD, 1}; sgemm_phase(G, BUF1, (const bf16*)(ws + WS_WUP1), FF, D, SE); }
    }
    SEAM(13);
    if (IN(14)) {
        pg8::Gemm g{RA, (const bf16*)(ws + WS_WDN1), MP, D, FF}; pg8::StaticOrder S; S.init(MP, D, G, F.bid);
        pg8::EpiResid E{args.out, args.out + (size_t)MP * D, args.out, BUF0, rsq + 4 * MPAD, M};
        pg8::gemm_phase<pg8::EpiResid, pg8::StaticOrder, true, true>(F.lds, g, S, E);
        { FRESH(G); SEpiResid SE{args.out + (size_t)MP * D, args.out + (size_t)MP * D, BUF0, rsq + 4 * MPAD}; sgemm_phase(G, RA, (const bf16*)(ws + WS_WDN1), D, FF, SE); }
    }
    SEAM(14);
    if (IN(15)) { FRESH(G); final_norm(args, G, rsq + 4 * MPAD); }
#undef IN
#undef SEAM
}

extern "C" void kernel_launch(void* const* d_in, const int* in_sizes, int n_in, void* d_out, int out_size, void* d_ws, size_t ws_size, hipStream_t stream) {
    static int grid = 0;
    if (grid == 0) {
        if (n_in != 31 || in_sizes[0] != MP * D || out_size != (int)O_END || ws_size < WS_REQUIRED) {
            fprintf(stderr, "kernel_launch: shape/workspace mismatch: n_in %d in0 %d out %d ws %zu (need %zu); nothing launched\n", n_in, n_in > 0 ? in_sizes[0] : -1, out_size, ws_size, (size_t)WS_REQUIRED); grid = -1; return; }
        if (hipFuncSetAttribute((const void*)mk_fwd, hipFuncAttributeMaxDynamicSharedMemorySize, LDS_BYTES) != hipSuccess) { fprintf(stderr, "kernel_launch: hipFuncSetAttribute failed\n"); grid = -1; return; }
        int per_cu = 0;
        if (hipOccupancyMaxActiveBlocksPerMultiprocessor(&per_cu, (const void*)mk_fwd, NTHR, LDS_BYTES) != hipSuccess || per_cu < 1)
            fprintf(stderr, "kernel_launch: note: occupancy query reports %d workgroups per CU\n", per_cu);
        (void)hipGetLastError();
        grid = 256;
    }
    if (grid < 0) return;
    if (hipMemsetAsync((char*)d_ws + WS_CTL, 0, CTL_ZERO_BYTES, stream) != hipSuccess) { fprintf(stderr, "kernel_launch: hipMemsetAsync failed\n"); return; }
    Args a{};
    for (int i = 0; i < 31; ++i) a.in[i] = (const float*)d_in[i];
    a.out = (float*)d_out; a.ws = (unsigned char*)d_ws;
#if MK_PER_PHASE
    for (int p = 0; p < NPHASE; ++p) { a.ph_lo = p; a.ph_hi = p + 1; hipLaunchKernelGGL(mk_fwd, dim3(grid), dim3(NTHR), LDS_BYTES, stream, a); }
#else
#if defined(PROBE_PHASE)
    a.ph_lo = 0; a.ph_hi = PROBE_PHASE + 1; a.li = 0; hipLaunchKernelGGL(mk_fwd, dim3(grid), dim3(NTHR), LDS_BYTES, stream, a);
    a.ph_lo = PROBE_PHASE; a.ph_hi = PROBE_PHASE + 1; a.li = 1; hipLaunchKernelGGL(mk_fwd, dim3(grid), dim3(NTHR), LDS_BYTES, stream, a);
    a.ph_lo = PROBE_PHASE + 1; a.ph_hi = NPHASE; a.li = 2; hipLaunchKernelGGL(mk_fwd, dim3(grid), dim3(NTHR), LDS_BYTES, stream, a);
#else
    a.ph_lo = 0; a.ph_hi = NPHASE;
    hipLaunchKernelGGL(mk_fwd, dim3(grid), dim3(NTHR), LDS_BYTES, stream, a);
#endif
#endif
    const hipError_t le = hipPeekAtLastError();
    if (le != hipSuccess) fprintf(stderr, "kernel_launch: launch failed: %s\n", hipGetErrorName(le));
}
```
